# Optimizing an MI355X kernel written in HIP

```python
import math
import jax, jax.numpy as jnp
from jax import lax
import numpy as np

D_MODEL = 1024
BATCH = 8
SEQ = 2048
DEPTH = 2

N_GROUPS = 4
GROUP_WIDTH = D_MODEL // N_GROUPS
D_MIX = N_GROUPS * GROUP_WIDTH
HEAD_DIM = 64
N_HEADS_G = GROUP_WIDTH // HEAD_DIM
RWKV_LORA = 32
RWKV_DECAY_SCALE = math.exp(-0.5)
RWKV_LNX_EPS = 64e-5
RWKV_IN = 3 * GROUP_WIDTH + 2 * RWKV_LORA
RWKV_COLS = RWKV_IN + GROUP_WIDTH
BRANCH_COLS = 4 * GROUP_WIDTH
W_IN_COLS = RWKV_COLS + 3 * BRANCH_COLS
CONV_WIDTH = 3
MOBA_BLOCK = 256
MOBA_TOPK = 3
MOBA_QBLOCK = 128
RET_CHUNK = 128
REL_BUCKETS = 32
REL_MAX_DIST = 128
NORM_EPS = 1e-6

kernel_name = "hymba_style_rwkv7_conv_moba_retnet_hybrid"


def rmsnorm(x, w):
    xf = x.astype(jnp.float32)
    y = xf * lax.rsqrt(jnp.mean(xf * xf, axis=-1, keepdims=True) + NORM_EPS)
    return (y * w.astype(jnp.float32)).astype(x.dtype)


def token_shift(u):
    return jnp.pad(u, ((0, 0), (1, 0), (0, 0)))[:, :-1]


def rwkv7_time_mix(p, mu, w0, w2, a0, a2, k_k, k_a, r_k, lnx_w, lnx_b):
    B, T, _ = p.shape
    H, N, G, L = N_HEADS_G, HEAD_DIM, GROUP_WIDTH, RWKV_LORA
    p = p + (token_shift(p) - p) * mu
    r, k, v, wl, al = jnp.split(p, [G, 2 * G, 3 * G, 3 * G + L], axis=-1)
    decay = jnp.exp(-RWKV_DECAY_SCALE * jax.nn.sigmoid(w0 + jnp.tanh(wl) @ w2))
    a = jax.nn.sigmoid(a0 + al @ a2)
    kk = (k * k_k).reshape(B, T, H, N).astype(jnp.float32)
    kk = kk / jnp.maximum(jnp.sqrt(jnp.sum(kk * kk, axis=-1, keepdims=True)), 1e-12)
    k = k * (1.0 + (a - 1.0) * k_a)

    def heads(t):
        return t.reshape(B, T, H, N).astype(jnp.float32)

    rh, kh, vh = heads(r), heads(k), heads(v)
    to_time = lambda t: t.transpose(1, 0, 2, 3)
    xs = (to_time(rh), to_time(heads(decay)), to_time(kh), to_time(vh),
          to_time(kk), to_time(heads(a)))

    def step(state, inp):
        r_t, w_t, k_t, v_t, kk_t, a_t = inp
        s_kk = jnp.einsum('bhij,bhj->bhi', state, kk_t)
        state = (state * w_t[:, :, None, :]
                 - s_kk[..., None] * (kk_t * a_t)[:, :, None, :]
                 + v_t[..., None] * k_t[:, :, None, :])
        y_t = jnp.einsum('bhij,bhj->bhi', state, r_t)
        return state, y_t

    state0 = jnp.zeros((B, H, N, N), jnp.float32)
    _, y = lax.scan(step, state0, xs)
    y = y.transpose(1, 0, 2, 3)
    mean = jnp.mean(y, axis=-1, keepdims=True)
    var = jnp.mean(jnp.square(y - mean), axis=-1, keepdims=True)
    y = ((y - mean) * lax.rsqrt(var + RWKV_LNX_EPS)).reshape(B, T, G)
    y = y * lnx_w.astype(jnp.float32) + lnx_b.astype(jnp.float32)
    bonus = jnp.sum(rh * kh * r_k.astype(jnp.float32), axis=-1, keepdims=True) * vh
    y = y + bonus.reshape(B, T, G)
    return y.astype(p.dtype)


def short_conv_mix(p, conv_w):
    T = p.shape[1]
    b_gate, c_gate, h = jnp.split(p, 3, axis=-1)
    u = c_gate * h
    up = jnp.pad(u, ((0, 0), (CONV_WIDTH - 1, 0), (0, 0)))
    y = up[:, 0:T] * conv_w[0]
    for j in range(1, CONV_WIDTH):
        y = y + up[:, j:j + T] * conv_w[j]
    return b_gate * y


def t5_bucket(dist):
    max_exact = REL_BUCKETS // 2
    d_f = jnp.maximum(dist, 1).astype(jnp.float32)
    large = max_exact + (jnp.log(d_f / max_exact) / math.log(REL_MAX_DIST / max_exact)
                         * (REL_BUCKETS - max_exact)).astype(jnp.int32)
    large = jnp.minimum(large, REL_BUCKETS - 1)
    return jnp.where(dist < max_exact, dist, large)


def moba_attention(q, k, v, rel_bias):
    B, T, _ = q.shape
    H, Dh, BLK, QB = N_HEADS_G, HEAD_DIM, MOBA_BLOCK, MOBA_QBLOCK
    to_heads = lambda t: t.reshape(B, T, H, Dh).transpose(0, 2, 1, 3)
    q, k, v = to_heads(q) * (Dh ** -0.5), to_heads(k), to_heads(v)
    nb = -(-T // BLK)
    pad = nb * BLK - T
    kp = jnp.pad(k, ((0, 0), (0, 0), (0, pad), (0, 0))).reshape(B, H, nb, BLK, Dh)
    vp = jnp.pad(v, ((0, 0), (0, 0), (0, pad), (0, 0))).reshape(B, H, nb, BLK, Dh)
    k_mean = jnp.mean(kp, axis=3)
    gate = jnp.einsum('bhtd,bhnd->bhtn', q, k_mean).astype(jnp.float32)
    q_block = jnp.arange(T) // BLK
    fully_past = jnp.arange(nb)[None, :] < q_block[:, None]
    gate = jnp.where(fully_past, gate, -jnp.inf)
    ksel = min(MOBA_TOPK, nb)
    top_val, top_idx = lax.top_k(gate, ksel)
    sel_ok = jnp.isfinite(top_val)

    nqb = T // QB
    def to_items(t):
        X = t.shape[-1]
        return t.reshape(B, H, nqb, QB, X).transpose(0, 2, 1, 3, 4).reshape(B * nqb, H, QB, X)

    items = jnp.arange(B * nqb)
    bias_tab = rel_bias.T
    offs = jnp.arange(BLK)

    def one_item(args):
        item, q_i, idx_i, ok_i = args
        b = item // nqb
        qb = item % nqb
        kb = lax.dynamic_index_in_dim(kp, b, 0, keepdims=False)
        vb = lax.dynamic_index_in_dim(vp, b, 0, keepdims=False)
        k_sel = jax.vmap(lambda kh, ih: kh[ih])(kb, idx_i)
        v_sel = jax.vmap(lambda vh, ih: vh[ih])(vb, idx_i)
        ib = (qb * QB) // BLK
        k_own = lax.dynamic_index_in_dim(kb, ib, 1, keepdims=False)
        v_own = lax.dynamic_index_in_dim(vb, ib, 1, keepdims=False)
        q_pos = qb * QB + jnp.arange(QB)
        sel_pos = idx_i[..., None] * BLK + offs
        own_pos = ib * BLK + offs
        bias_sel = jax.vmap(lambda tab, bk: tab[bk])(bias_tab, t5_bucket(q_pos[None, :, None, None] - sel_pos))
        own_dist = q_pos[:, None] - own_pos[None, :]
        bias_own = bias_tab[:, t5_bucket(jnp.maximum(own_dist, 0))]
        s_sel = jnp.einsum('hqd,hqnkd->hqnk', q_i, k_sel) + bias_sel
        s_sel = jnp.where(ok_i[..., None], s_sel, -jnp.inf)
        s_own = jnp.einsum('hqd,hkd->hqk', q_i, k_own) + bias_own
        s_own = jnp.where((own_dist >= 0)[None], s_own, -jnp.inf)
        logits = jnp.concatenate([s_sel.reshape(H, QB, ksel * BLK), s_own], axis=-1).astype(jnp.float32)
        prob = jax.nn.softmax(logits, axis=-1).astype(v.dtype)
        p_sel = prob[..., :ksel * BLK].reshape(H, QB, ksel, BLK)
        p_own = prob[..., ksel * BLK:]
        return (jnp.einsum('hqnk,hqnkd->hqd', p_sel, v_sel)
                + jnp.einsum('hqk,hkd->hqd', p_own, v_own))

    out = lax.map(one_item, (items, to_items(q), to_items(top_idx), to_items(sel_ok)))
    out = out.reshape(B, nqb, H, QB, Dh).transpose(0, 1, 3, 2, 4).reshape(B, T, H * Dh)
    return out


def rotate_every_two(x, pos):
    half = x.shape[-1] // 2
    theta = 1.0 / (10000.0 ** jnp.linspace(0.0, 1.0, half))
    ang = pos[:, None] * theta[None, :]
    sin, cos = jnp.sin(ang).astype(x.dtype), jnp.cos(ang).astype(x.dtype)
    x1, x2 = x[..., 0::2], x[..., 1::2]
    return jnp.stack([x1 * cos - x2 * sin, x1 * sin + x2 * cos], axis=-1).reshape(x.shape)


def retention_chunkwise(q, k, v):
    B, T, _ = q.shape
    H, Dh, C = N_HEADS_G, HEAD_DIM, RET_CHUNK
    to_heads = lambda t: t.reshape(B, T, H, Dh).transpose(0, 2, 1, 3).astype(jnp.float32)
    pos = jnp.arange(T, dtype=jnp.float32)
    q = rotate_every_two(to_heads(q), pos)
    k = rotate_every_two(to_heads(k), pos) * (Dh ** -0.5)
    v = to_heads(v)
    log_gamma = jnp.log(1.0 - 2.0 ** (-5.0 - jnp.arange(H, dtype=jnp.float32)))
    idx = jnp.arange(C, dtype=jnp.float32)
    diff = idx[:, None] - idx[None, :]
    decay_intra = jnp.where(diff >= 0, jnp.exp(log_gamma[:, None, None] * jnp.maximum(diff, 0.0)), 0.0)
    q_decay = jnp.exp(log_gamma[:, None] * (idx + 1.0))[..., None]
    k_decay = jnp.exp(log_gamma[:, None] * (C - 1.0 - idx))[..., None]
    chunk_decay = jnp.exp(log_gamma * C)[:, None, None]
    nc = T // C
    chunks = lambda t: t.reshape(B, H, nc, C, Dh).transpose(2, 0, 1, 3, 4)

    def step(R, inp):
        qc, kc, vc = inp
        inner = jnp.einsum('bhnd,bhmd->bhnm', qc, kc) * decay_intra
        y = (jnp.einsum('bhnm,bhmd->bhnd', inner, vc)
             + jnp.einsum('bhnd,bhde->bhne', qc * q_decay, R))
        R = R * chunk_decay + jnp.einsum('bhmd,bhme->bhde', kc * k_decay, vc)
        return R, y

    R0 = jnp.zeros((B, H, Dh, Dh), jnp.float32)
    _, y = lax.scan(step, R0, (chunks(q), chunks(k), chunks(v)))
    y = y.transpose(1, 0, 3, 2, 4).reshape(B, T, H, Dh)
    y = y * lax.rsqrt(jnp.mean(y * y, axis=-1, keepdims=True) + NORM_EPS)
    return y.reshape(B, T, H * Dh)


def hybrid_layer(x, norm_w, w_in, w_out, rwkv_mu, rwkv_w0, rwkv_w2, rwkv_a0, rwkv_a2,
                 rwkv_k_k, rwkv_k_a, rwkv_r_k, rwkv_lnx_w, rwkv_lnx_b, conv_w, rel_bias):
    G = GROUP_WIDTH
    h = rmsnorm(x, norm_w)
    proj = h @ w_in
    p_rwkv, p_conv, p_moba, p_ret = jnp.split(
        proj, [RWKV_COLS, RWKV_COLS + BRANCH_COLS, RWKV_COLS + 2 * BRANCH_COLS], axis=-1)
    dt = proj.dtype
    y_rwkv = rwkv7_time_mix(p_rwkv[..., :RWKV_IN], rwkv_mu, rwkv_w0, rwkv_w2, rwkv_a0, rwkv_a2,
                            rwkv_k_k, rwkv_k_a, rwkv_r_k, rwkv_lnx_w, rwkv_lnx_b)
    y_rwkv = y_rwkv.astype(dt) * jax.nn.silu(p_rwkv[..., RWKV_IN:])
    y_conv = short_conv_mix(p_conv[..., :3 * G], conv_w).astype(dt) * jax.nn.silu(p_conv[..., 3 * G:])
    y_moba = moba_attention(p_moba[..., :G], p_moba[..., G:2 * G], p_moba[..., 2 * G:3 * G], rel_bias)
    y_moba = y_moba.astype(dt) * jax.nn.silu(p_moba[..., 3 * G:])
    y_ret = retention_chunkwise(p_ret[..., :G], p_ret[..., G:2 * G], p_ret[..., 2 * G:3 * G])
    y_ret = y_ret.astype(dt) * jax.nn.silu(p_ret[..., 3 * G:])
    y = jnp.concatenate([y_rwkv, y_conv, y_moba, y_ret], axis=-1)
    return x + y @ w_out


def setup_inputs(seed: int = 0) -> dict:
    key = jax.random.key(seed)
    ks = jax.random.split(key, 17)
    f32 = jnp.float32
    nrm = lambda k, shape: jax.random.normal(k, shape, f32)
    G, L = GROUP_WIDTH, RWKV_LORA
    return {
        "x": nrm(ks[0], (BATCH, SEQ, D_MODEL)),
        "norm_w": 1.0 + 0.02 * nrm(ks[1], (DEPTH, D_MODEL)),
        "w_in": nrm(ks[2], (DEPTH, D_MODEL, W_IN_COLS)) * D_MODEL ** -0.5,
        "w_out": nrm(ks[3], (DEPTH, D_MIX, D_MODEL)) * D_MIX ** -0.5,
        "rwkv_mu": jax.random.uniform(ks[4], (DEPTH, RWKV_IN), f32),
        "rwkv_w0": 0.5 * nrm(ks[5], (DEPTH, G)),
        "rwkv_w2": nrm(ks[6], (DEPTH, L, G)) * 0.5 * L ** -0.5,
        "rwkv_a0": 0.5 * nrm(ks[7], (DEPTH, G)),
        "rwkv_a2": nrm(ks[8], (DEPTH, L, G)) * 0.5 * L ** -0.5,
        "rwkv_k_k": 0.85 + 0.05 * nrm(ks[9], (DEPTH, G)),
        "rwkv_k_a": 1.0 + 0.05 * nrm(ks[10], (DEPTH, G)),
        "rwkv_r_k": 0.1 * nrm(ks[11], (DEPTH, N_HEADS_G, HEAD_DIM)),
        "rwkv_lnx_w": 1.0 + 0.02 * nrm(ks[12], (DEPTH, G)),
        "rwkv_lnx_b": 0.02 * nrm(ks[13], (DEPTH, G)),
        "conv_w": nrm(ks[14], (DEPTH, CONV_WIDTH, G)) * CONV_WIDTH ** -0.5,
        "rel_bias": 0.5 * nrm(ks[15], (REL_BUCKETS, N_HEADS_G)),
        "final_norm_w": 1.0 + 0.02 * nrm(ks[16], (D_MODEL,)),
    }


def reference(x, norm_w, w_in, w_out, rwkv_mu, rwkv_w0, rwkv_w2, rwkv_a0, rwkv_a2,
              rwkv_k_k, rwkv_k_a, rwkv_r_k, rwkv_lnx_w, rwkv_lnx_b, conv_w, rel_bias,
              final_norm_w):
    for l in range(DEPTH):
        x = hybrid_layer(x, norm_w[l], w_in[l], w_out[l], rwkv_mu[l], rwkv_w0[l], rwkv_w2[l],
                         rwkv_a0[l], rwkv_a2[l], rwkv_k_k[l], rwkv_k_a[l], rwkv_r_k[l],
                         rwkv_lnx_w[l], rwkv_lnx_b[l], conv_w[l], rel_bias)
    return rmsnorm(x, final_norm_w)
```

```cpp
#include <hip/hip_runtime.h>
#include <cstdio>
#include <cstdint>
namespace pg8 {
#define PG8_LAS __attribute__((address_space(3)))
typedef unsigned short bf16_t;
typedef short bf16x8 __attribute__((ext_vector_type(8)));
typedef float f32x4 __attribute__((ext_vector_type(4)));
typedef unsigned u32x4 __attribute__((ext_vector_type(4)));
constexpr int BM = 256, BK = 64, HALF = 128, HTB = HALF * BK * 2  , STAGE_BYTES = 8 * HTB, NXCD = 8, WGM = 8;

__host__ __device__ __forceinline__ int lds_byte(int r, int c) { const int st = (r >> 4) * 2 + (c >> 5), rr = r & 15, cc = c & 31, ob = rr * 64 + cc * 2; return st * 1024 + (ob ^ (((ob >> 9) & 1) << 5)); }
__host__ __device__ __forceinline__ void stage_rc(int b, int& R, int& C) { const int st = b / 1024, sb = b % 1024, swz = sb ^ (((sb >> 9) & 1) << 5); R = (st >> 1) * 16 + swz / 64; C = (st & 1) * 32 + (swz % 64) / 2; }
__host__ __device__ __forceinline__ int perm32(int rho) { const int n = rho >> 4, i = rho & 15; return 8 * (i >> 2) + 4 * n + (i & 3); }

struct Unit { int pm, pn; };
struct Gemm { const bf16_t* A; const bf16_t* Bt; int M, N, K; };

struct StaticOrder {
    int nM, nN, nwg, G, c;
    __host__ __device__ void init(int M, int N, int G_, int c_) { nM = M / BM; nN = N / BM; nwg = nM * nN; G = G_; c = c_; }
    __host__ __device__ bool next(int i, Unit& u) const {
        const long L = (long)i * G + c; if (L >= nwg) return false;
        int wgid = (int)L; { const int q = nwg / NXCD, r = nwg % NXCD, xcd = wgid % NXCD, off = wgid / NXCD; wgid = (xcd < r ? xcd * (q + 1) : r * (q + 1) + (xcd - r) * q) + off; }
        const int nig = WGM * nN, gid = wgid / nig, fm = gid * WGM, gsz = (nM - fm) < WGM ? (nM - fm) : WGM;
        u.pm = fm + ((wgid % nig) % gsz); u.pn = (wgid % nig) / gsz; return true;
    }
    __device__ __forceinline__ void a_ready(const Unit&) const {}
    __device__ __forceinline__ void done(const Unit&) const {}
};
typedef float f32x2_e __attribute__((ext_vector_type(2))); typedef __bf16 bf16x2_e __attribute__((ext_vector_type(2)));
__device__ __forceinline__ unsigned cvt_pk_bf16(float lo, float hi) { f32x2_e v = {lo, hi}; bf16x2_e b = __builtin_convertvector(v, bf16x2_e); return __builtin_bit_cast(unsigned, b); }

constexpr int EP_M = 16384;
#define PG8_GAS __attribute__((address_space(1)))
struct EpiWin {
    static constexpr bool PERM = true, AFTER_DRAIN = false;
    bf16_t* PB; const float* ssq; const float* thr; float* KM;
    __device__ __forceinline__ void operator()(const f32x4 (&acc)[2][2][4][2], const Unit& u, int wr, int wc, int fr, int fq) const {
        const int pn = u.pn;
        PG8_GAS bf16_t* PB_ = (PG8_GAS bf16_t*)PB; const PG8_GAS float* ssq_ = (const PG8_GAS float*)ssq; const PG8_GAS float* thr_ = (const PG8_GAS float*)thr; PG8_GAS float* KM_ = (PG8_GAS float*)KM;
        asm volatile("" : "+s"(PB_), "+s"(ssq_), "+s"(thr_), "+s"(KM_));
        const int rowb = u.pm * BM + wr * 64 + fr;
        const bool do_silu = (pn == 3 || pn == 7 || pn == 11 || pn == 15);
        const bool do_rot = (pn == 12 || pn == 13);
        const float scl = pn == 8 ? 0.125f * 1.4426950408889634f : (pn == 13 ? 0.125f : 1.0f);
        const bool do_km = (pn == 9);
        const bool lora = (pn == 16);
        PG8_GAS bf16_t* base = PB_ + (size_t)pn * ((size_t)EP_M * 256);
        const int ldc = lora ? 64 : 256;
        float rsv[2][4];
#pragma unroll
        for (int ai = 0; ai < 2; ++ai)
#pragma unroll
            for (int m = 0; m < 4; ++m) rsv[ai][m] = ssq_[rowb + ai * HALF + m * 16];
        f32x4 th[2] = {{0.f, 0.f, 0.f, 0.f}, {0.f, 0.f, 0.f, 0.f}};
        if (do_rot) {
#pragma unroll
            for (int bj = 0; bj < 2; ++bj) th[bj] = *(const PG8_GAS f32x4*)(thr_ + (((bj * HALF + wc * 32 + 8 * fq) & 63) >> 1));
        }
#pragma unroll
        for (int ai = 0; ai < 2; ++ai)
#pragma unroll
            for (int m = 0; m < 4; ++m) rsv[ai][m] = rsqrtf(rsv[ai][m] * (1.0f / 1024.0f) + 1e-6f);
        float cs[2][8];
#pragma unroll
        for (int bj = 0; bj < 2; ++bj)
#pragma unroll
            for (int j = 0; j < 8; ++j) cs[bj][j] = 0.f;
#pragma unroll
        for (int ai = 0; ai < 2; ++ai)
#pragma unroll
            for (int m = 0; m < 4; ++m) {
                const int row = rowb + ai * HALF + m * 16;
                const float rs = rsv[ai][m];
#pragma unroll
                for (int bj = 0; bj < 2; ++bj) {
                    const int c8 = bj * HALF + wc * 32 + 8 * fq;
                    float v[8];
#pragma unroll
                    for (int j = 0; j < 4; ++j) { v[j] = acc[ai][bj][m][0][j] * rs; v[4 + j] = acc[ai][bj][m][1][j] * rs; }
                    if (do_silu) {
#pragma unroll
                        for (int j = 0; j < 8; ++j) v[j] = v[j] * __builtin_amdgcn_rcpf(1.0f + __expf(-v[j]));
                    }
                    if (do_rot) {
                        const int pos = row & 2047; const float fpos = (float)pos;
#pragma unroll
                        for (int j = 0; j < 4; ++j) {
                            float rev = fpos * th[bj][j]; rev = rev - floorf(rev);
                            const float cj = __builtin_amdgcn_cosf(rev), sj = __builtin_amdgcn_sinf(rev);
                            const float a = v[2 * j], b = v[2 * j + 1]; v[2 * j] = a * cj - b * sj; v[2 * j + 1] = a * sj + b * cj; }
                        const float lgm = __log2f(1.0f - __builtin_amdgcn_exp2f(-5.0f - (float)(c8 >> 6))) * (float)(pos & 255);
                        const float fdec = __builtin_amdgcn_exp2f(pn == 12 ? lgm : -lgm);
#pragma unroll
                        for (int j = 0; j < 8; ++j) v[j] *= fdec;
                    }
#pragma unroll
                    for (int j = 0; j < 8; ++j) v[j] *= scl;
                    if (do_km) {
#pragma unroll
                        for (int j = 0; j < 8; ++j) cs[bj][j] += v[j];
                    }
                    u32x4 w; w.x = cvt_pk_bf16(v[0], v[1]); w.y = cvt_pk_bf16(v[2], v[3]); w.z = cvt_pk_bf16(v[4], v[5]); w.w = cvt_pk_bf16(v[6], v[7]);
                    if (!lora || c8 < 64) *(PG8_GAS u32x4*)(base + (size_t)row * ldc + c8) = w;
                }
            }
        if (do_km) {
#pragma unroll
            for (int bj = 0; bj < 2; ++bj)
#pragma unroll
                for (int j = 0; j < 8; ++j) {
                    float s = cs[bj][j];
                    s += __shfl_xor(s, 1); s += __shfl_xor(s, 2); s += __shfl_xor(s, 4); s += __shfl_xor(s, 8);
                    if (fr == 0) __hip_atomic_fetch_add(KM_ + u.pm * 256 + bj * HALF + wc * 32 + 8 * fq + j, s, __ATOMIC_RELAXED, __HIP_MEMORY_SCOPE_AGENT);
                }
        }
    }
};
struct EpiWout {
    static constexpr bool PERM = true, AFTER_DRAIN = false;
    const bf16_t* xin; bf16_t* xb; float* ssq_next;
    __device__ __forceinline__ void operator()(const f32x4 (&acc)[2][2][4][2], const Unit& u, int wr, int wc, int fr, int fq) const {
        const PG8_GAS bf16_t* xin_ = (const PG8_GAS bf16_t*)xin; PG8_GAS bf16_t* xb_ = (PG8_GAS bf16_t*)xb; PG8_GAS float* ssq_next_ = (PG8_GAS float*)ssq_next;
        asm volatile("" : "+s"(xin_), "+s"(xb_), "+s"(ssq_next_));
        const int rowb = u.pm * BM + wr * 64 + fr;
        u32x4 xv[2][4][2];
#pragma unroll
        for (int ai = 0; ai < 2; ++ai)
#pragma unroll
            for (int m = 0; m < 4; ++m)
#pragma unroll
                for (int bj = 0; bj < 2; ++bj) xv[ai][m][bj] = *(const PG8_GAS u32x4*)(xin_ + (size_t)(rowb + ai * HALF + m * 16) * 1024 + u.pn * BM + bj * HALF + wc * 32 + 8 * fq);
#pragma unroll
        for (int ai = 0; ai < 2; ++ai)
#pragma unroll
            for (int m = 0; m < 4; ++m) {
                const int row = rowb + ai * HALF + m * 16;
                float part = 0.f;
#pragma unroll
                for (int bj = 0; bj < 2; ++bj) {
                    const size_t off = (size_t)row * 1024 + u.pn * BM + bj * HALF + wc * 32 + 8 * fq;
                    const u32x4 xw = xv[ai][m][bj];
                    const f32x4 y0 = acc[ai][bj][m][0] + (f32x4){__uint_as_float(xw.x << 16), __uint_as_float(xw.x & 0xffff0000u), __uint_as_float(xw.y << 16), __uint_as_float(xw.y & 0xffff0000u)};
                    const f32x4 y1 = acc[ai][bj][m][1] + (f32x4){__uint_as_float(xw.z << 16), __uint_as_float(xw.z & 0xffff0000u), __uint_as_float(xw.w << 16), __uint_as_float(xw.w & 0xffff0000u)};
                    part += (y0[0] * y0[0] + y0[1] * y0[1]) + (y0[2] * y0[2] + y0[3] * y0[3]) + (y1[0] * y1[0] + y1[1] * y1[1]) + (y1[2] * y1[2] + y1[3] * y1[3]);
                    u32x4 w; w.x = cvt_pk_bf16(y0[0], y0[1]); w.y = cvt_pk_bf16(y0[2], y0[3]); w.z = cvt_pk_bf16(y1[0], y1[1]); w.w = cvt_pk_bf16(y1[2], y1[3]); *(PG8_GAS u32x4*)(xb_ + off) = w;
                }
                part += __shfl_xor(part, 16); part += __shfl_xor(part, 32);
                if (fq == 0) __hip_atomic_fetch_add(ssq_next_ + row, part, __ATOMIC_RELAXED, __HIP_MEMORY_SCOPE_AGENT);
            }
    }
};
struct EpiWoutFinal {
    static constexpr bool PERM = true, AFTER_DRAIN = true;
    const bf16_t* xin; float* out; float* part; unsigned* cnt; const float* fw; unsigned* tmo;
    __device__ __forceinline__ void fused(f32x4 (&acc)[2][2][4][2], const Unit& u, int wr, int wc, int fr, int fq, PG8_LAS unsigned char*, int wid, int lane) const {
        const PG8_GAS bf16_t* xin_ = (const PG8_GAS bf16_t*)xin; PG8_GAS float* out_ = (PG8_GAS float*)out; PG8_GAS float* part_ = (PG8_GAS float*)part; PG8_GAS unsigned* cnt_ = (PG8_GAS unsigned*)cnt;
        const PG8_GAS float* fw_ = (const PG8_GAS float*)fw; PG8_GAS unsigned* tmo_ = (PG8_GAS unsigned*)tmo;
        asm volatile("" : "+s"(xin_), "+s"(out_), "+s"(part_), "+s"(cnt_), "+s"(fw_), "+s"(tmo_));
        const int rowb = u.pm * BM + wr * 64 + fr;
#pragma unroll
        for (int ai = 0; ai < 2; ++ai) {
            u32x4 xv[4][2];
#pragma unroll
            for (int m = 0; m < 4; ++m)
#pragma unroll
                for (int bj = 0; bj < 2; ++bj) xv[m][bj] = *(const PG8_GAS u32x4*)(xin_ + (size_t)(rowb + ai * HALF + m * 16) * 1024 + u.pn * BM + bj * HALF + wc * 32 + 8 * fq);
#pragma unroll
            for (int m = 0; m < 4; ++m) {
                const int row = rowb + ai * HALF + m * 16; float ps = 0.f;
#pragma unroll
                for (int bj = 0; bj < 2; ++bj) {
                    const u32x4 xw = xv[m][bj];
                    acc[ai][bj][m][0] += (f32x4){__uint_as_float(xw.x << 16), __uint_as_float(xw.x & 0xffff0000u), __uint_as_float(xw.y << 16), __uint_as_float(xw.y & 0xffff0000u)};
                    acc[ai][bj][m][1] += (f32x4){__uint_as_float(xw.z << 16), __uint_as_float(xw.z & 0xffff0000u), __uint_as_float(xw.w << 16), __uint_as_float(xw.w & 0xffff0000u)};
                    const f32x4 y0 = acc[ai][bj][m][0], y1 = acc[ai][bj][m][1];
                    ps += (y0[0] * y0[0] + y0[1] * y0[1]) + (y0[2] * y0[2] + y0[3] * y0[3]) + (y1[0] * y1[0] + y1[1] * y1[1]) + (y1[2] * y1[2] + y1[3] * y1[3]);
                }
                ps += __shfl_xor(ps, 16); ps += __shfl_xor(ps, 32);
                if (fq == 0) __hip_atomic_store((PG8_GAS unsigned*)(part_ + (size_t)row * 16 + u.pn * 4 + wc), __float_as_uint(ps), __ATOMIC_RELAXED, __HIP_MEMORY_SCOPE_AGENT);
            }
        }
        asm volatile("s_waitcnt vmcnt(0)" ::: "memory");
        __syncthreads();
        if (wid == 0 && lane == 0) {
            __hip_atomic_fetch_add(cnt_ + 64 * u.pm, 1u, __ATOMIC_RELAXED, __HIP_MEMORY_SCOPE_AGENT);
            unsigned sp = 0;
            while (__hip_atomic_load(cnt_ + 64 * u.pm, __ATOMIC_RELAXED, __HIP_MEMORY_SCOPE_AGENT) < 4u) {
                __builtin_amdgcn_s_sleep(1);
                if ((++sp & 255u) == 0u) { if (__hip_atomic_load(tmo_, __ATOMIC_RELAXED, __HIP_MEMORY_SCOPE_AGENT) != 0u) break; if (sp > (1u << 20)) { __hip_atomic_store(tmo_, 1u, __ATOMIC_RELAXED, __HIP_MEMORY_SCOPE_AGENT); break; } }
            }
            __builtin_amdgcn_fence(__ATOMIC_ACQUIRE, "agent");
            asm volatile("s_waitcnt vmcnt(0)" ::: "memory");
        }
        __syncthreads();
        f32x4 wv[2][2];
#pragma unroll
        for (int bj = 0; bj < 2; ++bj) { const int col = u.pn * BM + bj * HALF + wc * 32 + 8 * fq; wv[bj][0] = *(const PG8_GAS f32x4*)(fw_ + col); wv[bj][1] = *(const PG8_GAS f32x4*)(fw_ + col + 4); }
#pragma unroll
        for (int ai = 0; ai < 2; ++ai)
#pragma unroll
            for (int m = 0; m < 4; ++m) {
                const int row = rowb + ai * HALF + m * 16;
                const PG8_GAS f32x4* sp4 = (const PG8_GAS f32x4*)(part_ + (size_t)row * 16); const f32x4 q0 = sp4[0], q1 = sp4[1], q2 = sp4[2], q3 = sp4[3];
                const float sq = ((q0[0] + q0[1]) + (q0[2] + q0[3])) + ((q1[0] + q1[1]) + (q1[2] + q1[3])) + ((q2[0] + q2[1]) + (q2[2] + q2[3])) + ((q3[0] + q3[1]) + (q3[2] + q3[3]));
                const float rs = rsqrtf(sq * (1.0f / 1024.0f) + 1e-6f);
#pragma unroll
                for (int bj = 0; bj < 2; ++bj) {
                    const size_t off = (size_t)row * 1024 + u.pn * BM + bj * HALF + wc * 32 + 8 * fq;
                    *(PG8_GAS f32x4*)(out_ + off) = acc[ai][bj][m][0] * rs * wv[bj][0]; *(PG8_GAS f32x4*)(out_ + off + 4) = acc[ai][bj][m][1] * rs * wv[bj][1];
                }
            }
    }
};
struct EpiNull {
    static constexpr bool PERM = true, AFTER_DRAIN = false;
    __device__ __forceinline__ void operator()(const f32x4 (&acc)[2][2][4][2], const Unit&, int, int, int, int) const {
#pragma unroll
        for (int ai = 0; ai < 2; ++ai)
#pragma unroll
            for (int bj = 0; bj < 2; ++bj)
#pragma unroll
                for (int m = 0; m < 4; ++m)
#pragma unroll
                    for (int n = 0; n < 2; ++n) asm volatile("" :: "v"(acc[ai][bj][m][n]));
    }
};
template <class Epi, class Sched, bool ALIGN_EPI = false, bool SP2 = false>
__device__ __forceinline__ void gemm_phase(PG8_LAS unsigned char* lds, const Gemm g, const Sched& S, const Epi& E, int tid_in) {
    int tid_ = tid_in; asm volatile("" : "+v"(tid_));
    const int tid = tid_, wid = __builtin_amdgcn_readfirstlane(tid >> 6), lane = tid & 63, wr = wid >> 2, wc = wid & 3, fr = lane & 15, fq = lane >> 4;
    const int K = g.K, nt = K / BK;
    unsigned voffA[2], voffB[2];
#pragma unroll
    for (int i = 0; i < 2; ++i) { int R, C; stage_rc(tid * 16 + i * 8192, R, C); const int Rb = Epi::PERM ? ((R & ~31) + perm32(R & 31)) : R;
        voffA[i] = (unsigned)(R * K + C) * 2u; voffB[i] = (unsigned)(Rb * K + C) * 2u; }
    const size_t kstep = (size_t)(BK * 2);
    const size_t hstep = (size_t)HALF * K * 2;
    const size_t tstep = 2 * hstep;
    const unsigned ldsw = (unsigned)wid * 1024u;
    const int aoff = lds_byte(wr * 64 + fr, fq * 8), boff = lds_byte(wc * 32 + fr, fq * 8);
#define PG8_SA(b, h) (((b) * 2 + (h)) * HTB)
#define PG8_SB(b, h) ((4 + (b) * 2 + (h)) * HTB)
#define PG8_STAGE(bufoff, gbase, voff) do { _Pragma("unroll") for (int _i = 0; _i < 2; ++_i) \
        __builtin_amdgcn_global_load_lds((const unsigned*)((const char*)(gbase) + (voff)[_i]), (PG8_LAS unsigned*)(lds + (bufoff) + ldsw + _i * 8192), 16, 0, 0); } while (0)
#define PG8_LDA(dst, b, h) do { _Pragma("unroll") for (int m = 0; m < 4; ++m) _Pragma("unroll") for (int k = 0; k < 2; ++k) dst[m][k] = *(const PG8_LAS bf16x8*)(lds + PG8_SA(b, h) + aoff + m * 2048 + k * 1024); } while (0)
#define PG8_LDB(dst, b, h) do { _Pragma("unroll") for (int n = 0; n < 2; ++n) _Pragma("unroll") for (int k = 0; k < 2; ++k) dst[n][k] = *(const PG8_LAS bf16x8*)(lds + PG8_SB(b, h) + boff + n * 2048 + k * 1024); } while (0)
#define PG8_MMA(ai, bj, At, Bt) do { __builtin_amdgcn_s_setprio(1); _Pragma("unroll") for (int m = 0; m < 4; ++m) _Pragma("unroll") for (int n = 0; n < 2; ++n) _Pragma("unroll") for (int k = 0; k < 2; ++k) \
        acc[ai][bj][m][n] = __builtin_amdgcn_mfma_f32_16x16x32_bf16(Bt[n][k], At[m][k], acc[ai][bj][m][n], 0, 0, 0); __builtin_amdgcn_s_setprio(0); } while (0)
#define PG8_WAIT_V(n) asm volatile("s_waitcnt vmcnt(" #n ")" ::: "memory")
#define PG8_WAIT_L(n) asm volatile("s_waitcnt lgkmcnt(" #n ")" ::: "memory")
#define PG8_BAR __builtin_amdgcn_s_barrier()
#define PG8_SCHED __builtin_amdgcn_sched_barrier(0)
    Unit cur, nxt; int ui = 0;
    if (!S.next(0, cur)) return;
    f32x4 acc[2][2][4][2];
#pragma unroll
    for (int a = 0; a < 2; ++a)
#pragma unroll
        for (int b = 0; b < 2; ++b)
#pragma unroll
            for (int m = 0; m < 4; ++m)
#pragma unroll
                for (int n = 0; n < 2; ++n) acc[a][b][m][n] = (f32x4){0.f, 0.f, 0.f, 0.f};
    bf16x8 At[4][2], B0[2][2], B1[2][2];
    const char* cA = (const char*)g.A + (size_t)cur.pm * tstep; const char* cB = (const char*)g.Bt + (size_t)cur.pn * tstep;
    S.a_ready(cur);
    if constexpr (SP2) {
        PG8_STAGE(PG8_SB(0, 0), cB, voffB); PG8_STAGE(PG8_SB(0, 1), cB + hstep, voffB); PG8_STAGE(PG8_SA(0, 0), cA, voffA); PG8_STAGE(PG8_SA(0, 1), cA + hstep, voffA);
        if (wr == 1) PG8_BAR;
        PG8_WAIT_V(2); PG8_BAR;
        PG8_STAGE(PG8_SB(1, 0), cB + kstep, voffB); PG8_STAGE(PG8_SA(1, 0), cA + kstep, voffA); PG8_STAGE(PG8_SB(1, 1), cB + hstep + kstep, voffB);
        PG8_WAIT_V(6); PG8_BAR;
    } else {
        PG8_STAGE(PG8_SB(0, 0), cB, voffB); PG8_STAGE(PG8_SA(0, 0), cA, voffA); PG8_STAGE(PG8_SB(0, 1), cB + hstep, voffB); PG8_STAGE(PG8_SA(0, 1), cA + hstep, voffA);
        if (wr == 1) PG8_BAR;
        PG8_WAIT_V(4); PG8_BAR;
        PG8_STAGE(PG8_SB(1, 0), cB + kstep, voffB); PG8_STAGE(PG8_SA(1, 0), cA + kstep, voffA); PG8_STAGE(PG8_SB(1, 1), cB + hstep + kstep, voffB);
        PG8_WAIT_V(6); PG8_BAR;
    }
    for (;;) {
        const bool has_next = S.next(ui + 1, nxt);
        const char* nA = has_next ? (const char*)g.A + (size_t)nxt.pm * tstep : cA; const char* nB = has_next ? (const char*)g.Bt + (size_t)nxt.pn * tstep : cB;
        for (int t = 0; t < nt; t += 2) {
            const bool last = (t == nt - 2);
            const char* a1 = cA + (size_t)(t + 1) * kstep;
            const char* a2 = last ? nA : cA + (size_t)(t + 2) * kstep; const char* b2 = last ? nB : cB + (size_t)(t + 2) * kstep;
            const char* a3 = a2 + kstep; const char* b3 = b2 + kstep;
            if (last && has_next) S.a_ready(nxt);
            if constexpr (SP2) {
            PG8_LDB(B0, 0, 0); PG8_LDB(B1, 0, 1); PG8_SCHED; PG8_LDA(At, 0, 0); PG8_STAGE(PG8_SA(1, 1), a1 + hstep, voffA);
            PG8_WAIT_V(8); PG8_WAIT_L(0); PG8_BAR; PG8_MMA(0, 0, At, B0); PG8_MMA(0, 1, At, B1); PG8_BAR; PG8_SCHED;
            PG8_LDA(At, 0, 1); PG8_STAGE(PG8_SB(0, 0), b2, voffB); PG8_STAGE(PG8_SB(0, 1), b2 + hstep, voffB); PG8_STAGE(PG8_SA(0, 0), a2, voffA);
            PG8_WAIT_V(8); PG8_WAIT_L(0); PG8_BAR; PG8_MMA(1, 0, At, B0); PG8_MMA(1, 1, At, B1); PG8_BAR; PG8_SCHED;
            PG8_LDB(B0, 1, 0); PG8_LDB(B1, 1, 1); PG8_SCHED; PG8_LDA(At, 1, 0); PG8_STAGE(PG8_SA(0, 1), a2 + hstep, voffA);
            PG8_WAIT_V(8); PG8_WAIT_L(0); PG8_BAR; PG8_MMA(0, 0, At, B0); PG8_MMA(0, 1, At, B1); PG8_BAR; PG8_SCHED;
            PG8_LDA(At, 1, 1); PG8_STAGE(PG8_SB(1, 0), b3, voffB); PG8_STAGE(PG8_SB(1, 1), b3 + hstep, voffB); PG8_STAGE(PG8_SA(1, 0), a3, voffA);
            PG8_WAIT_V(8); PG8_WAIT_L(0); PG8_BAR; PG8_MMA(1, 0, At, B0); PG8_MMA(1, 1, At, B1); PG8_BAR; PG8_SCHED;
            } else {
            PG8_LDB(B0, 0, 0); PG8_SCHED; PG8_LDA(At, 0, 0); PG8_STAGE(PG8_SA(1, 1), a1 + hstep, voffA);
            PG8_WAIT_L(8); PG8_BAR; PG8_WAIT_L(0); PG8_MMA(0, 0, At, B0); PG8_BAR; PG8_SCHED;
            PG8_LDB(B1, 0, 1); PG8_STAGE(PG8_SB(0, 0), b2, voffB);
            PG8_BAR; PG8_WAIT_L(0); PG8_MMA(0, 1, At, B1); PG8_BAR;
            PG8_LDA(At, 0, 1); PG8_STAGE(PG8_SA(0, 0), a2, voffA);
            PG8_BAR; PG8_WAIT_L(0); PG8_MMA(1, 0, At, B0); PG8_BAR; PG8_SCHED;
            PG8_STAGE(PG8_SB(0, 1), b2 + hstep, voffB);
            PG8_WAIT_V(6); PG8_BAR; PG8_MMA(1, 1, At, B1); PG8_BAR;
            PG8_LDB(B0, 1, 0); PG8_SCHED; PG8_LDA(At, 1, 0); PG8_STAGE(PG8_SA(0, 1), a2 + hstep, voffA);
            PG8_WAIT_L(8); PG8_BAR; PG8_WAIT_L(0); PG8_MMA(0, 0, At, B0); PG8_BAR; PG8_SCHED;
            PG8_LDB(B1, 1, 1); PG8_STAGE(PG8_SB(1, 0), b3, voffB);
            PG8_BAR; PG8_WAIT_L(0); PG8_MMA(0, 1, At, B1); PG8_BAR;
            PG8_LDA(At, 1, 1); PG8_STAGE(PG8_SA(1, 0), a3, voffA);
            PG8_BAR; PG8_WAIT_L(0); PG8_MMA(1, 0, At, B0); PG8_BAR; PG8_SCHED;
            PG8_STAGE(PG8_SB(1, 1), b3 + hstep, voffB);
            PG8_WAIT_V(6); PG8_BAR; PG8_MMA(1, 1, At, B1); PG8_BAR;
            }
        }
        if constexpr (ALIGN_EPI) { if (wr == 0) PG8_BAR; }
        if constexpr (!Epi::AFTER_DRAIN) { E(acc, cur, wr, wc, fr, fq); S.done(cur); }
        if (!has_next) break;
#pragma unroll
        for (int a = 0; a < 2; ++a)
#pragma unroll
            for (int b = 0; b < 2; ++b)
#pragma unroll
                for (int m = 0; m < 4; ++m)
#pragma unroll
                    for (int n = 0; n < 2; ++n) acc[a][b][m][n] = (f32x4){0.f, 0.f, 0.f, 0.f};
        cur = nxt; cA = nA; cB = nB; ++ui;
        if constexpr (ALIGN_EPI) { if (wr == 1) PG8_BAR; }
    }
    PG8_WAIT_V(0);
    if constexpr (!ALIGN_EPI) { if (wr == 0) PG8_BAR; }
    PG8_BAR;
    if constexpr (Epi::AFTER_DRAIN) { E.fused(acc, cur, wr, wc, fr, fq, lds, wid, lane); S.done(cur); }
#undef PG8_SA
#undef PG8_SB
#undef PG8_STAGE
#undef PG8_LDA
#undef PG8_LDB
#undef PG8_MMA
#undef PG8_WAIT_V
#undef PG8_WAIT_L
#undef PG8_BAR
#undef PG8_SCHED
}
}
#ifndef PG8_SP2
#define PG8_SP2 true
#endif
#ifndef PG8_ALIGN
#define PG8_ALIGN true
#endif
#ifndef PROBE_DUP
#define PROBE_DUP 0
#endif
#ifndef ATT_STAGGER
#define ATT_STAGGER 2
#endif
#ifndef PROBE_R1
#define PROBE_R1 0
#endif
#ifndef PROBE_ATT
#define PROBE_ATT 0
#endif
#ifndef MK_N_LAUNCHES
#define MK_N_LAUNCHES 1
#endif

constexpr int NWAVES = 8;
constexpr int BATCH = 8, T = 2048, D = 1024, M = BATCH * T, DEPTH = 2;
constexpr int GW = 256, NH = 4, HD = 64, LORA = 32;
constexpr int WCOLS = 4160, NPAD = 4352, NMAIN = 4096;
constexpr int N_PHASES = 7;
constexpr int N_LAUNCHES = MK_N_LAUNCHES;

constexpr size_t MiB = 1u << 20;
constexpr size_t WS_CTL = 0, CTL_ZERO_BYTES = 1 * MiB;
constexpr size_t CTL_KM = 131072;
constexpr size_t CTL_SSQ = 262144;
constexpr size_t CTL_Q = 65536;
constexpr size_t WS_TAB = 1 * MiB;
constexpr size_t TAB_SIN = 262144, TAB_LUT = 524288, TAB_THR = 528384, TAB_LUT2 = 532480;
constexpr size_t WS_WIN = 2 * MiB;
constexpr size_t WS_WOUT = 19 * MiB;
constexpr size_t WS_XA = 23 * MiB;
constexpr size_t WS_XB = 55 * MiB;
constexpr size_t WS_PB = 87 * MiB;
constexpr size_t WS_R1 = 217 * MiB;
constexpr size_t WS_YRAW = 233 * MiB;
constexpr size_t WS_SB = 249 * MiB;
constexpr size_t WS_SSQP = 250 * MiB;
constexpr size_t WS_END = 253 * MiB;
constexpr size_t PANEL = (size_t)M * 256;
constexpr int CW_BAR = 4096;

constexpr int RING_OFF = 0, RING_BYTES = 131072;
constexpr int LDSCTL_OFF = RING_BYTES, MISC_OFF = LDSCTL_OFF + 320;
constexpr int LDS_BYTES = 147456;

#define GAS __attribute__((address_space(1)))
#define LAS __attribute__((address_space(3)))
typedef unsigned short bf16;
typedef unsigned v4u __attribute__((ext_vector_type(4)));
typedef unsigned v2u __attribute__((ext_vector_type(2)));
typedef float f32x4 __attribute__((ext_vector_type(4)));
typedef GAS unsigned gu32;
#define RLX_AGENT __ATOMIC_RELAXED, __HIP_MEMORY_SCOPE_AGENT
#define LDS_WAIT() asm volatile("s_waitcnt lgkmcnt(0)" ::: "memory")
__device__ __forceinline__ float bf2f(unsigned b) { return __uint_as_float(b << 16); }
__device__ __forceinline__ unsigned f2bf(float f) { unsigned u = __float_as_uint(f); return (u + 0x7fffu + ((u >> 16) & 1u)) >> 16; }
__device__ __forceinline__ unsigned pk2(float lo, float hi) { return f2bf(lo) | (f2bf(hi) << 16); }
__device__ __forceinline__ float sigmoidf_(float x) { return __builtin_amdgcn_rcpf(1.0f + __expf(-x)); }
__device__ __forceinline__ float wave_sum(float v) {
#pragma unroll
    for (int o = 1; o < 64; o <<= 1) v += __shfl_xor(v, o);
    return v;
}
__device__ __forceinline__ void unpack8(const v4u w, float* f) {
    f[0] = bf2f(w.x & 0xffffu); f[1] = bf2f(w.x >> 16); f[2] = bf2f(w.y & 0xffffu); f[3] = bf2f(w.y >> 16);
    f[4] = bf2f(w.z & 0xffffu); f[5] = bf2f(w.z >> 16); f[6] = bf2f(w.w & 0xffffu); f[7] = bf2f(w.w >> 16);
}

__constant__ double THETA_D[32] = {1.0, 0.7429639507594948, 0.551995432128157, 0.4101127070551301, 0.30469895709035083, 0.22638034095214485, 0.168192432488087, 0.12496091412919871,
    0.09284145445194746, 0.06897785379387658, 0.05124805876960934, 0.03807546021222372, 0.028288694346259694, 0.021017480113324893, 0.015615230060004972, 0.011601553017399716,
    0.008619535664753031, 0.006404004271197283, 0.004757944314009414, 0.0035349811050301057, 0.0026263635276533325, 0.0019512934226359642, 0.0014497406703726315, 0.001077105056036769,
    0.0008002502278161054, 0.0005945570708544394, 0.0004417344703140073, 0.0003281927872511474, 0.00024383540982688293, 0.00018116091942004152, 0.00013459603241553644, 0.0001};


typedef GAS bf16 gbf; typedef GAS float gf32; typedef GAS unsigned char gu8; typedef GAS v4u gv4u; typedef GAS v2u gv2u; typedef GAS f32x4 gf32x4;
struct Args { const float* in[17]; float* out; unsigned char* ws; int ph_lo, ph_hi, li, pad; };
struct DArgs { const gf32* in[17]; gf32* out; gu8* ws; };
#define XB_TMO      128
#define XB_XCNT(j)  (256  + 64 * (j))
#define XB_XSUB(j)  (1280 + 64 * (j))
#define XB_XGEN(j)  (2304 + 64 * (j))
#define XB_TOP      3328
#define XB_TOPGEN   3392
#define XCD_BAR_WORDS 3456
#define XB_SPIN_CAP (1u << 18)

__device__ __forceinline__ unsigned xb_ld(unsigned* p)              { return __hip_atomic_load(p, __ATOMIC_RELAXED, __HIP_MEMORY_SCOPE_AGENT); }
__device__ __forceinline__ unsigned xb_add(unsigned* p, unsigned v) { return __hip_atomic_fetch_add(p, v, __ATOMIC_RELAXED, __HIP_MEMORY_SCOPE_AGENT); }
__device__ __forceinline__ unsigned xb_xcc_id() { return (unsigned)__builtin_amdgcn_s_getreg((3 << 11) | 20) & 0xFu; }
#define XB_SPIN(cond, bar) do { unsigned _sp = 0; while (cond) { __builtin_amdgcn_s_sleep(1); \
    if ((++_sp & 255u) == 0u) { if (xb_ld(&(bar)[XB_TMO])) break; if (_sp > XB_SPIN_CAP) { atomicAdd(&(bar)[XB_TMO], 1u); break; } } } } while (0)

struct XcdBarrier {
    unsigned* bar; unsigned x;
    volatile LAS unsigned* st;
};

__device__ __forceinline__ XcdBarrier xcd_barrier_post(unsigned* bar, volatile LAS unsigned* st) {
    XcdBarrier b; b.bar = bar; b.x = xb_xcc_id(); b.st = st;
    if (threadIdx.x == 0) (void)xb_add(&bar[XB_XCNT(b.x)], 1u);
    return b;
}
__device__ __forceinline__ void xcd_barrier_complete(unsigned* bar, unsigned x, unsigned& nloc, unsigned& nx) {
    const unsigned G = gridDim.x * gridDim.y * gridDim.z;
    unsigned sum, cnt, mine, sp = 0u;
    for (;;) {
        sum = 0u; cnt = 0u; mine = 0u;
#pragma unroll
        for (unsigned j = 0; j < 16; ++j) { const unsigned c = xb_ld(&bar[XB_XCNT(j)]); sum += c; cnt += (c > 0u) ? 1u : 0u; mine = (j == x) ? c : mine; }
        if (sum == G) break;
        __builtin_amdgcn_s_sleep(1);
        if ((++sp & 255u) == 0u) { if (xb_ld(&bar[XB_TMO])) break; if (sp > XB_SPIN_CAP) { atomicAdd(&bar[XB_TMO], 1u); break; } }
    }
    nloc = mine > 0u ? mine : 1u; nx = cnt > 0u ? cnt : 1u;
}

__device__ __forceinline__ void xcd_barrier(const XcdBarrier& b) {
    asm volatile("s_waitcnt vmcnt(0)" ::: "memory");
    __syncthreads();
    if (threadIdx.x == 0) {
        unsigned* bar = b.bar;
        __builtin_amdgcn_s_waitcnt(0);
        unsigned nloc = b.st[0], nx = b.st[1];
        if (nloc == 0u) { xcd_barrier_complete(bar, b.x, nloc, nx); b.st[0] = nloc; b.st[1] = nx; }
        const unsigned old = xb_add(&bar[XB_XSUB(b.x)], 1u);
        const unsigned gen = old / nloc;
        if (old + 1u == (gen + 1u) * nloc) {
            __builtin_amdgcn_fence(__ATOMIC_RELEASE, "agent");
            asm volatile("s_waitcnt vmcnt(0)" ::: "memory");
            const unsigned og = xb_add(&bar[XB_TOP], 1u);
            const unsigned tg = og / nx;
            if (og + 1u == (tg + 1u) * nx) xb_add(&bar[XB_TOPGEN], 1u);
            else XB_SPIN(xb_ld(&bar[XB_TOPGEN]) == tg, bar);
            __builtin_amdgcn_fence(__ATOMIC_ACQUIRE, "agent");
            xb_add(&bar[XB_XGEN(b.x)], 1u);
            asm volatile("s_waitcnt vmcnt(0)" ::: "memory");
        } else {
            XB_SPIN(xb_ld(&bar[XB_XGEN(b.x)]) == gen, bar);
            __builtin_amdgcn_fence(__ATOMIC_ACQUIRE, "agent");
            asm volatile("s_waitcnt vmcnt(0)" ::: "memory");
        }
    }
    __syncthreads();
}
typedef short bf16x8 __attribute__((ext_vector_type(8)));
typedef short s16x4 __attribute__((ext_vector_type(4)));
typedef short v4i16_t __attribute__((ext_vector_type(4)));
typedef float f32x16 __attribute__((ext_vector_type(16)));
typedef GAS bf16x8 gbf16x8;
constexpr int AT_NS = 4;
constexpr int AT_K = 0, AT_V = AT_NS * 8192, AT_LUT = 2 * AT_NS * 8192, AT_SEL = AT_LUT + 512, AT_BYTES = AT_SEL + 2048;
constexpr float LOG2E = 1.4426950408889634f;

__device__ __forceinline__ void glds16(const GAS void* gsrc, unsigned lds_dst) { unsigned keep;
    asm volatile("s_mov_b32 %0, m0\n\ts_mov_b32 m0, %2\n\ts_nop 0\n\tglobal_load_lds_dwordx4 %1, off\n\ts_mov_b32 m0, %0" : "=&s"(keep) : "v"(gsrc), "s"(lds_dst) : "memory"); }
#define AT_WAIT_BAR() asm volatile("s_waitcnt vmcnt(0) lgkmcnt(0)\n\ts_barrier" ::: "memory")
#define AT_WAIT_BAR_N(N) asm volatile("s_waitcnt vmcnt(" #N ") lgkmcnt(0)\n\ts_barrier" ::: "memory")
__device__ __forceinline__ s16x4 vtr(const LAS unsigned char* p) { return __builtin_bit_cast(s16x4, __builtin_amdgcn_ds_read_tr16_b64_v4i16((LAS v4i16_t*)p)); }
typedef float f32x2_t __attribute__((ext_vector_type(2))); typedef __bf16 bf16x2_t __attribute__((ext_vector_type(2)));
__device__ __forceinline__ unsigned cvtpk(float lo, float hi) { f32x2_t v = {lo, hi}; bf16x2_t b = __builtin_convertvector(v, bf16x2_t); return __builtin_bit_cast(unsigned, b); }
__device__ __forceinline__ float ex2(float x) { return __builtin_amdgcn_exp2f(x); }

constexpr float AT_THR = 6.0f;
template <int MODE, int PROBE = 0>
__device__ __forceinline__ void attn_unit(const gbf* Pq, const gbf* Pk, const gbf* Pv, const gbf* Pg, gbf* Y, int ycol, int b, int h, int qb,
                                          const gf32* KMl, const gf32* lut, LAS unsigned char* lds, int wave, int lane) {
    const int r32 = lane & 31, h2 = lane >> 5;
    const int q_abs = qb * 256 + wave * 32 + r32; const size_t qrow = (size_t)(b * T + q_abs);
    const unsigned lds0 = (unsigned)(uintptr_t)lds;
    const int NT = 4 * (qb + 1);
    const gbf* ksrc = Pk + (size_t)(b * T + lane) * 256 + h * 64 + wave * 8;
    const gbf* vsrc = Pv + (size_t)(b * T + 16 * (wave & 3) + (lane >> 2)) * 256 + h * 64 + (wave >> 2) * 32 + (lane & 3) * 8;
#define AT_DMA(t, buf) do { glds16(ksrc + (size_t)(t) * 64 * 256, (unsigned)__builtin_amdgcn_readfirstlane(lds0 + AT_K + (buf) * 8192 + wave * 1024)); \
                            glds16(vsrc + (size_t)(t) * 64 * 256, (unsigned)__builtin_amdgcn_readfirstlane(lds0 + AT_V + (buf) * 8192 + wave * 1024)); } while (0)
    if (PROBE != 2 && PROBE != 3) { AT_DMA(0, 0); AT_DMA(1, 1); AT_DMA(2, 2); }
    bf16x8 qf[4];
#pragma unroll
    for (int ks = 0; ks < 4; ++ks) qf[ks] = *(const gbf16x8*)(Pq + qrow * 256 + h * 64 + 16 * ks + 8 * h2);
    LAS float* lutL = (LAS float*)(lds + AT_LUT);
    unsigned sel = 0u;
    if (MODE == 0) {
        if (wave == 0) { const float c31 = lut[h * 128 + 127]; lutL[lane] = (lut[h * 128 + lane] - c31) * LOG2E; lutL[64 + lane] = (lut[h * 128 + 64 + lane] - c31) * LOG2E; }
        if (qb <= 3) sel = (1u << qb) - 1u;
        else {
            f32x16 gacc;
#pragma unroll
            for (int r = 0; r < 16; ++r) gacc[r] = 0.f;
            const gf32* km = KMl + (b * 8 + (r32 & 7)) * 256 + h * 64 + 8 * h2;
#pragma unroll
            for (int ks = 0; ks < 4; ++ks) {
                const f32x4 ka = *(const gf32x4*)(km + 16 * ks), kb = *(const gf32x4*)(km + 16 * ks + 4);
                v4u w; w.x = cvtpk(ka[0], ka[1]); w.y = cvtpk(ka[2], ka[3]); w.z = cvtpk(kb[0], kb[1]); w.w = cvtpk(kb[2], kb[3]);
                gacc = __builtin_amdgcn_mfma_f32_32x32x16_bf16(__builtin_bit_cast(bf16x8, w), qf[ks], gacc, 0, 0, 0);
            }
            float gv[8];
#pragma unroll
            for (int e = 0; e < 4; ++e) { const float mine = gacc[e], other = __shfl_xor(mine, 32); gv[e] = h2 ? other : mine; gv[4 + e] = h2 ? mine : other; }
            float g0 = -INFINITY, g1 = -INFINITY, g2 = -INFINITY; int i0 = 0, i1 = 0, i2 = 0;
#pragma unroll
            for (int n = 0; n < 8; ++n) {
                const float g = (n < qb) ? gv[n] : -INFINITY;
                if (g > g0) { g2 = g1; i2 = i1; g1 = g0; i1 = i0; g0 = g; i0 = n; }
                else if (g > g1) { g2 = g1; i2 = i1; g1 = g; i1 = n; }
                else if (g > g2) { g2 = g; i2 = n; }
            }
            sel = (1u << i0) | (1u << i1) | (1u << i2);
        }
    }
    const float g64 = (MODE == 1) ? ex2(64.0f * log2f(1.0f - ex2(-5.0f - (float)h))) : 1.0f;
    AT_WAIT_BAR_N(4);
    float m_run = 0.f, l_run = 0.f; f32x16 o0, o1, cinit;
#pragma unroll
    for (int r = 0; r < 16; ++r) { o0[r] = 0.f; o1[r] = 0.f; cinit[r] = 0.f; }
    for (int t = 0; t < NT; ++t) {
        const int cur = t & (AT_NS - 1);
        if (PROBE != 2 && PROBE != 3 && t + 3 < NT) AT_DMA(t + 3, (t + 3) & (AT_NS - 1));
        const int nb = t >> 2; const bool own = (nb == qb);
        const bool active = !own || ((t & 3) * 64 <= wave * 32 + 31);
        if (active && PROBE != 1) {
            if (MODE == 0 && (t & 3) == 0) {
                const float cv = (own || ((sel >> nb) & 1u)) ? -m_run : -1e30f;
#pragma unroll
                for (int r = 0; r < 16; ++r) cinit[r] = cv;
            }
            f32x16 s0 = cinit, s1 = cinit;
            const LAS unsigned char* kb = lds + AT_K + cur * 8192 + h2 * 1024 + r32 * 16;
#pragma unroll
            for (int ks = 0; ks < 4; ++ks) {
                const bf16x8 a0 = *(const LAS bf16x8*)(kb + ks * 2048), a1 = *(const LAS bf16x8*)(kb + ks * 2048 + 512);
                s0 = __builtin_amdgcn_mfma_f32_32x32x16_bf16(a0, qf[ks], s0, 0, 0, 0);
                s1 = __builtin_amdgcn_mfma_f32_32x32x16_bf16(a1, qf[ks], s1, 0, 0, 0);
            }
            const int dq = q_abs - (t * 64 + 4 * h2);
            if (PROBE == 3) {   } else if (MODE == 0) {
                const bool near = own || (qb * 256 + wave * 32 - (t * 64 + 63) < 113);
                if (near) {
#pragma unroll
                    for (int r = 0; r < 16; ++r) {
                        const int d0 = dq - ((r & 3) + 8 * (r >> 2)), d1 = d0 - 32;
                        const float b0 = lutL[min(max(d0, 0), 127)], b1 = lutL[min(max(d1, 0), 127)];
                        s0[r] = d0 >= 0 ? s0[r] + b0 : -1e30f;
                        s1[r] = d1 >= 0 ? s1[r] + b1 : -1e30f;
                    }
                }
                float mx = fmaxf(fmaxf(s0[0], s0[1]), fmaxf(s1[0], s1[1]));
#pragma unroll
                for (int r = 2; r < 16; r += 2) mx = fmaxf(mx, fmaxf(fmaxf(s0[r], s0[r + 1]), fmaxf(s1[r], s1[r + 1])));
                mx = fmaxf(mx, __shfl_xor(mx, 32));
                if (__any(mx > AT_THR)) {
                    const float dl = fmaxf(mx, 0.f), alpha = ex2(-dl); m_run += dl; l_run *= alpha;
#pragma unroll
                    for (int r = 0; r < 16; ++r) { s0[r] -= dl; s1[r] -= dl; o0[r] *= alpha; o1[r] *= alpha; cinit[r] -= dl; }
                }
                float ps = 0.f;
#pragma unroll
                for (int r = 0; r < 16; ++r) { s0[r] = ex2(s0[r]); s1[r] = ex2(s1[r]); ps += s0[r] + s1[r]; }
                l_run += ps;
            } else {
                if (t == qb * 4 + (wave >> 1)) {
#pragma unroll
                    for (int r = 0; r < 16; ++r) {
                        const int d0 = dq - ((r & 3) + 8 * (r >> 2)), d1 = d0 - 32;
                        s0[r] = d0 >= 0 ? s0[r] : 0.f; s1[r] = d1 >= 0 ? s1[r] : 0.f;
                    }
                }
#pragma unroll
                for (int r = 0; r < 16; ++r) { o0[r] *= g64; o1[r] *= g64; }
            }
            bf16x8 pf[4];
#pragma unroll
            for (int s = 0; s < 2; ++s) {
                v4u w0, w1;
                w0.x = cvtpk(s0[8 * s + 0], s0[8 * s + 1]); w0.y = cvtpk(s0[8 * s + 2], s0[8 * s + 3]); w0.z = cvtpk(s0[8 * s + 4], s0[8 * s + 5]); w0.w = cvtpk(s0[8 * s + 6], s0[8 * s + 7]);
                w1.x = cvtpk(s1[8 * s + 0], s1[8 * s + 1]); w1.y = cvtpk(s1[8 * s + 2], s1[8 * s + 3]); w1.z = cvtpk(s1[8 * s + 4], s1[8 * s + 5]); w1.w = cvtpk(s1[8 * s + 6], s1[8 * s + 7]);
                pf[s] = __builtin_bit_cast(bf16x8, w0); pf[2 + s] = __builtin_bit_cast(bf16x8, w1);
            }
            const LAS unsigned char* vb = lds + AT_V + cur * 8192 + ((lane >> 4) & 1) * 32 + (lane & 3) * 8 + (4 * h2 + ((lane & 15) >> 2)) * 64;
#pragma unroll
            for (int kk = 0; kk < 4; ++kk) {
                const s16x4 lo0 = vtr(vb + kk * 1024), hi0 = vtr(vb + kk * 1024 + 512), lo1 = vtr(vb + 4096 + kk * 1024), hi1 = vtr(vb + 4096 + kk * 1024 + 512);
                const bf16x8 v0 = (bf16x8){lo0[0], lo0[1], lo0[2], lo0[3], hi0[0], hi0[1], hi0[2], hi0[3]};
                const bf16x8 v1 = (bf16x8){lo1[0], lo1[1], lo1[2], lo1[3], hi1[0], hi1[1], hi1[2], hi1[3]};
                o0 = __builtin_amdgcn_mfma_f32_32x32x16_bf16(v0, pf[kk], o0, 0, 0, 0);
                o1 = __builtin_amdgcn_mfma_f32_32x32x16_bf16(v1, pf[kk], o1, 0, 0, 0);
            }
        }
        if (t + 3 < NT) AT_WAIT_BAR_N(4); else if (t + 3 == NT) AT_WAIT_BAR_N(2); else AT_WAIT_BAR();
    }
#undef AT_DMA
    if (PROBE != 0) { float sink = l_run + o0[0] + o1[3]; asm volatile("" :: "v"(sink)); return; }
    float scale;
    if (MODE == 0) { const float l = l_run + __shfl_xor(l_run, 32); scale = 1.0f / l; }
    else { float ss = 0.f;
#pragma unroll
        for (int r = 0; r < 16; ++r) ss += o0[r] * o0[r] + o1[r] * o1[r];
        ss += __shfl_xor(ss, 32); scale = rsqrtf(ss * (1.0f / 64.0f) + 1e-6f); }
#pragma unroll
    for (int g = 0; g < 4; ++g) {
        const int d0 = 8 * g + 4 * h2;
        const v2u g0 = *(const gv2u*)(Pg + qrow * 256 + h * 64 + d0), g1 = *(const gv2u*)(Pg + qrow * 256 + h * 64 + 32 + d0);
        v2u w0, w1;
        w0.x = cvtpk(o0[4 * g] * scale * bf2f(g0.x & 0xffffu), o0[4 * g + 1] * scale * bf2f(g0.x >> 16)); w0.y = cvtpk(o0[4 * g + 2] * scale * bf2f(g0.y & 0xffffu), o0[4 * g + 3] * scale * bf2f(g0.y >> 16));
        w1.x = cvtpk(o1[4 * g] * scale * bf2f(g1.x & 0xffffu), o1[4 * g + 1] * scale * bf2f(g1.x >> 16)); w1.y = cvtpk(o1[4 * g + 2] * scale * bf2f(g1.y & 0xffffu), o1[4 * g + 3] * scale * bf2f(g1.y >> 16));
        *(gv2u*)(Y + qrow * D + ycol + h * 64 + d0) = w0; *(gv2u*)(Y + qrow * D + ycol + h * 64 + 32 + d0) = w1;
    }
}

template <int MODE>
__device__ __forceinline__ void attn_unit_stg(const gbf* Pq, const gbf* Pk, const gbf* Pv, const gbf* Pg, gbf* Y, int ycol, int b, int h, int qb,
                                              const gf32* KMl, const gf32* lut, LAS unsigned char* lds, int wave, int lane) {
    const int r32 = lane & 31, h2 = lane >> 5, grp = wave >> 2;
    const int q_abs = qb * 256 + wave * 32 + r32; const size_t qrow = (size_t)(b * T + q_abs);
    const unsigned lds0 = (unsigned)(uintptr_t)lds;
    const int NT = 4 * (qb + 1);
    const gbf* ksrc = Pk + (size_t)(b * T + lane) * 256 + h * 64 + wave * 8;
    const gbf* vsrc = Pv + (size_t)(b * T + 16 * (wave & 3) + (lane >> 2)) * 256 + h * 64 + (wave >> 2) * 32 + (lane & 3) * 8;
#define AT_DMA(t, buf) do { glds16(ksrc + (size_t)(t) * 64 * 256, (unsigned)__builtin_amdgcn_readfirstlane(lds0 + AT_K + (buf) * 8192 + wave * 1024)); \
                            glds16(vsrc + (size_t)(t) * 64 * 256, (unsigned)__builtin_amdgcn_readfirstlane(lds0 + AT_V + (buf) * 8192 + wave * 1024)); } while (0)
    AT_DMA(0, 0); AT_DMA(1, 1);
    bf16x8 qf[4];
#pragma unroll
    for (int ks = 0; ks < 4; ++ks) qf[ks] = *(const gbf16x8*)(Pq + qrow * 256 + h * 64 + 16 * ks + 8 * h2);
    LAS float* lutL = (LAS float*)(lds + AT_LUT);
    unsigned sel = 0u;
    if (MODE == 0) {
        if (wave == 0) { const float c31 = lut[h * 128 + 127]; lutL[lane] = (lut[h * 128 + lane] - c31) * LOG2E; lutL[64 + lane] = (lut[h * 128 + 64 + lane] - c31) * LOG2E; }
        if (qb <= 3) sel = (1u << qb) - 1u;
        else {
            f32x16 gacc;
#pragma unroll
            for (int r = 0; r < 16; ++r) gacc[r] = 0.f;
            const gf32* km = KMl + (b * 8 + (r32 & 7)) * 256 + h * 64 + 8 * h2;
#pragma unroll
            for (int ks = 0; ks < 4; ++ks) {
                const f32x4 ka = *(const gf32x4*)(km + 16 * ks), kb = *(const gf32x4*)(km + 16 * ks + 4);
                v4u w; w.x = cvtpk(ka[0], ka[1]); w.y = cvtpk(ka[2], ka[3]); w.z = cvtpk(kb[0], kb[1]); w.w = cvtpk(kb[2], kb[3]);
                gacc = __builtin_amdgcn_mfma_f32_32x32x16_bf16(__builtin_bit_cast(bf16x8, w), qf[ks], gacc, 0, 0, 0);
            }
            float gv[8];
#pragma unroll
            for (int e = 0; e < 4; ++e) { const float mine = gacc[e], other = __shfl_xor(mine, 32); gv[e] = h2 ? other : mine; gv[4 + e] = h2 ? mine : other; }
            float g0 = -INFINITY, g1 = -INFINITY, g2 = -INFINITY; int i0 = 0, i1 = 0, i2 = 0;
#pragma unroll
            for (int n = 0; n < 8; ++n) {
                const float g = (n < qb) ? gv[n] : -INFINITY;
                if (g > g0) { g2 = g1; i2 = i1; g1 = g0; i1 = i0; g0 = g; i0 = n; }
                else if (g > g1) { g2 = g1; i2 = i1; g1 = g; i1 = n; }
                else if (g > g2) { g2 = g; i2 = n; }
            }
            sel = (1u << i0) | (1u << i1) | (1u << i2);
        }
    }
    LAS unsigned* selL = (LAS unsigned*)(lds + AT_SEL) + wave * 64 + lane;
    if (MODE == 0) *selL = sel;
    const float g64 = (MODE == 1) ? ex2(64.0f * log2f(1.0f - ex2(-5.0f - (float)h))) : 1.0f;
    AT_WAIT_BAR_N(2);
    float m_run = 0.f, l_run = 0.f; f32x16 o0, o1, cinit, s0, s1; bf16x8 pf[4];
#pragma unroll
    for (int r = 0; r < 16; ++r) { o0[r] = 0.f; o1[r] = 0.f; cinit[r] = 0.f; s0[r] = 0.f; s1[r] = 0.f; }
#pragma unroll
    for (int k = 0; k < 4; ++k) pf[k] = (bf16x8){0, 0, 0, 0, 0, 0, 0, 0};
#define AT_ACT(i_) (((i_) >> 2) != qb || ((i_) & 3) * 64 <= wave * 32 + 31)
    for (int ph = 0; ph < 2 * NT + 2; ++ph) {
        if (!(ph & 1)) { const int j = (ph >> 1) + 2; if (j < NT) AT_DMA(j, j & (AT_NS - 1)); }
        const int lp = ph - grp;
        if (lp >= 0 && lp <= 2 * NT) {
            const int i = lp >> 1;
            if (!(lp & 1)) {
                if (i >= 1 && AT_ACT(i - 1)) {
                    const LAS unsigned char* vb = lds + AT_V + ((i - 1) & (AT_NS - 1)) * 8192 + ((lane >> 4) & 1) * 32 + (lane & 3) * 8 + (4 * h2 + ((lane & 15) >> 2)) * 64;
#pragma unroll
                    for (int kk = 0; kk < 4; ++kk) {
                        const s16x4 lo0 = vtr(vb + kk * 1024), hi0 = vtr(vb + kk * 1024 + 512), lo1 = vtr(vb + 4096 + kk * 1024), hi1 = vtr(vb + 4096 + kk * 1024 + 512);
                        const bf16x8 v0 = (bf16x8){lo0[0], lo0[1], lo0[2], lo0[3], hi0[0], hi0[1], hi0[2], hi0[3]};
                        const bf16x8 v1 = (bf16x8){lo1[0], lo1[1], lo1[2], lo1[3], hi1[0], hi1[1], hi1[2], hi1[3]};
                        o0 = __builtin_amdgcn_mfma_f32_32x32x16_bf16(v0, pf[kk], o0, 0, 0, 0);
                        o1 = __builtin_amdgcn_mfma_f32_32x32x16_bf16(v1, pf[kk], o1, 0, 0, 0);
                    }
                }
                if (i < NT && AT_ACT(i)) {
                    if (MODE == 0 && (i & 3) == 0) {
                        const int nb = i >> 2; const float cv = (nb == qb || ((*selL >> nb) & 1u)) ? -m_run : -1e30f;
#pragma unroll
                        for (int r = 0; r < 16; ++r) cinit[r] = cv;
                    }
                    s0 = cinit; s1 = cinit;
                    const LAS unsigned char* kb = lds + AT_K + (i & (AT_NS - 1)) * 8192 + h2 * 1024 + r32 * 16;
#pragma unroll
                    for (int ks = 0; ks < 4; ++ks) {
                        const bf16x8 a0 = *(const LAS bf16x8*)(kb + ks * 2048), a1 = *(const LAS bf16x8*)(kb + ks * 2048 + 512);
                        s0 = __builtin_amdgcn_mfma_f32_32x32x16_bf16(a0, qf[ks], s0, 0, 0, 0);
                        s1 = __builtin_amdgcn_mfma_f32_32x32x16_bf16(a1, qf[ks], s1, 0, 0, 0);
                    }
                }
            } else if (AT_ACT(i)) {
                const bool own = ((i >> 2) == qb);
                const int dq = q_abs - (i * 64 + 4 * h2);
                if (MODE == 0) {
                    const bool near = own || (qb * 256 + wave * 32 - (i * 64 + 63) < 113);
                    if (near) {
#pragma unroll
                        for (int r = 0; r < 16; ++r) {
                            const int d0 = dq - ((r & 3) + 8 * (r >> 2)), d1 = d0 - 32;
                            const float b0 = lutL[min(max(d0, 0), 127)], b1 = lutL[min(max(d1, 0), 127)];
                            s0[r] = d0 >= 0 ? s0[r] + b0 : -1e30f;
                            s1[r] = d1 >= 0 ? s1[r] + b1 : -1e30f;
                        }
                    }
                    float mx = fmaxf(fmaxf(s0[0], s0[1]), fmaxf(s1[0], s1[1]));
#pragma unroll
                    for (int r = 2; r < 16; r += 2) mx = fmaxf(mx, fmaxf(fmaxf(s0[r], s0[r + 1]), fmaxf(s1[r], s1[r + 1])));
                    mx = fmaxf(mx, __shfl_xor(mx, 32));
                    if (__any(mx > AT_THR)) {
                        const float dl = fmaxf(mx, 0.f), alpha = ex2(-dl); m_run += dl; l_run *= alpha;
#pragma unroll
                        for (int r = 0; r < 16; ++r) { s0[r] -= dl; s1[r] -= dl; o0[r] *= alpha; o1[r] *= alpha; cinit[r] -= dl; }
                    }
                    float ps = 0.f;
#pragma unroll
                    for (int r = 0; r < 16; ++r) { s0[r] = ex2(s0[r]); s1[r] = ex2(s1[r]); ps += s0[r] + s1[r]; }
                    l_run += ps;
                } else {
                    if (i == qb * 4 + (wave >> 1)) {
#pragma unroll
                        for (int r = 0; r < 16; ++r) {
                            const int d0 = dq - ((r & 3) + 8 * (r >> 2)), d1 = d0 - 32;
                            s0[r] = d0 >= 0 ? s0[r] : 0.f; s1[r] = d1 >= 0 ? s1[r] : 0.f;
                        }
                    }
#pragma unroll
                    for (int r = 0; r < 16; ++r) { o0[r] *= g64; o1[r] *= g64; }
                }
#pragma unroll
                for (int s = 0; s < 2; ++s) {
                    v4u w0, w1;
                    w0.x = cvtpk(s0[8 * s + 0], s0[8 * s + 1]); w0.y = cvtpk(s0[8 * s + 2], s0[8 * s + 3]); w0.z = cvtpk(s0[8 * s + 4], s0[8 * s + 5]); w0.w = cvtpk(s0[8 * s + 6], s0[8 * s + 7]);
                    w1.x = cvtpk(s1[8 * s + 0], s1[8 * s + 1]); w1.y = cvtpk(s1[8 * s + 2], s1[8 * s + 3]); w1.z = cvtpk(s1[8 * s + 4], s1[8 * s + 5]); w1.w = cvtpk(s1[8 * s + 6], s1[8 * s + 7]);
                    pf[s] = __builtin_bit_cast(bf16x8, w0); pf[2 + s] = __builtin_bit_cast(bf16x8, w1);
                }
            }
        }
        if (ph & 1) { const int j = (ph + 1) >> 1; if (j + 1 < NT) AT_WAIT_BAR_N(2); else AT_WAIT_BAR(); }
        else asm volatile("s_waitcnt lgkmcnt(0)\n\ts_barrier" ::: "memory");
    }
#undef AT_DMA
#undef AT_ACT
    int qa2 = q_abs; asm volatile("" : "+v"(qa2));
    const size_t qrow_e = (size_t)(b * T + qa2);
    float scale;
    if (MODE == 0) { const float l = l_run + __shfl_xor(l_run, 32); scale = 1.0f / l; }
    else { float ss = 0.f;
#pragma unroll
        for (int r = 0; r < 16; ++r) ss += o0[r] * o0[r] + o1[r] * o1[r];
        ss += __shfl_xor(ss, 32); scale = rsqrtf(ss * (1.0f / 64.0f) + 1e-6f); }
#pragma unroll
    for (int g = 0; g < 4; ++g) {
        const int d0 = 8 * g + 4 * h2;
        const v2u g0 = *(const gv2u*)(Pg + qrow_e * 256 + h * 64 + d0), g1 = *(const gv2u*)(Pg + qrow_e * 256 + h * 64 + 32 + d0);
        v2u w0, w1;
        w0.x = cvtpk(o0[4 * g] * scale * bf2f(g0.x & 0xffffu), o0[4 * g + 1] * scale * bf2f(g0.x >> 16)); w0.y = cvtpk(o0[4 * g + 2] * scale * bf2f(g0.y & 0xffffu), o0[4 * g + 3] * scale * bf2f(g0.y >> 16));
        w1.x = cvtpk(o1[4 * g] * scale * bf2f(g1.x & 0xffffu), o1[4 * g + 1] * scale * bf2f(g1.x >> 16)); w1.y = cvtpk(o1[4 * g + 2] * scale * bf2f(g1.y & 0xffffu), o1[4 * g + 3] * scale * bf2f(g1.y >> 16));
        *(gv2u*)(Y + qrow_e * D + ycol + h * 64 + d0) = w0; *(gv2u*)(Y + qrow_e * D + ycol + h * 64 + 32 + d0) = w1;
    }
}

constexpr int AB_SLOT = 65536, AB_LUT = LDSCTL_OFF + 1024, AB_LUT2 = LDSCTL_OFF + 2048;
static_assert(2 * AB_SLOT <= RING_BYTES && AB_LUT2 + 6144 <= LDS_BYTES, "attention block ring");
template <int MODE>
__device__ __forceinline__ void attn_unit_blk(const gbf* Pq, const gbf* Pk, const gbf* Pv, const gbf* Pg, gbf* Y, int ycol, int b, int h, int qb,
                                              const gf32* KMl, const gf32* lut, LAS unsigned char* lds, int wave, int lane) {
    const int r32 = lane & 31, h2 = lane >> 5;
    const int q_abs = qb * 256 + wave * 32 + r32; const size_t qrow = (size_t)(b * T + q_abs);
    const unsigned lds0 = (unsigned)(uintptr_t)lds;
    const int NS = qb + 1;
    const int kkey_ = wave * 8 + (lane >> 3);
    const gbf* ksrc = Pk + (size_t)(b * T + kkey_) * 256 + h * 64 + (((lane & 7) ^ ((kkey_ >> 1) & 7)) * 8);
    int koff[4];
#pragma unroll
    for (int ks = 0; ks < 4; ++ks) koff[ks] = r32 * 128 + (((2 * ks + h2) ^ ((r32 >> 1) & 7)) * 16);
    const gbf* vsrc = Pv + (size_t)(b * T + 16 * (wave & 3) + (lane >> 2)) * 256 + h * 64 + (wave >> 2) * 32 + (lane & 3) * 8;
#define AB_DMA(S_, slot_) do { _Pragma("unroll") for (int u_ = 0; u_ < 4; ++u_) { \
        glds16(ksrc + (size_t)((S_) * 4 + u_) * 64 * 256, (unsigned)__builtin_amdgcn_readfirstlane(lds0 + (slot_) * AB_SLOT + u_ * 8192 + wave * 1024)); \
        glds16(vsrc + (size_t)((S_) * 4 + u_) * 64 * 256, (unsigned)__builtin_amdgcn_readfirstlane(lds0 + (slot_) * AB_SLOT + 32768 + u_ * 8192 + wave * 1024)); } } while (0)
    AB_DMA(0, 0);
    if (MODE == 0 && wave < 6) glds16((const GAS unsigned char*)lut + (TAB_LUT2 - TAB_LUT) + (size_t)h * 6144 + wave * 1024 + lane * 16, (unsigned)__builtin_amdgcn_readfirstlane(lds0 + AB_LUT2 + wave * 1024));
    bf16x8 qf[4];
#pragma unroll
    for (int ks = 0; ks < 4; ++ks) qf[ks] = *(const gbf16x8*)(Pq + qrow * 256 + h * 64 + 16 * ks + 8 * h2);
    LAS float* lutL = (LAS float*)(lds + AB_LUT);
    unsigned sel = 0u;
    if (MODE == 0) {
        if (qb <= 3) sel = (1u << qb) - 1u;
        else {
            f32x16 gacc;
#pragma unroll
            for (int r = 0; r < 16; ++r) gacc[r] = 0.f;
            const gf32* km = KMl + (b * 8 + (r32 & 7)) * 256 + h * 64 + 8 * h2;
#pragma unroll
            for (int ks = 0; ks < 4; ++ks) {
                const f32x4 ka = *(const gf32x4*)(km + 16 * ks), kb = *(const gf32x4*)(km + 16 * ks + 4);
                v4u w; w.x = cvtpk(ka[0], ka[1]); w.y = cvtpk(ka[2], ka[3]); w.z = cvtpk(kb[0], kb[1]); w.w = cvtpk(kb[2], kb[3]);
                gacc = __builtin_amdgcn_mfma_f32_32x32x16_bf16(__builtin_bit_cast(bf16x8, w), qf[ks], gacc, 0, 0, 0);
            }
            float gv[8];
#pragma unroll
            for (int e = 0; e < 4; ++e) { const float mine = gacc[e], other = __shfl_xor(mine, 32); gv[e] = h2 ? other : mine; gv[4 + e] = h2 ? mine : other; }
            float g0 = -INFINITY, g1 = -INFINITY, g2 = -INFINITY; int i0 = 0, i1 = 0, i2 = 0;
#pragma unroll
            for (int n = 0; n < 8; ++n) {
                const float g = (n < qb) ? gv[n] : -INFINITY;
                if (g > g0) { g2 = g1; i2 = i1; g1 = g0; i1 = i0; g0 = g; i0 = n; }
                else if (g > g1) { g2 = g1; i2 = i1; g1 = g; i1 = n; }
                else if (g > g2) { g2 = g; i2 = n; }
            }
            sel = (1u << i0) | (1u << i1) | (1u << i2);
        }
    }
    const float g64 = (MODE == 1) ? ex2(256.0f * log2f(1.0f - ex2(-5.0f - (float)h))) : 1.0f;
    float m_run = 0.f; f32x16 o0, o1, cinit, lacc;
#pragma unroll
    for (int r = 0; r < 16; ++r) { o0[r] = 0.f; o1[r] = 0.f; cinit[r] = 0.f; lacc[r] = 0.f; }
    const bf16x8 ones = (bf16x8){0x3F80, 0x3F80, 0x3F80, 0x3F80, 0x3F80, 0x3F80, 0x3F80, 0x3F80};
    for (int S = 0; S < NS; ++S) {
        if (S + 1 < NS) AB_DMA(S + 1, (S + 1) & 1);
        if (S == 0) { if (NS > 1) AT_WAIT_BAR_N(8); else AT_WAIT_BAR(); }
        const bool own = (S == qb);
        if (MODE == 0) { const float cv = (own || ((sel >> S) & 1u)) ? -m_run : -1e30f;
#pragma unroll
            for (int r = 0; r < 16; ++r) cinit[r] = cv; }
        if (MODE == 1 && S > 0) {
#pragma unroll
            for (int r = 0; r < 16; ++r) { o0[r] *= g64; o1[r] *= g64; } }
        const LAS unsigned char* slot = lds + (S & 1) * AB_SLOT;
        bf16x8 kf[8]; bool have = false;
#pragma unroll 1
        for (int u = 0; u < 4; ++u) {
            const int t = 4 * S + u;
            const bool active = !own || (u * 64 <= wave * 32 + 31);
            if (!active) break;
            const LAS unsigned char* kb = slot + u * 8192;
            if (!have) {
#pragma unroll
                for (int ks = 0; ks < 4; ++ks) { kf[2 * ks] = *(const LAS bf16x8*)(kb + koff[ks]); kf[2 * ks + 1] = *(const LAS bf16x8*)(kb + koff[ks] + 4096); }
            }
            f32x16 s0 = cinit, s1 = cinit;
#pragma unroll
            for (int ks = 0; ks < 4; ++ks) {
                s0 = __builtin_amdgcn_mfma_f32_32x32x16_bf16(kf[2 * ks], qf[ks], s0, 0, 0, 0);
                s1 = __builtin_amdgcn_mfma_f32_32x32x16_bf16(kf[2 * ks + 1], qf[ks], s1, 0, 0, 0);
            }
            __builtin_amdgcn_sched_barrier(0);
            const LAS unsigned char* vb = slot + 32768 + u * 8192 + ((lane >> 4) & 1) * 32 + (lane & 3) * 8 + (4 * h2 + ((lane & 15) >> 2)) * 64;
            s16x4 vlo0[4], vhi0[4], vlo1[4], vhi1[4];
#pragma unroll
            for (int kk = 0; kk < 4; ++kk) { vlo0[kk] = vtr(vb + kk * 1024); vhi0[kk] = vtr(vb + kk * 1024 + 512); vlo1[kk] = vtr(vb + 4096 + kk * 1024); vhi1[kk] = vtr(vb + 4096 + kk * 1024 + 512); }
            __builtin_amdgcn_sched_barrier(0);
            const int dq = q_abs - (t * 64 + 4 * h2);
            if (MODE == 0) {
                const bool near = own || (qb * 256 + wave * 32 - (t * 64 + 63) < 113);
                if (near) {
                    const int jb = 255 - dq, cpy = jb & 3;
                    const LAS unsigned char* lp = lds + AB_LUT2 + cpy * 1344 + (jb - cpy) * 4;
#pragma unroll
                    for (int g = 0; g < 4; ++g) {
                        const f32x4 b0 = *(const LAS f32x4*)(lp + 32 * g), b1 = *(const LAS f32x4*)(lp + 128 + 32 * g);
#pragma unroll
                        for (int k = 0; k < 4; ++k) { s0[4 * g + k] += b0[k]; s1[4 * g + k] += b1[k]; }
                    }
                }
                float mxa = fmaxf(s0[0], s1[0]), mxb = fmaxf(s0[1], s1[1]);
#pragma unroll
                for (int r = 2; r < 16; r += 2) { mxa = fmaxf(fmaxf(mxa, s0[r]), s1[r]); mxb = fmaxf(fmaxf(mxb, s0[r + 1]), s1[r + 1]); }
                float mx = fmaxf(mxa, mxb);
                { const auto sw = __builtin_amdgcn_permlane32_swap(__float_as_uint(mx), __float_as_uint(mx), false, false);
                  mx = fmaxf(__uint_as_float(sw[0]), __uint_as_float(sw[1])); }
                if (__any(mx > AT_THR)) {
                    const float dl = fmaxf(mx, 0.f), alpha = ex2(-dl); m_run += dl; lacc[0] *= alpha;
#pragma unroll
                    for (int r = 0; r < 16; ++r) { s0[r] -= dl; s1[r] -= dl; o0[r] *= alpha; o1[r] *= alpha; cinit[r] -= dl; }
                }
            } else {
                if (t == qb * 4 + (wave >> 1)) {
#pragma unroll
                    for (int r = 0; r < 16; ++r) {
                        const int d0 = dq - ((r & 3) + 8 * (r >> 2)), d1 = d0 - 32;
                        s0[r] = d0 >= 0 ? s0[r] : 0.f; s1[r] = d1 >= 0 ? s1[r] : 0.f;
                    }
                }
            }
            bf16x8 pf[4];
#define AT_EX(kk, e) do { if (MODE == 0) { if ((kk) < 2) s0[8 * ((kk) & 1) + (e)] = ex2(s0[8 * ((kk) & 1) + (e)]); else s1[8 * ((kk) & 1) + (e)] = ex2(s1[8 * ((kk) & 1) + (e)]); } } while (0)
#define AT_CVT(kk) do { const int b_ = 8 * ((kk) & 1); v4u w_; \
                if ((kk) < 2) { w_.x = cvtpk(s0[b_], s0[b_ + 1]); w_.y = cvtpk(s0[b_ + 2], s0[b_ + 3]); w_.z = cvtpk(s0[b_ + 4], s0[b_ + 5]); w_.w = cvtpk(s0[b_ + 6], s0[b_ + 7]); } \
                else { w_.x = cvtpk(s1[b_], s1[b_ + 1]); w_.y = cvtpk(s1[b_ + 2], s1[b_ + 3]); w_.z = cvtpk(s1[b_ + 4], s1[b_ + 5]); w_.w = cvtpk(s1[b_ + 6], s1[b_ + 7]); } \
                pf[kk] = __builtin_bit_cast(bf16x8, w_); } while (0)
#define AT_SB() __builtin_amdgcn_sched_barrier(0)
#pragma unroll
            for (int e = 0; e < 8; ++e) AT_EX(0, e);
            AT_CVT(0);
            AT_SB();
            have = (u < 3) && (!own || ((u + 1) * 64 <= wave * 32 + 31));
            if (have) {
#pragma unroll
                for (int ks = 0; ks < 4; ++ks) { kf[2 * ks] = *(const LAS bf16x8*)(kb + 8192 + koff[ks]); kf[2 * ks + 1] = *(const LAS bf16x8*)(kb + 8192 + koff[ks] + 4096); }
            }
            AT_SB();
#pragma unroll
            for (int kk = 0; kk < 4; ++kk) {
                const s16x4 lo0 = vlo0[kk], hi0 = vhi0[kk], lo1 = vlo1[kk], hi1 = vhi1[kk];
                const bf16x8 v0 = (bf16x8){lo0[0], lo0[1], lo0[2], lo0[3], hi0[0], hi0[1], hi0[2], hi0[3]};
                const bf16x8 v1 = (bf16x8){lo1[0], lo1[1], lo1[2], lo1[3], hi1[0], hi1[1], hi1[2], hi1[3]};
                o0 = __builtin_amdgcn_mfma_f32_32x32x16_bf16(v0, pf[kk], o0, 0, 0, 0);
                AT_SB();
                if (kk < 3) { if (MODE == 0) { AT_EX(kk + 1, 0); AT_EX(kk + 1, 1); AT_EX(kk + 1, 2); } else AT_CVT(kk + 1); }
                AT_SB();
                o1 = __builtin_amdgcn_mfma_f32_32x32x16_bf16(v1, pf[kk], o1, 0, 0, 0);
                if (MODE == 0) {
                    AT_SB();
                    if (kk < 3) { AT_EX(kk + 1, 3); AT_EX(kk + 1, 4); AT_EX(kk + 1, 5); }
                    AT_SB();
                    lacc = __builtin_amdgcn_mfma_f32_32x32x16_bf16(ones, pf[kk], lacc, 0, 0, 0);
                    AT_SB();
                    if (kk < 3) { AT_EX(kk + 1, 6); AT_EX(kk + 1, 7); AT_CVT(kk + 1); }
                    AT_SB();
                }
            }
#undef AT_EX
#undef AT_CVT
#undef AT_SB
        }
        AT_WAIT_BAR();
    }
#undef AB_DMA
    int qa2 = q_abs; asm volatile("" : "+v"(qa2));
    const size_t qrow_e = (size_t)(b * T + qa2);
    float scale;
    if (MODE == 0) { scale = 1.0f / lacc[0]; }
    else { float ss = 0.f;
#pragma unroll
        for (int r = 0; r < 16; ++r) ss += o0[r] * o0[r] + o1[r] * o1[r];
        ss += __shfl_xor(ss, 32); scale = rsqrtf(ss * (1.0f / 64.0f) + 1e-6f); }
#pragma unroll
    for (int g = 0; g < 4; ++g) {
        const int d0 = 8 * g + 4 * h2;
        const v2u g0 = *(const gv2u*)(Pg + qrow_e * 256 + h * 64 + d0), g1 = *(const gv2u*)(Pg + qrow_e * 256 + h * 64 + 32 + d0);
        v2u w0, w1;
        w0.x = cvtpk(o0[4 * g] * scale * bf2f(g0.x & 0xffffu), o0[4 * g + 1] * scale * bf2f(g0.x >> 16)); w0.y = cvtpk(o0[4 * g + 2] * scale * bf2f(g0.y & 0xffffu), o0[4 * g + 3] * scale * bf2f(g0.y >> 16));
        w1.x = cvtpk(o1[4 * g] * scale * bf2f(g1.x & 0xffffu), o1[4 * g + 1] * scale * bf2f(g1.x >> 16)); w1.y = cvtpk(o1[4 * g + 2] * scale * bf2f(g1.y & 0xffffu), o1[4 * g + 3] * scale * bf2f(g1.y >> 16));
        *(gv2u*)(Y + qrow_e * D + ycol + h * 64 + d0) = w0; *(gv2u*)(Y + qrow_e * D + ycol + h * 64 + 32 + d0) = w1;
    }
}

__device__ __forceinline__ void attn_dispatch(const gu8* wsc, int l, int u, LAS unsigned char* lds, int wave, int lane) {
    gu8* ws = (gu8*)wsc;
    const gbf* PB = (const gbf*)(ws + WS_PB);
    const gf32* KMl = (const gf32*)(ws + WS_CTL + CTL_KM) + l * 64 * 256;
    const gf32* lut = (const gf32*)(ws + WS_TAB + TAB_LUT);
    gbf* Y = (gbf*)(ws + WS_XB);
    const int qb = 7 - (u >> 6), mode = (u >> 5) & 1, b = (u >> 2) & 7, h = u & 3;
#if ATT_STAGGER == 2
    if (mode == 0) attn_unit_blk<0>(PB + 8 * PANEL, PB + 9 * PANEL, PB + 10 * PANEL, PB + 11 * PANEL, Y, 512, b, h, qb, KMl, lut, lds, wave, lane);
    else           attn_unit_blk<1>(PB + 12 * PANEL, PB + 13 * PANEL, PB + 14 * PANEL, PB + 15 * PANEL, Y, 768, b, h, qb, KMl, lut, lds, wave, lane);
#elif ATT_STAGGER == 1
    if (mode == 0) attn_unit_stg<0>(PB + 8 * PANEL, PB + 9 * PANEL, PB + 10 * PANEL, PB + 11 * PANEL, Y, 512, b, h, qb, KMl, lut, lds, wave, lane);
    else           attn_unit_stg<1>(PB + 12 * PANEL, PB + 13 * PANEL, PB + 14 * PANEL, PB + 15 * PANEL, Y, 768, b, h, qb, KMl, lut, lds, wave, lane);
#else
    if (mode == 0) attn_unit<0>(PB + 8 * PANEL, PB + 9 * PANEL, PB + 10 * PANEL, PB + 11 * PANEL, Y, 512, b, h, qb, KMl, lut, lds, wave, lane);
    else           attn_unit<1>(PB + 12 * PANEL, PB + 13 * PANEL, PB + 14 * PANEL, PB + 15 * PANEL, Y, 768, b, h, qb, KMl, lut, lds, wave, lane);
#endif
#if PROBE_ATT
    if (mode == 0) attn_unit<0, PROBE_ATT>(PB + 8 * PANEL, PB + 9 * PANEL, PB + 10 * PANEL, PB + 11 * PANEL, Y, 512, b, h, qb, KMl, lut, lds, wave, lane);
    else           attn_unit<1, PROBE_ATT>(PB + 12 * PANEL, PB + 13 * PANEL, PB + 14 * PANEL, PB + 15 * PANEL, Y, 768, b, h, qb, KMl, lut, lds, wave, lane);
#endif
}
constexpr int RP = 144, TILE_B = 64 * RP;
constexpr int RW_LORA = 5 * TILE_B, RW_W2S = RW_LORA + 64 * 65 * 4, RW_A2S = RW_W2S + 8192;
constexpr int RW_TOT = 12 * TILE_B, RW_GL = RW_TOT + 2048, RW_END = RW_GL + 256;
constexpr int RW_W2P = 114688, RW_A2P = RW_W2P + 8192;
static_assert(2 * 64 * 68 * 4 <= 4 * TILE_B && RW_END <= RW_W2P && RW_W2P + 64 * RP <= RING_BYTES, "rwkv LDS map");

typedef GAS unsigned long long gu64;
__device__ __forceinline__ void st_wt64(GAS void* p, v2u v) { __hip_atomic_store((gu64*)p, ((unsigned long long)v.y << 32) | v.x, __ATOMIC_RELAXED, __HIP_MEMORY_SCOPE_AGENT); }
__device__ __forceinline__ void st_wt128(GAS void* p, v4u v) { st_wt64(p, (v2u){v.x, v.y}); st_wt64((GAS unsigned char*)p + 8, (v2u){v.z, v.w}); }
__device__ __forceinline__ void st_wt128f(GAS void* p, f32x4 v) { st_wt128(p, __builtin_bit_cast(v4u, v)); }
__device__ __forceinline__ bf16x8 rowfrag(const LAS unsigned char* tile, int idx0, int k0, int r32, int h2) { return *(const LAS bf16x8*)(tile + (idx0 + r32) * RP + (k0 + 8 * h2) * 2); }
__device__ __forceinline__ bf16x8 trfrag(const LAS unsigned char* tile, int k0, int idx0, int lane) {
    const int g = lane >> 4, i = lane & 15;
    const LAS unsigned char* p = tile + (k0 + 8 * (g >> 1) + (i >> 2)) * RP + (idx0 + 16 * (g & 1) + 4 * (i & 3)) * 2;
    const s16x4 lo = vtr(p), hi = vtr(p + 4 * RP);
    return (bf16x8){lo[0], lo[1], lo[2], lo[3], hi[0], hi[1], hi[2], hi[3]};
}
template <bool ATR, bool BTR>
__device__ __forceinline__ void quad_mma(f32x16& acc, const LAS unsigned char* At, int a0, const LAS unsigned char* Bt, int b0, int klo, int khi, int lane) {
    const int r32 = lane & 31, h2 = lane >> 5;
    const int nk = (khi - klo) >> 4;
    bf16x8 af[4], bfr[4];
#pragma unroll
    for (int i = 0; i < 4; ++i) { const int k0 = klo + 16 * i;
        af[i] = ATR ? trfrag(At, k0, a0, lane) : rowfrag(At, a0, k0, r32, h2);
        bfr[i] = BTR ? trfrag(Bt, k0, b0, lane) : rowfrag(Bt, b0, k0, r32, h2); }
    __builtin_amdgcn_sched_barrier(0);
    if (nk > 0) acc = __builtin_amdgcn_mfma_f32_32x32x16_bf16(bfr[0], af[0], acc, 0, 0, 0);
    if (nk > 1) acc = __builtin_amdgcn_mfma_f32_32x32x16_bf16(bfr[1], af[1], acc, 0, 0, 0);
    if (nk > 2) acc = __builtin_amdgcn_mfma_f32_32x32x16_bf16(bfr[2], af[2], acc, 0, 0, 0);
    if (nk > 3) acc = __builtin_amdgcn_mfma_f32_32x32x16_bf16(bfr[3], af[3], acc, 0, 0, 0);
}
__device__ __forceinline__ void quad_store_lds(const f32x16& acc, LAS unsigned char* tile, int a0, int b0, int lane) {
    const int r32 = lane & 31, h2 = lane >> 5;
#pragma unroll
    for (int g = 0; g < 4; ++g) { v2u w; w.x = cvtpk(acc[4 * g], acc[4 * g + 1]); w.y = cvtpk(acc[4 * g + 2], acc[4 * g + 3]);
        *(LAS v2u*)(tile + (a0 + r32) * RP + (b0 + 8 * g + 4 * h2) * 2) = w; }
}
#define RW_BAR() __syncthreads()

struct R1In { v4u l0, l1, r0, r1, k0, k1, v0, v1; };
__device__ __forceinline__ void r1_load(R1In& in, const gu8* wsc, int item, int tid) {
    const gbf* PB = (const gbf*)((gu8*)wsc + WS_PB); const gbf*P0 = PB, *P1 = PB + PANEL, *P2 = PB + 2 * PANEL, *P16 = PB + 16 * PANEL;
    const int c = item & 31, h = (item >> 5) & 3, b = (item >> 7) & 7, t = tid >> 3, cg = tid & 7, c0 = h * 64 + 8 * cg, tl = c * 64 + t;
    const size_t tok = (size_t)b * T + tl, prv = tok - (tl > 0 ? 1 : 0);
    in.l0 = *(const gv4u*)(P16 + tok * 64 + 8 * cg); in.l1 = *(const gv4u*)(P16 + prv * 64 + 8 * cg);
    in.r0 = *(const gv4u*)(P0 + tok * 256 + c0); in.r1 = *(const gv4u*)(P0 + prv * 256 + c0);
    in.k0 = *(const gv4u*)(P1 + tok * 256 + c0); in.k1 = *(const gv4u*)(P1 + prv * 256 + c0);
    in.v0 = *(const gv4u*)(P2 + tok * 256 + c0); in.v1 = *(const gv4u*)(P2 + prv * 256 + c0);
}
constexpr int RW_PAR = RW_W2P + 64 * RP;
static_assert(RW_PAR + 9 * 64 * 4 <= RING_BYTES, "rwkv parameter block");
__device__ __forceinline__ void r1_stage_lora_w(const DArgs& a, int l, int h, LAS unsigned char* lds, int tid) {
    const gf32*w2 = a.in[6] + l * 32 * 256, *a2 = a.in[8] + l * 32 * 256;
    const int idx = tid * 4, m = idx >> 6, j = idx & 63;
    const f32x4 wv = *(const gf32x4*)(w2 + m * 256 + h * 64 + j), av = *(const gf32x4*)(a2 + m * 256 + h * 64 + j);
    v2u ww, aw; ww.x = cvtpk(wv[0], wv[1]); ww.y = cvtpk(wv[2], wv[3]); aw.x = cvtpk(av[0], av[1]); aw.y = cvtpk(av[2], av[3]);
    *(LAS v2u*)(lds + RW_W2P + m * RP + j * 2) = ww; *(LAS v2u*)(lds + RW_W2P + 32 * RP + m * RP + j * 2) = aw;
}
__device__ __forceinline__ void rwkv_chunk_item(const gu8* wsc, const DArgs& a, int l, int item, const R1In& in, int next_item, R1In& nxt, LAS unsigned char* lds, int wave, int lane, int tid) {
    gu8* ws = (gu8*)wsc;
    const int c = item & 31, h = (item >> 5) & 3, b = (item >> 7) & 7;
    const gf32*mu = a.in[4] + l * 832, *w0 = a.in[5] + l * 256, *a0p = a.in[7] + l * 256,
                *k_k = a.in[9] + l * 256, *k_a = a.in[10] + l * 256, *r_k = a.in[11] + l * 256;
    gu8* tmpb = (gu8*)a.out;
    gbf* QtG = (gbf*)(tmpb) + (size_t)item * 4096; gbf* PG = (gbf*)(tmpb + 8 * MiB) + (size_t)item * 4096;
    gf32* YiG = (gf32*)(tmpb + 16 * MiB) + (size_t)item * 4096; gf32* GG = (gf32*)(ws + WS_R1) + (size_t)item * 4096;
    gf32* SB = (gf32*)(ws + WS_SB);
    const int r32 = lane & 31, h2 = lane >> 5;
#define TL(s) (lds + (s) * TILE_B)
    {
        const int t = tid >> 3, cg = tid & 7, c0 = h * 64 + 8 * cg, tl = c * 64 + t; const size_t tok = (size_t)b * T + tl; const bool hp = tl > 0;
        { float fc[8], fp[8], xl[8]; unpack8(in.l0, fc); unpack8(in.l1, fp);
#pragma unroll
          for (int e = 0; e < 8; ++e) { float x = fc[e] + ((hp ? fp[e] : 0.f) - fc[e]) * mu[768 + 8 * cg + e]; if (cg < 4) x = 1.0f - 2.0f * __builtin_amdgcn_rcpf(1.0f + __expf(2.0f * x)); xl[e] = x; }
          v4u w_; w_.x = cvtpk(xl[0], xl[1]); w_.y = cvtpk(xl[2], xl[3]); w_.z = cvtpk(xl[4], xl[5]); w_.w = cvtpk(xl[6], xl[7]); *(LAS v4u*)(TL(5) + t * RP + cg * 16) = w_; }
        float xr[8], xk[8], xv[8];
        { float f0[8], f1[8];
          unpack8(in.r0, f0); unpack8(in.r1, f1);
#pragma unroll
          for (int e = 0; e < 8; ++e) xr[e] = f0[e] + ((hp ? f1[e] : 0.f) - f0[e]) * mu[c0 + e];
          unpack8(in.k0, f0); unpack8(in.k1, f1);
#pragma unroll
          for (int e = 0; e < 8; ++e) xk[e] = f0[e] + ((hp ? f1[e] : 0.f) - f0[e]) * mu[256 + c0 + e];
          unpack8(in.v0, f0); unpack8(in.v1, f1);
#pragma unroll
          for (int e = 0; e < 8; ++e) xv[e] = f0[e] + ((hp ? f1[e] : 0.f) - f0[e]) * mu[512 + c0 + e]; }
        RW_BAR();
        { const int kind = wave >> 2, q = wave & 3, qa = (q >> 1) * 32, qb_ = (q & 1) * 32; f32x16 acc;
#pragma unroll
          for (int r = 0; r < 16; ++r) acc[r] = 0.f;
          quad_mma<false, true>(acc, TL(5) + kind * 64, qa, lds + RW_W2P + kind * 32 * RP, qb_, 0, 32, lane);
          LAS float* od = (LAS float*)(lds + 8 * TILE_B) + kind * (64 * 68) + (qa + r32) * 68 + qb_ + 4 * h2;
#pragma unroll
          for (int g = 0; g < 4; ++g) *(LAS f32x4*)(od + 8 * g) = (f32x4){acc[4 * g], acc[4 * g + 1], acc[4 * g + 2], acc[4 * g + 3]}; }
        RW_BAR();
        float lw[8], la[8];
        { const LAS float* lwp = (const LAS float*)(lds + 8 * TILE_B) + t * 68 + 8 * cg; const LAS float* lap = lwp + 64 * 68;
          const f32x4 w0_ = *(const LAS f32x4*)lwp, w1_ = *(const LAS f32x4*)(lwp + 4), a0_ = *(const LAS f32x4*)lap, a1_ = *(const LAS f32x4*)(lap + 4);
#pragma unroll
          for (int e = 0; e < 4; ++e) { lw[e] = w0_[e]; lw[4 + e] = w1_[e]; la[e] = a0_[e]; la[4 + e] = a1_[e]; } }
        float l2w[8], av[8], kk[8], kp[8]; float ssum = 0.f, sb = 0.f;
#pragma unroll
        for (int e = 0; e < 8; ++e) {
            l2w[e] = (-0.6065306597126334f * LOG2E) * sigmoidf_(w0[c0 + e] + lw[e]);
            av[e] = sigmoidf_(a0p[c0 + e] + la[e]);
            kk[e] = xk[e] * k_k[c0 + e]; ssum += kk[e] * kk[e];
            kp[e] = xk[e] * (1.0f + (av[e] - 1.0f) * k_a[c0 + e]);
            sb += xr[e] * kp[e] * r_k[c0 + e];
        }
        ssum += __shfl_xor(ssum, 1); ssum += __shfl_xor(ssum, 2); ssum += __shfl_xor(ssum, 4);
        sb += __shfl_xor(sb, 1); sb += __shfl_xor(sb, 2); sb += __shfl_xor(sb, 4);
        if (cg == 0) SB[tok * 4 + h] = sb;
        const float rn = __builtin_amdgcn_rsqf(fmaxf(ssum, 1e-24f));
        float cs[8];
#pragma unroll
        for (int e = 0; e < 8; ++e) cs[e] = l2w[e];
#pragma unroll
        for (int off = 8; off < 64; off <<= 1) {
#pragma unroll
            for (int e = 0; e < 8; ++e) { const float v = __shfl_up(cs[e], off); if (lane >= off) cs[e] += v; }
        }
        LAS float* tot = (LAS float*)(lds + RW_TOT);
        if (lane >= 56) {
#pragma unroll
            for (int e = 0; e < 8; ++e) tot[wave * 64 + 8 * cg + e] = cs[e]; }
        RW_BAR();
        for (int w = 0; w < wave; ++w) {
            const f32x4 ta = *(const LAS f32x4*)(tot + w * 64 + 8 * cg), tb = *(const LAS f32x4*)(tot + w * 64 + 8 * cg + 4);
#pragma unroll
            for (int e = 0; e < 4; ++e) { cs[e] += ta[e]; cs[4 + e] += tb[e]; }
        }
        float vRb[8], vAb[8], vBb[8], vKb[8];
#pragma unroll
        for (int e = 0; e < 8; ++e) {
            const float g = ex2(cs[e]), gp = ex2(cs[e] - l2w[e]), gi = ex2(-cs[e]); const float kn = kk[e] * rn;
            vRb[e] = xr[e] * g; vAb[e] = kn * gp; vBb[e] = -kn * av[e] * gi; vKb[e] = kp[e] * gi;
            if (t == 63) ((LAS float*)(lds + RW_GL))[8 * cg + e] = g;
        }
#define ST8(slot, v) do { v4u w_; w_.x = cvtpk(v[0], v[1]); w_.y = cvtpk(v[2], v[3]); w_.z = cvtpk(v[4], v[5]); w_.w = cvtpk(v[6], v[7]); *(LAS v4u*)(TL(slot) + t * RP + cg * 16) = w_; } while (0)
        ST8(0, vRb); ST8(1, vAb); ST8(2, vBb); ST8(3, vKb); ST8(4, xv);
#undef ST8
        RW_BAR();
    }
    if (PROBE_R1 == 1 && item >= 4096) return;
    f32x16 macc;
#pragma unroll
    for (int r = 0; r < 16; ++r) macc[r] = 0.f;
#pragma unroll
    for (int rnd = 0; rnd < 2; ++rnd) {
        const int id = rnd * 8 + wave;
        if (id < 12) {
            const int mi = id / 3, qi = id % 3, qa = qi >= 1 ? 32 : 0, qb_ = qi == 2 ? 32 : 0;
            f32x16 acc;
#pragma unroll
            for (int r = 0; r < 16; ++r) acc[r] = 0.f;
            quad_mma<false, false>(acc, TL(mi < 2 ? 1 : 0), qa, TL((mi & 1) ? 3 : 2), qb_, 0, 64, lane);
            const int trow = qa + r32; const bool strict = mi < 2;
#pragma unroll
            for (int r = 0; r < 16; ++r) { const int tau = qb_ + (r & 3) + 8 * (r >> 2) + 4 * h2; const bool keep = strict ? (tau < trow) : (tau <= trow); acc[r] = keep ? acc[r] : 0.f; }
            quad_store_lds(acc, TL(5 + mi), qa, qb_, lane);
            if (mi == 0) {
#pragma unroll
                for (int r = 0; r < 16; ++r) { const int tau = qb_ + (r & 3) + 8 * (r >> 2) + 4 * h2; macc[r] = acc[r] + (tau == trow ? 1.0f : 0.f); }
                quad_store_lds(macc, TL(10), qa, qb_, lane);
            }
        }
    }
    RW_BAR();
    {
        const int qi = wave < 3 ? wave : wave - 3, qa = qi >= 1 ? 32 : 0, qb_ = qi == 2 ? 32 : 0;
        if (wave >= 3 && wave < 6) { f32x16 acc;
#pragma unroll
            for (int r = 0; r < 16; ++r) acc[r] = 0.f;
            quad_mma<false, true>(acc, TL(5), qa, TL(5), qb_, qb_, qa + 32, lane); quad_store_lds(acc, TL(9), qa, qb_, lane); }
        RW_BAR();
#pragma unroll
        for (int k = 1; k <= 5; ++k) {
            const int xs = (k & 1) ? 9 : 5, xd = (k & 1) ? 5 : 9, ms = (k & 1) ? 10 : 11, md = (k & 1) ? 11 : 10;
            if (wave < 3) { quad_mma<false, true>(macc, TL(ms), qa, TL(xs), qb_, qb_, qa + 32, lane); quad_store_lds(macc, TL(md), qa, qb_, lane); }
            else if (wave < 6 && k < 5) { f32x16 acc;
#pragma unroll
                for (int r = 0; r < 16; ++r) acc[r] = 0.f;
                quad_mma<false, true>(acc, TL(xs), qa, TL(xs), qb_, qb_, qa + 32, lane); quad_store_lds(acc, TL(xd), qa, qb_, lane); }
            RW_BAR();
        }
    }
    {
        const int q = wave & 3, qa = (q >> 1) * 32, qb_ = (q & 1) * 32; f32x16 acc;
#pragma unroll
        for (int r = 0; r < 16; ++r) acc[r] = 0.f;
        if (wave < 4) { quad_mma<false, true>(acc, TL(11), qa, TL(1), qb_, 0, qa + 32, lane); quad_store_lds(acc, TL(5), qa, qb_, lane); }
        else          { quad_mma<false, true>(acc, TL(6), qa, TL(4), qb_, 0, qa + 32, lane); quad_store_lds(acc, TL(9), qa, qb_, lane); }
    }
    RW_BAR();
    if (next_item >= 0) r1_load(nxt, wsc, next_item, tid);
    const LAS float* gl = (const LAS float*)(lds + RW_GL);
#pragma unroll
    for (int rnd = 0; rnd < 2; ++rnd) {
        const int id = rnd * 8 + wave;
        if (id < 12) {
            const int kind = id >> 2, q = id & 3, qa = (q >> 1) * 32, qb_ = (q & 1) * 32; const int row = qa + r32; f32x16 acc;
#pragma unroll
            for (int r = 0; r < 16; ++r) acc[r] = 0.f;
            if (kind == 0) { quad_mma<false, true>(acc, TL(11), qa, TL(9), qb_, 0, qa + 32, lane); quad_store_lds(acc, TL(10), qa, qb_, lane); }
            else if (kind == 1) {
#pragma unroll
                for (int g = 0; g < 4; ++g) { const v2u w = *(const LAS v2u*)(TL(0) + row * RP + (qb_ + 8 * g + 4 * h2) * 2);
                    acc[4 * g] = bf2f(w.x & 0xffffu); acc[4 * g + 1] = bf2f(w.x >> 16); acc[4 * g + 2] = bf2f(w.y & 0xffffu); acc[4 * g + 3] = bf2f(w.y >> 16); }
                quad_mma<false, true>(acc, TL(7), qa, TL(5), qb_, 0, qa + 32, lane);
#pragma unroll
                for (int g = 0; g < 4; ++g) { v2u w; w.x = cvtpk(acc[4 * g], acc[4 * g + 1]); w.y = cvtpk(acc[4 * g + 2], acc[4 * g + 3]); *(gv2u*)(QtG + row * 64 + qb_ + 8 * g + 4 * h2) = w; }
            } else {
                quad_mma<true, true>(acc, TL(2), qa, TL(5), qb_, 0, 64, lane);
                const float gL = gl[row];
                float p[16];
#pragma unroll
                for (int r = 0; r < 16; ++r) { const int col = qb_ + 8 * (r >> 2) + 4 * h2 + (r & 3); p[r] = gL * (acc[r] + (col == row ? 1.0f : 0.f)); }
#pragma unroll
                for (int s = 0; s < 2; ++s) { v4u w; w.x = cvtpk(p[8 * s], p[8 * s + 1]); w.y = cvtpk(p[8 * s + 2], p[8 * s + 3]); w.z = cvtpk(p[8 * s + 4], p[8 * s + 5]); w.w = cvtpk(p[8 * s + 6], p[8 * s + 7]);
                    *(gv4u*)(PG + (((qa >> 5) * 4 + (qb_ >> 4) + s) * 64 + lane) * 8) = w; }
            }
        }
    }
    RW_BAR();
    {
        const int q = wave & 3, qa = (q >> 1) * 32, qb_ = (q & 1) * 32; const int row = qa + r32; f32x16 acc;
#pragma unroll
        for (int r = 0; r < 16; ++r) acc[r] = 0.f;
        if (wave < 4) {
            quad_mma<false, true>(acc, TL(7), qa, TL(10), qb_, 0, qa + 32, lane); quad_mma<false, true>(acc, TL(8), qa, TL(4), qb_, 0, qa + 32, lane);
#pragma unroll
            for (int g = 0; g < 4; ++g) *(gf32x4*)(YiG + row * 64 + qb_ + 8 * g + 4 * h2) = (f32x4){acc[4 * g], acc[4 * g + 1], acc[4 * g + 2], acc[4 * g + 3]};
        } else {
            for (int k0 = 0; k0 < 64; k0 += 16) { acc = __builtin_amdgcn_mfma_f32_32x32x16_bf16(trfrag(TL(2), k0, qa, lane), trfrag(TL(10), k0, qb_, lane), acc, 0, 0, 0);
                                                  acc = __builtin_amdgcn_mfma_f32_32x32x16_bf16(trfrag(TL(3), k0, qa, lane), trfrag(TL(4), k0, qb_, lane), acc, 0, 0, 0); }
            gf32* gp = GG + ((((qb_ >> 5) * 2 + (qa >> 5)) * 4) * 64 + lane) * 4;
#pragma unroll
            for (int g = 0; g < 4; ++g) { const f32x4 gv = *(const LAS f32x4*)(gl + qa + 8 * g + 4 * h2);
                *(gf32x4*)(gp + g * 256) = (f32x4){gv[0] * acc[4 * g], gv[1] * acc[4 * g + 1], gv[2] * acc[4 * g + 2], gv[3] * acc[4 * g + 3]}; }
        }
    }
    RW_BAR();
#undef TL
}

constexpr int SC_NS = 5, SC_SLOT = 24576;
static_assert(SC_NS * SC_SLOT <= RING_BYTES, "scan ring");
__device__ __forceinline__ void rwkv_scan(const gu8* wsc, const gu8* tmpc, int bh, LAS unsigned char* lds, int wave, int lane) {
    gu8* ws = (gu8*)wsc;
    const gbf* PGb = (const gbf*)(tmpc + 8 * MiB) + (size_t)bh * 32 * 4096; const gf32* GGb = (const gf32*)(ws + WS_R1) + (size_t)bh * 32 * 4096;
    gbf* TGb = (gbf*)(ws + WS_YRAW) + (size_t)bh * 32 * 4096;
    const int r32 = lane & 31, h2 = lane >> 5, cb = wave & 1;
    const unsigned lds0 = (unsigned)(uintptr_t)lds;
#define SC_DMA(c_, slot_) do { _Pragma("unroll") for (int q_ = 0; q_ < 4; ++q_) { const int p_ = (wave - 2) * 4 + q_; \
        const GAS void* src_ = p_ < 8 ? (const GAS void*)(PGb + (size_t)(c_) * 4096 + p_ * 512 + lane * 8) : (const GAS void*)(GGb + (size_t)(c_) * 4096 + (p_ - 8) * 256 + lane * 4); \
        glds16(src_, (unsigned)__builtin_amdgcn_readfirstlane(lds0 + (slot_) * SC_SLOT + p_ * 1024)); } } while (0)
    if (wave >= 2) { SC_DMA(0, 0); SC_DMA(1, 1); SC_DMA(2, 2); SC_DMA(3, 3); asm volatile("s_waitcnt vmcnt(12)" ::: "memory"); }
    asm volatile("s_waitcnt lgkmcnt(0)\n\ts_barrier" ::: "memory");
    f32x16 T0, T1;
#pragma unroll
    for (int r = 0; r < 16; ++r) { T0[r] = 0.f; T1[r] = 0.f; }
    for (int c = 0; c < 32; ++c) {
        if (wave >= 2) { if (c + 4 < 32) SC_DMA(c + 4, (c + 4) % SC_NS); }
        else {
            const LAS unsigned char* sl = lds + (c % SC_NS) * SC_SLOT;
            gbf* Tp = TGb + (size_t)c * 4096 + (32 * cb + r32) * 64;
            bf16x8 tb[4];
#pragma unroll
            for (int g = 0; g < 4; ++g) {
                v2u w0, w1; w0.x = cvtpk(T0[4 * g], T0[4 * g + 1]); w0.y = cvtpk(T0[4 * g + 2], T0[4 * g + 3]); w1.x = cvtpk(T1[4 * g], T1[4 * g + 1]); w1.y = cvtpk(T1[4 * g + 2], T1[4 * g + 3]);
                *(gv2u*)(Tp + 8 * g + 4 * h2) = w0; *(gv2u*)(Tp + 32 + 8 * g + 4 * h2) = w1;
            }
#pragma unroll
            for (int s = 0; s < 2; ++s) {
                v4u w0, w1;
                w0.x = cvtpk(T0[8 * s], T0[8 * s + 1]); w0.y = cvtpk(T0[8 * s + 2], T0[8 * s + 3]); w0.z = cvtpk(T0[8 * s + 4], T0[8 * s + 5]); w0.w = cvtpk(T0[8 * s + 6], T0[8 * s + 7]);
                w1.x = cvtpk(T1[8 * s], T1[8 * s + 1]); w1.y = cvtpk(T1[8 * s + 2], T1[8 * s + 3]); w1.z = cvtpk(T1[8 * s + 4], T1[8 * s + 5]); w1.w = cvtpk(T1[8 * s + 6], T1[8 * s + 7]);
                tb[s] = __builtin_bit_cast(bf16x8, w0); tb[2 + s] = __builtin_bit_cast(bf16x8, w1);
            }
            f32x16 N0, N1;
#pragma unroll
            for (int g = 0; g < 4; ++g) {
                const f32x4 ga = *(const LAS f32x4*)(sl + 8192 + (((cb * 2 + 0) * 4 + g) * 64 + lane) * 16), gb = *(const LAS f32x4*)(sl + 8192 + (((cb * 2 + 1) * 4 + g) * 64 + lane) * 16);
                N0[4 * g] = ga[0]; N0[4 * g + 1] = ga[1]; N0[4 * g + 2] = ga[2]; N0[4 * g + 3] = ga[3]; N1[4 * g] = gb[0]; N1[4 * g + 1] = gb[1]; N1[4 * g + 2] = gb[2]; N1[4 * g + 3] = gb[3];
            }
#pragma unroll
            for (int ks = 0; ks < 4; ++ks) {
                const bf16x8 a0 = *(const LAS bf16x8*)(sl + ((0 * 4 + ks) * 64 + lane) * 16), a1 = *(const LAS bf16x8*)(sl + ((1 * 4 + ks) * 64 + lane) * 16);
                N0 = __builtin_amdgcn_mfma_f32_32x32x16_bf16(a0, tb[ks], N0, 0, 0, 0);
                N1 = __builtin_amdgcn_mfma_f32_32x32x16_bf16(a1, tb[ks], N1, 0, 0, 0);
            }
            T0 = N0; T1 = N1;
        }
        if (wave >= 2) { if (c + 4 < 32) asm volatile("s_waitcnt vmcnt(12)" ::: "memory"); else if (c + 3 < 32) asm volatile("s_waitcnt vmcnt(8)" ::: "memory");
                         else if (c + 2 < 32) asm volatile("s_waitcnt vmcnt(4)" ::: "memory"); else asm volatile("s_waitcnt vmcnt(0)" ::: "memory"); }
        asm volatile("s_waitcnt lgkmcnt(0)\n\ts_barrier" ::: "memory");
    }
#undef SC_DMA
}

__device__ __forceinline__ void rwkv_out_item(const gu8* wsc, const DArgs& a, int l, int e, int wave, int lane) {
    gu8* ws = (gu8*)wsc;
    const gu8* tmpb = (const gu8*)a.out;
    const gbf* QtGb = (const gbf*)(tmpb); const gf32* YiGb = (const gf32*)(tmpb + 16 * MiB); const gbf* TGb = (const gbf*)(ws + WS_YRAW);
    const gf32* SB = (const gf32*)(ws + WS_SB);
    const gbf* P2 = (const gbf*)(ws + WS_PB) + 2 * PANEL; const gbf* P3 = (const gbf*)(ws + WS_PB) + 3 * PANEL;
    const gf32*mu_v = a.in[4] + l * 832 + 512, *lnx_w = a.in[12] + l * 256, *lnx_b = a.in[13] + l * 256;
    gbf* Y = (gbf*)(ws + WS_XB);
    const int r32 = lane & 31, h2 = lane >> 5;
    {
        const int tb_ = wave & 1, item = (e >> 3) * 32 + (e & 7) * 4 + (wave >> 1), c = item & 31, h = (item >> 5) & 3, b = item >> 7;
        const int tl = c * 64 + 32 * tb_ + r32; const size_t tok = (size_t)b * T + tl;
        const gbf* Qp = QtGb + (size_t)item * 4096 + (32 * tb_ + r32) * 64; const gf32* Yp = YiGb + (size_t)item * 4096 + (32 * tb_ + r32) * 64; const gbf* Tp = TGb + (size_t)item * 4096;
        f32x16 acc[2];
#pragma unroll
        for (int ib = 0; ib < 2; ++ib)
#pragma unroll
            for (int g = 0; g < 4; ++g) { const f32x4 y = *(const gf32x4*)(Yp + 32 * ib + 8 * g + 4 * h2); acc[ib][4 * g] = y[0]; acc[ib][4 * g + 1] = y[1]; acc[ib][4 * g + 2] = y[2]; acc[ib][4 * g + 3] = y[3]; }
#pragma unroll
        for (int ks = 0; ks < 4; ++ks) {
            const bf16x8 qf = *(const gbf16x8*)(Qp + 16 * ks + 8 * h2);
#pragma unroll
            for (int ib = 0; ib < 2; ++ib) { const bf16x8 tf = *(const gbf16x8*)(Tp + (32 * ib + r32) * 64 + 16 * ks + 8 * h2);
                acc[ib] = __builtin_amdgcn_mfma_f32_32x32x16_bf16(tf, qf, acc[ib], 0, 0, 0); }
        }
        float s = 0.f;
#pragma unroll
        for (int r = 0; r < 16; ++r) s += acc[0][r] + acc[1][r];
        s += __shfl_xor(s, 32); const float mean = s * (1.0f / 64.0f);
        float vs = 0.f;
#pragma unroll
        for (int r = 0; r < 16; ++r) { const float d0 = acc[0][r] - mean, d1 = acc[1][r] - mean; vs += d0 * d0 + d1 * d1; }
        vs += __shfl_xor(vs, 32); const float rstd = rsqrtf(vs * (1.0f / 64.0f) + 64e-5f);
        const float sb = SB[tok * 4 + h]; const bool hp = tl > 0;
        const size_t tokp = hp ? tok - 1 : tok;
#pragma unroll
        for (int ib = 0; ib < 2; ++ib) {
            f32x4 lw[4], lb[4], mv[4]; v2u vc[4], gt[4], vp[4];
#pragma unroll
            for (int g = 0; g < 4; ++g) { const int ch = h * 64 + 32 * ib + 8 * g + 4 * h2;
                lw[g] = *(const gf32x4*)(lnx_w + ch); lb[g] = *(const gf32x4*)(lnx_b + ch); mv[g] = *(const gf32x4*)(mu_v + ch);
                vc[g] = *(const gv2u*)(P2 + tok * 256 + ch); gt[g] = *(const gv2u*)(P3 + tok * 256 + ch); vp[g] = *(const gv2u*)(P2 + tokp * 256 + ch); }
#pragma unroll
            for (int g = 0; g < 4; ++g) {
                const int ch = h * 64 + 32 * ib + 8 * g + 4 * h2;
                float o[4];
#pragma unroll
                for (int e = 0; e < 4; ++e) {
                    const unsigned sh = (e & 1) * 16; const float v0 = bf2f(((e >> 1 ? vc[g].y : vc[g].x) >> sh) & 0xffffu), v1 = hp ? bf2f(((e >> 1 ? vp[g].y : vp[g].x) >> sh) & 0xffffu) : 0.f, gg = bf2f(((e >> 1 ? gt[g].y : gt[g].x) >> sh) & 0xffffu);
                    const float xv = v0 + (v1 - v0) * mv[g][e];
                    o[e] = ((acc[ib][4 * g + e] - mean) * rstd * lw[g][e] + lb[g][e] + sb * xv) * gg;
                }
                v2u w; w.x = cvtpk(o[0], o[1]); w.y = cvtpk(o[2], o[3]);
                *(gv2u*)(Y + tok * D + ch) = w;
            }
        }
    }
}

constexpr int LR_PITCH = 68;
static_assert(4 * 64 * LR_PITCH * 4 <= RING_BYTES, "lora partials fit the LDS scratch");
__device__ __forceinline__ void lora_proj(const gu8* wsc, int l, LAS unsigned char* lds, int wave, int lane, int tid) {
    gu8* ws = (gu8*)wsc;
    const gbf* XA = (const gbf*)(ws + WS_XA); const gbf* WL = (const gbf*)(ws + WS_WIN) + (size_t)l * NPAD * D + (size_t)4096 * D;
    const gf32* ssq = (const gf32*)(ws + WS_CTL + CTL_SSQ) + (size_t)l * M; gbf* P16 = (gbf*)(ws + WS_PB) + 16 * PANEL;
    const int r32 = lane & 31, h2 = lane >> 5, ksl = wave & 3, a = wave >> 2;
    LAS float* part = (LAS float*)lds;
    for (int blk = blockIdx.x; blk < M / 64; blk += gridDim.x) {
        const int r0 = blk * 64;
        f32x16 acc0, acc1;
#pragma unroll
        for (int r = 0; r < 16; ++r) { acc0[r] = 0.f; acc1[r] = 0.f; }
#pragma unroll 4
        for (int s = 0; s < 16; ++s) {
            const int k = 256 * ksl + 16 * s + 8 * h2;
            const bf16x8 af = *(const gbf16x8*)(XA + (size_t)(r0 + 32 * a + r32) * D + k);
            const bf16x8 b0 = *(const gbf16x8*)(WL + (size_t)r32 * D + k), b1 = *(const gbf16x8*)(WL + (size_t)(32 + r32) * D + k);
            acc0 = __builtin_amdgcn_mfma_f32_32x32x16_bf16(b0, af, acc0, 0, 0, 0); acc1 = __builtin_amdgcn_mfma_f32_32x32x16_bf16(b1, af, acc1, 0, 0, 0);
        }
#pragma unroll
        for (int g = 0; g < 4; ++g) {
            *(LAS f32x4*)(part + (ksl * 64 + 32 * a + r32) * LR_PITCH + 8 * g + 4 * h2) = (f32x4){acc0[4 * g], acc0[4 * g + 1], acc0[4 * g + 2], acc0[4 * g + 3]};
            *(LAS f32x4*)(part + (ksl * 64 + 32 * a + r32) * LR_PITCH + 32 + 8 * g + 4 * h2) = (f32x4){acc1[4 * g], acc1[4 * g + 1], acc1[4 * g + 2], acc1[4 * g + 3]};
        }
        __syncthreads();
        { const int row = tid >> 3, cg = tid & 7; f32x4 s0 = {0.f, 0.f, 0.f, 0.f}, s1 = {0.f, 0.f, 0.f, 0.f};
#pragma unroll
          for (int w = 0; w < 4; ++w) { s0 += *(const LAS f32x4*)(part + (w * 64 + row) * LR_PITCH + 8 * cg); s1 += *(const LAS f32x4*)(part + (w * 64 + row) * LR_PITCH + 8 * cg + 4); }
          const float rs = rsqrtf(ssq[r0 + row] * (1.0f / 1024.0f) + 1e-6f);
          v4u o; o.x = cvtpk(s0[0] * rs, s0[1] * rs); o.y = cvtpk(s0[2] * rs, s0[3] * rs); o.z = cvtpk(s1[0] * rs, s1[1] * rs); o.w = cvtpk(s1[2] * rs, s1[3] * rs);
          *(gv4u*)(P16 + (size_t)(r0 + row) * 64 + 8 * cg) = o; }
        __syncthreads();
    }
}

__device__ __forceinline__ int src_col(int n) { return n < 768 ? n : (n < 4096 ? n + 64 : n - 4096 + 768); }

__device__ __forceinline__ void p0_transpose_item(const gf32* W, int N, int K, const gf32* kscale, gbf* WT, int dst_row0, int src_col0, int k0, LAS float* scr, int lane) {
    float wv[32];
#pragma unroll
    for (int i = 0; i < 32; ++i) wv[i] = W[(size_t)(k0 + 2 * i + (lane >> 5)) * N + src_col0 + (lane & 31)];
    if (kscale) {
#pragma unroll
        for (int i = 0; i < 32; ++i) wv[i] *= kscale[k0 + 2 * i + (lane >> 5)];
    }
#pragma unroll
    for (int i = 0; i < 32; ++i) scr[(2 * i + (lane >> 5)) * 33 + (lane & 31)] = wv[i];
    LDS_WAIT(); asm volatile("" ::: "memory");
    const int c = lane & 7;
#pragma unroll
    for (int j = 0; j < 4; ++j) { const int n = (lane >> 3) + 8 * j; const LAS float* s = scr + (8 * c) * 33 + n;
        v4u o; o.x = pk2(s[0 * 33], s[1 * 33]); o.y = pk2(s[2 * 33], s[3 * 33]); o.z = pk2(s[4 * 33], s[5 * 33]); o.w = pk2(s[6 * 33], s[7 * 33]);
        *(gv4u*)(WT + (size_t)(dst_row0 + n) * K + k0 + 8 * c) = o; }
    LDS_WAIT(); asm volatile("" ::: "memory");
}

constexpr int I_IN = 16 * 130, I_OUT = 16 * 32, I_L = I_IN + I_OUT;
__device__ __forceinline__ void convert_weights(const DArgs& a, int it0, int it1, int w, int nw, LAS unsigned char* lds, int wave, int lane) {
    gu8* ws = a.ws;
    LAS float* scr = (LAS float*)(lds + RING_OFF + wave * 16384);
    for (int it = it0 + w; it < it1; it += nw) {
        const int l = it / I_L; int r = it % I_L;
        if (r < I_IN) { const int kb = r / 130, nb = r % 130;
            p0_transpose_item(a.in[2] + (size_t)l * D * WCOLS, WCOLS, D, a.in[1] + l * D, (gbf*)(ws + WS_WIN) + (size_t)l * NPAD * D, 32 * nb, src_col(32 * nb), 64 * kb, scr, lane); }
        else { r -= I_IN; const int kb = r / 32, nb = r % 32;
            p0_transpose_item(a.in[3] + (size_t)l * D * D, D, D, nullptr, (gbf*)(ws + WS_WOUT) + (size_t)l * D * D, 32 * nb, 32 * nb, 64 * kb, scr, lane); }
    }
}
constexpr int W_LATER = I_IN;
__device__ __forceinline__ void phase_prologue(const DArgs& a, LAS unsigned char* lds, int wave, int lane, int tid) {
    gu8* ws = a.ws;
    const int G = gridDim.x, gw = blockIdx.x * NWAVES + wave, NGW = G * NWAVES;
    convert_weights(a, 0, (G == 256) ? W_LATER : DEPTH * I_L, gw, NGW, lds, wave, lane);
    { const gf32* x = a.in[0]; gbf* xa = (gbf*)(ws + WS_XA); gf32* ssq0 = (gf32*)(ws + WS_CTL + CTL_SSQ);
      for (int m0 = gw * 4; m0 < M; m0 += NGW * 4) {
          f32x4 v[4][4];
#pragma unroll
          for (int r = 0; r < 4; ++r) { const gf32x4* xr = (const gf32x4*)(x + (size_t)(m0 + r) * D) + lane;
#pragma unroll
              for (int j = 0; j < 4; ++j) v[r][j] = xr[64 * j]; }
#pragma unroll
          for (int r = 0; r < 4; ++r) { float s = 0.f;
#pragma unroll
              for (int j = 0; j < 4; ++j) s += (v[r][j].x * v[r][j].x + v[r][j].y * v[r][j].y) + (v[r][j].z * v[r][j].z + v[r][j].w * v[r][j].w);
              s = wave_sum(s); if (lane == 0) ssq0[m0 + r] = s;
              gv2u* o8 = (gv2u*)(xa + (size_t)(m0 + r) * D) + lane;
#pragma unroll
              for (int j = 0; j < 4; ++j) { v2u o; o.x = pk2(v[r][j].x, v[r][j].y); o.y = pk2(v[r][j].z, v[r][j].w); o8[64 * j] = o; } }
      } }
    { const int gt = blockIdx.x * (NWAVES * 64) + tid, NT = G * NWAVES * 64;
      gf32* lut = (gf32*)(ws + WS_TAB + TAB_LUT);
      if (gt < 32) ((gf32*)(ws + WS_TAB + TAB_THR))[gt] = (float)(THETA_D[gt] * 0.15915494309189535);
      for (int idx = gt; idx < NH * 128; idx += NT) { const int h = idx >> 7, d = idx & 127;
          int bk = d; if (d >= 16) { bk = 16 + (int)(logf((float)d * (1.0f / 16.0f)) / 2.0794415416798357f * 16.0f); if (bk > 31) bk = 31; }
          lut[idx] = a.in[15][bk * NH + h]; }
      gf32* lut2 = (gf32*)(ws + WS_TAB + TAB_LUT2);
      for (int idx = gt; idx < NH * 1536; idx += NT) { const int h = idx / 1536, w = idx % 1536, c = w / 336, i = w % 336;
          float v = -1e30f;
          if (c < 4) { const int d = 255 - (i + c);
              if (d > 127) v = 0.f;
              else if (d >= 0) { int bk = d; if (d >= 16) { bk = 16 + (int)(logf((float)d * (1.0f / 16.0f)) / 2.0794415416798357f * 16.0f); if (bk > 31) bk = 31; }
                  v = (a.in[15][bk * NH + h] - a.in[15][31 * NH + h]) * 1.4426950408889634f; } }
          lut2[idx] = v; }
    }
}

__device__ __forceinline__ void conv_item(const DArgs& a, int l, int e, int wave, int lane) {
    gu8* ws = a.ws; const gf32* cw = a.in[14] + l * 768;
    const gbf* PB = (const gbf*)(ws + WS_PB);
    const gbf*Pb = PB + 4 * PANEL, *Pc = PB + 5 * PANEL, *Ph = PB + 6 * PANEL, *Pg = PB + 7 * PANEL;
    gbf* Y = (gbf*)(ws + WS_XB);
    const int tok0 = e * 64 + wave * 8, t0 = tok0 & (T - 1); const size_t o0 = (size_t)tok0 * 256 + 4 * lane;
    v2u bb[8], gg[8], cc[10], hh[10];
#pragma unroll
    for (int i = 0; i < 8; ++i) { bb[i] = *(const gv2u*)(Pb + o0 + i * 256); gg[i] = *(const gv2u*)(Pg + o0 + i * 256); cc[i + 2] = *(const gv2u*)(Pc + o0 + i * 256); hh[i + 2] = *(const gv2u*)(Ph + o0 + i * 256); }
    cc[0] = cc[1] = hh[0] = hh[1] = (v2u){0u, 0u};
    if (t0 >= 2) { cc[0] = *(const gv2u*)(Pc + o0 - 512); hh[0] = *(const gv2u*)(Ph + o0 - 512); cc[1] = *(const gv2u*)(Pc + o0 - 256); hh[1] = *(const gv2u*)(Ph + o0 - 256); }
    const f32x4 w0 = *(const gf32x4*)(cw + 4 * lane), w1 = *(const gf32x4*)(cw + 256 + 4 * lane), w2 = *(const gf32x4*)(cw + 512 + 4 * lane);
#pragma unroll
    for (int i = 0; i < 8; ++i) {
        float out[4];
#pragma unroll
        for (int j = 0; j < 4; ++j) {
            const unsigned sh = (j & 1) * 16; const int hi = j >> 1;
#define EL(v) bf2f(((hi ? (v).y : (v).x) >> sh) & 0xffffu)
            const float u0 = EL(cc[i + 2]) * EL(hh[i + 2]), u1 = EL(cc[i + 1]) * EL(hh[i + 1]), u2 = EL(cc[i]) * EL(hh[i]);
            out[j] = EL(bb[i]) * (w0[j] * u2 + w1[j] * u1 + w2[j] * u0) * EL(gg[i]);
#undef EL
        }
        v2u w; w.x = cvtpk(out[0], out[1]); w.y = cvtpk(out[2], out[3]);
        *(gv2u*)(Y + (size_t)(tok0 + i) * D + 256 + 4 * lane) = w;
    }
}

constexpr int QN_SCAN = 32, QN_ATT = 512, QN_CONV = M / 64, QN_OUT = 256, QN_ALL = QN_SCAN + QN_ATT + QN_CONV + QN_OUT;
constexpr int QW_HEAD = 0, QW_CNT = 64, QW_SCANDONE = 64 * 40, QW_LAYER = 4096;
__device__ __forceinline__ bool q_wait_ge(GAS unsigned* w, unsigned need, GAS unsigned* tmo) {
    unsigned sp = 0; bool ok = true;
    while (__hip_atomic_load(w, __ATOMIC_RELAXED, __HIP_MEMORY_SCOPE_AGENT) < need) {
        __builtin_amdgcn_s_sleep(2);
        if ((++sp & 255u) == 0u) { if (__hip_atomic_load(tmo, __ATOMIC_RELAXED, __HIP_MEMORY_SCOPE_AGENT) != 0u) { ok = false; break; }
                                   if (sp > (1u << 20)) { __hip_atomic_store(tmo, 1u, __ATOMIC_RELAXED, __HIP_MEMORY_SCOPE_AGENT); ok = false; break; } }
    }
    __builtin_amdgcn_fence(__ATOMIC_ACQUIRE, "agent");
    asm volatile("s_waitcnt vmcnt(0)" ::: "memory");
    return ok;
}
__device__ __forceinline__ void q_publish(GAS unsigned* w, unsigned add) {
    __builtin_amdgcn_fence(__ATOMIC_RELEASE, "agent");
    asm volatile("s_waitcnt vmcnt(0)" ::: "memory");
    __hip_atomic_fetch_add(w, add, __ATOMIC_RELAXED, __HIP_MEMORY_SCOPE_AGENT);
}
__device__ __forceinline__ void mix_phase(const DArgs& a0_, int l, int qblk, LAS unsigned char* lds, int wave, int lane0_, int tid) {
    GAS unsigned* qw = (GAS unsigned*)(a0_.ws + WS_CTL + CTL_Q) + qblk * QW_LAYER;
    GAS unsigned* tmo = (GAS unsigned*)(a0_.ws + WS_CTL) + 8;
    volatile LAS unsigned* qslot = (volatile LAS unsigned*)(lds + MISC_OFF + 64);
    {
        R1In inA, inB; int staged_h = -1;
        if ((int)blockIdx.x < BATCH * NH * 32) r1_load(inA, a0_.ws, blockIdx.x, tid);
        for (int item = blockIdx.x; item < BATCH * NH * 32; item += gridDim.x) {
            int ln2; asm volatile("v_mbcnt_lo_u32_b32 %0, -1, 0\n\tv_mbcnt_hi_u32_b32 %0, -1, %0" : "=v"(ln2));
            const int td2 = wave * 64 + ln2;
            const int h = (item >> 5) & 3;
            if (h != staged_h) { __syncthreads(); r1_stage_lora_w(a0_, l, h, lds, td2); staged_h = h; }
            const int nx = item + (int)gridDim.x < BATCH * NH * 32 ? item + (int)gridDim.x : -1;
            rwkv_chunk_item(a0_.ws, a0_, l, item, inA, nx, inB, lds, wave, ln2, td2);
            inA = inB;
        }
    }
    asm volatile("s_waitcnt vmcnt(0)" ::: "memory"); __syncthreads();
    if (tid == 0) { __builtin_amdgcn_fence(__ATOMIC_RELEASE, "agent"); asm volatile("s_waitcnt vmcnt(0)" ::: "memory");
        for (int item = blockIdx.x; item < BATCH * NH * 32; item += gridDim.x) __hip_atomic_fetch_add(qw + QW_CNT + 64 * (item >> 5), 1u, __ATOMIC_RELAXED, __HIP_MEMORY_SCOPE_AGENT);
    }
    bool out_ready = false;
    for (int it = 0;; ++it) {
        if (tid == 0) qslot[it & 1] = __hip_atomic_fetch_add(qw + QW_HEAD, 1u, __ATOMIC_RELAXED, __HIP_MEMORY_SCOPE_AGENT);
        __syncthreads();
        const int u = (int)__builtin_amdgcn_readfirstlane(qslot[it & 1]);
        if (u >= QN_ALL) break;
        DArgs al = a0_;
        { _Pragma("unroll") for (int i_ = 0; i_ < 17; ++i_) asm volatile("" : "+s"(al.in[i_])); asm volatile("" : "+s"(al.out), "+s"(al.ws)); }
        int lane; asm volatile("v_mbcnt_lo_u32_b32 %0, -1, 0\n\tv_mbcnt_hi_u32_b32 %0, -1, %0" : "=v"(lane));
        if (u < QN_SCAN) {
            if (tid == 0) (void)q_wait_ge(qw + QW_CNT + 64 * u, 32u, tmo);
            __syncthreads();
            rwkv_scan(al.ws, (const gu8*)al.out, u, lds, wave, lane);
            asm volatile("s_waitcnt vmcnt(0)" ::: "memory"); __syncthreads();
            if (tid == 0) q_publish(qw + QW_SCANDONE, 1u);
        } else if (u < QN_SCAN + QN_ATT) {
            attn_dispatch(al.ws, l, u - QN_SCAN, lds, wave, lane);
            if (PROBE_DUP == 20 || (PROBE_DUP == 21 && ((u - QN_SCAN) >> 5 & 1) == 0) || (PROBE_DUP == 22 && ((u - QN_SCAN) >> 5 & 1) == 1)) { __syncthreads(); attn_dispatch(al.ws, l, u - QN_SCAN, lds, wave, lane); }
        } else if (u < QN_SCAN + QN_ATT + QN_CONV) {
            conv_item(al, l, u - QN_SCAN - QN_ATT, wave, lane);
        } else {
            if (!out_ready) { if (tid == 0) (void)q_wait_ge(qw + QW_SCANDONE, (unsigned)QN_SCAN, tmo); __syncthreads(); out_ready = true; }
            rwkv_out_item(al.ws, al, l, u - QN_SCAN - QN_ATT - QN_CONV, wave, lane);
        }
    }
}

__global__ void __launch_bounds__(NWAVES * 64, 2) hybrid_fwd(Args args) {
    extern __shared__ __attribute__((aligned(16))) unsigned char lds_raw[];
    LAS unsigned char* lds = (LAS unsigned char*)lds_raw;
    const int tid = threadIdx.x; const int wave = __builtin_amdgcn_readfirstlane(tid >> 6);
    volatile LAS unsigned* MISC = (volatile LAS unsigned*)(lds + MISC_OFF);
    for (int u = tid; u < (LDS_BYTES - LDSCTL_OFF) / 4; u += NWAVES * 64) ((LAS unsigned*)(lds + LDSCTL_OFF))[u] = 0u;
    __syncthreads();
    unsigned char* ws = args.ws;
    unsigned* ctl = (unsigned*)(ws + WS_CTL);
    const int lo = (N_LAUNCHES == 1) ? 0 : args.ph_lo, hi = (N_LAUNCHES == 1) ? N_PHASES : args.ph_hi;
    XcdBarrier bar; bar.bar = ctl + CW_BAR; bar.x = 0; bar.st = nullptr;
    if (hi - lo > 1) bar = xcd_barrier_post(ctl + CW_BAR, MISC + 8);
#define IN(k) (lo <= (k) && (k) < hi)
#define SEAM(k) do { if (IN(k) && IN((k) + 1)) { XcdBarrier b_ = bar; asm volatile("" : "+s"(b_.bar), "+s"(b_.x)); xcd_barrier(b_); } } while (0)

#define FRESH_ARGS() DArgs A; { _Pragma("unroll") for (int i_ = 0; i_ < 17; ++i_) { A.in[i_] = (const gf32*)args.in[i_]; asm volatile("" : "+s"(A.in[i_])); } A.out = (gf32*)args.out; A.ws = (gu8*)args.ws; asm volatile("" : "+s"(A.out), "+s"(A.ws)); } \
    int wv = wave; asm volatile("" : "+s"(wv)); int ln; asm volatile("v_mbcnt_lo_u32_b32 %0, -1, 0\n\tv_mbcnt_hi_u32_b32 %0, -1, %0" : "=v"(ln)); int td = wv * 64 + ln;
    if (IN(0)) { for (int rep = 0; rep < (PROBE_DUP == 7 ? 2 : 1); ++rep) { FRESH_ARGS(); phase_prologue(A, lds, wv, ln, td); } }
    SEAM(0);
    for (int l = 0; l < DEPTH; ++l) {
        const int pb = 1 + 3 * l;
        if (IN(pb)) {
            for (int rep = 0; rep < (PROBE_DUP == 6 ? 2 : 1); ++rep) {
            FRESH_ARGS(); unsigned char* w_ = (unsigned char*)A.ws;
            pg8::Gemm g{(const pg8::bf16_t*)(w_ + WS_XA), (const pg8::bf16_t*)(w_ + WS_WIN) + (size_t)l * NPAD * D, M, NPAD, D};
            pg8::StaticOrder S; S.init(M, NPAD, gridDim.x, (int)blockIdx.x);
            pg8::EpiWin E{(pg8::bf16_t*)(w_ + WS_PB), (const float*)(w_ + WS_CTL + CTL_SSQ) + (size_t)l * M, (const float*)(w_ + WS_TAB + TAB_THR), (float*)(w_ + WS_CTL + CTL_KM) + l * 64 * 256};
            pg8::gemm_phase<pg8::EpiWin, pg8::StaticOrder, PG8_ALIGN, PG8_SP2>(lds + RING_OFF, g, S, E, td);
            if (l == 0 && gridDim.x == 256) {
                pg8::Unit u5; if (!S.next(4, u5)) convert_weights(A, W_LATER, DEPTH * I_L, ((int)blockIdx.x - 64) * NWAVES + wv, 192 * NWAVES, lds, wv, ln);
            }
            if (PROBE_DUP == 6) __syncthreads();
            if (PROBE_DUP == 12) { __syncthreads(); pg8::EpiNull EN; pg8::gemm_phase<pg8::EpiNull, pg8::StaticOrder, PG8_ALIGN, PG8_SP2>(lds + RING_OFF, g, S, EN, td); }
            }
        }
        SEAM(pb);
        if (IN(pb + 1)) { for (int rep = 0; rep < (PROBE_DUP == 10 ? 2 : 1); ++rep) { FRESH_ARGS(); mix_phase(A, l, l + 2 * rep, lds, wv, ln, td); } }
        SEAM(pb + 1);
        if (IN(pb + 2)) {
            FRESH_ARGS(); unsigned char* w_ = (unsigned char*)A.ws;
            pg8::Gemm g{(const pg8::bf16_t*)(w_ + WS_XB), (const pg8::bf16_t*)(w_ + WS_WOUT) + (size_t)l * D * D, M, D, D};
            pg8::StaticOrder S; S.init(M, D, gridDim.x, (int)blockIdx.x);
            if (l + 1 < DEPTH) {
                pg8::EpiWout E{(const pg8::bf16_t*)(w_ + WS_XA), (pg8::bf16_t*)(w_ + WS_XA), (float*)(w_ + WS_CTL + CTL_SSQ) + (size_t)(l + 1) * M};
                pg8::gemm_phase<pg8::EpiWout, pg8::StaticOrder, PG8_ALIGN, PG8_SP2>(lds + RING_OFF, g, S, E, td);
            } else {
                pg8::EpiWoutFinal E{(const pg8::bf16_t*)(w_ + WS_XA), (float*)A.out, (float*)(w_ + WS_SSQP), (unsigned*)(w_ + WS_CTL + CTL_Q) + 3 * QW_LAYER, (const float*)A.in[16], (unsigned*)(w_ + WS_CTL) + 8};
                pg8::gemm_phase<pg8::EpiWoutFinal, pg8::StaticOrder, false, PG8_SP2>(lds + RING_OFF, g, S, E, td);
            }
        }
        if (l + 1 < DEPTH) SEAM(pb + 2);
    }
#undef IN
#undef SEAM
}

extern "C" void kernel_launch(void* const* d_in, const int* in_sizes, int n_in, void* d_out, int out_size, void* d_ws, size_t ws_size, hipStream_t stream) {
    static int grid = 0;
    if (grid == 0) {
        if (n_in != 17 || in_sizes[0] != M * D || out_size != M * D || ws_size < WS_END) { fprintf(stderr, "kernel_launch: unexpected shapes (n_in %d, in0 %d, out %d, ws %zu); nothing launched\n", n_in, n_in > 0 ? in_sizes[0] : -1, out_size, ws_size); grid = -1; return; }
        int dev = 0, cus = 0, per_cu = 0;
        if (hipGetDevice(&dev) != hipSuccess || hipDeviceGetAttribute(&cus, hipDeviceAttributeMultiprocessorCount, dev) != hipSuccess) { grid = -1; return; }
        if (hipFuncSetAttribute((const void*)hybrid_fwd, hipFuncAttributeMaxDynamicSharedMemorySize, LDS_BYTES) != hipSuccess) { fprintf(stderr, "kernel_launch: hipFuncSetAttribute failed\n"); grid = -1; return; }
        if (hipOccupancyMaxActiveBlocksPerMultiprocessor(&per_cu, (const void*)hybrid_fwd, NWAVES * 64, LDS_BYTES) != hipSuccess || per_cu < 1)
            fprintf(stderr, "kernel_launch: note: occupancy query reports %d workgroups per CU\n", per_cu);
        (void)hipGetLastError();
        grid = cus;
    }
    if (grid < 0) return;
    if (hipMemsetAsync((char*)d_ws + WS_CTL, 0, CTL_ZERO_BYTES, stream) != hipSuccess) { fprintf(stderr, "kernel_launch: hipMemsetAsync failed\n"); return; }
    Args a{};
    for (int i = 0; i < 17; ++i) a.in[i] = (const float*)d_in[i];
    a.out = (float*)d_out; a.ws = (unsigned char*)d_ws;
    if (N_LAUNCHES == 1) {
        a.ph_lo = 0; a.ph_hi = N_PHASES; a.li = 0;
        hipLaunchKernelGGL(hybrid_fwd, dim3(grid), dim3(NWAVES * 64), LDS_BYTES, stream, a);
    } else {
        for (int p = 0; p < N_PHASES; ++p) { a.ph_lo = p; a.ph_hi = p + 1; a.li = p;
            hipLaunchKernelGGL(hybrid_fwd, dim3(grid), dim3(NWAVES * 64), LDS_BYTES, stream, a); }
    }
    const hipError_t le = hipPeekAtLastError();
    if (le != hipSuccess) fprintf(stderr, "kernel_launch: launch failed: %s\n", hipGetErrorName(le));
}
```

```cpp
#include <hip/hip_runtime.h>
#include <cstdio>
#include <cstdint>
namespace pg8 {
#define PG8_LAS __attribute__((address_space(3)))
typedef unsigned short bf16_t;
typedef short bf16x8 __attribute__((ext_vector_type(8)));
typedef float f32x4 __attribute__((ext_vector_type(4)));
typedef unsigned u32x4 __attribute__((ext_vector_type(4)));
constexpr int BM = 256, BK = 64, HALF = 128, HTB = HALF * BK * 2  , STAGE_BYTES = 8 * HTB, NXCD = 8, WGM = 8;

__host__ __device__ __forceinline__ int lds_byte(int r, int c) { const int st = (r >> 4) * 2 + (c >> 5), rr = r & 15, cc = c & 31, ob = rr * 64 + cc * 2; return st * 1024 + (ob ^ (((ob >> 9) & 1) << 5)); }
__host__ __device__ __forceinline__ void stage_rc(int b, int& R, int& C) { const int st = b / 1024, sb = b % 1024, swz = sb ^ (((sb >> 9) & 1) << 5); R = (st >> 1) * 16 + swz / 64; C = (st & 1) * 32 + (swz % 64) / 2; }
__host__ __device__ __forceinline__ int perm32(int rho) { const int n = rho >> 4, i = rho & 15; return 8 * (i >> 2) + 4 * n + (i & 3); }

struct Unit { int pm, pn; };
struct Gemm { const bf16_t* A; const bf16_t* Bt; int M, N, K; };

struct StaticOrder {
    int nM, nN, nwg, G, c;
    __host__ __device__ void init(int M, int N, int G_, int c_) { nM = M / BM; nN = N / BM; nwg = nM * nN; G = G_; c = c_; }
    __host__ __device__ bool next(int i, Unit& u) const {
        const long L = (long)i * G + c; if (L >= nwg) return false;
        int wgid = (int)L; { const int q = nwg / NXCD, r = nwg % NXCD, xcd = wgid % NXCD, off = wgid / NXCD; wgid = (xcd < r ? xcd * (q + 1) : r * (q + 1) + (xcd - r) * q) + off; }
        const int nig = WGM * nN, gid = wgid / nig, fm = gid * WGM, gsz = (nM - fm) < WGM ? (nM - fm) : WGM;
        u.pm = fm + ((wgid % nig) % gsz); u.pn = (wgid % nig) / gsz; return true;
    }
    __device__ __forceinline__ void a_ready(const Unit&) const {}
    __device__ __forceinline__ void done(const Unit&) const {}
};
typedef float f32x2_e __attribute__((ext_vector_type(2))); typedef __bf16 bf16x2_e __attribute__((ext_vector_type(2)));
__device__ __forceinline__ unsigned cvt_pk_bf16(float lo, float hi) { f32x2_e v = {lo, hi}; bf16x2_e b = __builtin_convertvector(v, bf16x2_e); return __builtin_bit_cast(unsigned, b); }

constexpr int EP_M = 16384;
#define PG8_GAS __attribute__((address_space(1)))
struct EpiWin {
    static constexpr bool PERM = true, AFTER_DRAIN = false;
    bf16_t* PB; const float* ssq; const float* thr; float* KM;
    __device__ __forceinline__ void operator()(const f32x4 (&acc)[2][2][4][2], const Unit& u, int wr, int wc, int fr, int fq) const {
        const int pn = u.pn;
        PG8_GAS bf16_t* PB_ = (PG8_GAS bf16_t*)PB; const PG8_GAS float* ssq_ = (const PG8_GAS float*)ssq; const PG8_GAS float* thr_ = (const PG8_GAS float*)thr; PG8_GAS float* KM_ = (PG8_GAS float*)KM;
        asm volatile("" : "+s"(PB_), "+s"(ssq_), "+s"(thr_), "+s"(KM_));
        const int rowb = u.pm * BM + wr * 64 + fr;
        const bool do_silu = (pn == 3 || pn == 7 || pn == 11 || pn == 15);
        const bool do_rot = (pn == 12 || pn == 13);
        const float scl = pn == 8 ? 0.125f * 1.4426950408889634f : (pn == 13 ? 0.125f : 1.0f);
        const bool do_km = (pn == 9);
        const bool lora = (pn == 16);
        PG8_GAS bf16_t* base = PB_ + (size_t)pn * ((size_t)EP_M * 256);
        const int ldc = lora ? 64 : 256;
        float rsv[2][4];
#pragma unroll
        for (int ai = 0; ai < 2; ++ai)
#pragma unroll
            for (int m = 0; m < 4; ++m) rsv[ai][m] = ssq_[rowb + ai * HALF + m * 16];
        f32x4 th[2] = {{0.f, 0.f, 0.f, 0.f}, {0.f, 0.f, 0.f, 0.f}};
        if (do_rot) {
#pragma unroll
            for (int bj = 0; bj < 2; ++bj) th[bj] = *(const PG8_GAS f32x4*)(thr_ + (((bj * HALF + wc * 32 + 8 * fq) & 63) >> 1));
        }
#pragma unroll
        for (int ai = 0; ai < 2; ++ai)
#pragma unroll
            for (int m = 0; m < 4; ++m) rsv[ai][m] = rsqrtf(rsv[ai][m] * (1.0f / 1024.0f) + 1e-6f);
        float cs[2][8];
#pragma unroll
        for (int bj = 0; bj < 2; ++bj)
#pragma unroll
            for (int j = 0; j < 8; ++j) cs[bj][j] = 0.f;
#pragma unroll
        for (int ai = 0; ai < 2; ++ai)
#pragma unroll
            for (int m = 0; m < 4; ++m) {
                const int row = rowb + ai * HALF + m * 16;
                const float rs = rsv[ai][m];
#pragma unroll
                for (int bj = 0; bj < 2; ++bj) {
                    const int c8 = bj * HALF + wc * 32 + 8 * fq;
                    float v[8];
#pragma unroll
                    for (int j = 0; j < 4; ++j) { v[j] = acc[ai][bj][m][0][j] * rs; v[4 + j] = acc[ai][bj][m][1][j] * rs; }
                    if (do_silu) {
#pragma unroll
                        for (int j = 0; j < 8; ++j) v[j] = v[j] * __builtin_amdgcn_rcpf(1.0f + __expf(-v[j]));
                    }
                    if (do_rot) {
                        const int pos = row & 2047; const float fpos = (float)pos;
#pragma unroll
                        for (int j = 0; j < 4; ++j) {
                            float rev = fpos * th[bj][j]; rev = rev - floorf(rev);
                            const float cj = __builtin_amdgcn_cosf(rev), sj = __builtin_amdgcn_sinf(rev);
                            const float a = v[2 * j], b = v[2 * j + 1]; v[2 * j] = a * cj - b * sj; v[2 * j + 1] = a * sj + b * cj; }
                        const float lgm = __log2f(1.0f - __builtin_amdgcn_exp2f(-5.0f - (float)(c8 >> 6))) * (float)(pos & 255);
                        const float fdec = __builtin_amdgcn_exp2f(pn == 12 ? lgm : -lgm);
#pragma unroll
                        for (int j = 0; j < 8; ++j) v[j] *= fdec;
                    }
#pragma unroll
                    for (int j = 0; j < 8; ++j) v[j] *= scl;
                    if (do_km) {
#pragma unroll
                        for (int j = 0; j < 8; ++j) cs[bj][j] += v[j];
                    }
                    u32x4 w; w.x = cvt_pk_bf16(v[0], v[1]); w.y = cvt_pk_bf16(v[2], v[3]); w.z = cvt_pk_bf16(v[4], v[5]); w.w = cvt_pk_bf16(v[6], v[7]);
                    if (!lora || c8 < 64) *(PG8_GAS u32x4*)(base + (size_t)row * ldc + c8) = w;
                }
            }
        if (do_km) {
#pragma unroll
            for (int bj = 0; bj < 2; ++bj)
#pragma unroll
                for (int j = 0; j < 8; ++j) {
                    float s = cs[bj][j];
                    s += __shfl_xor(s, 1); s += __shfl_xor(s, 2); s += __shfl_xor(s, 4); s += __shfl_xor(s, 8);
                    if (fr == 0) __hip_atomic_fetch_add(KM_ + u.pm * 256 + bj * HALF + wc * 32 + 8 * fq + j, s, __ATOMIC_RELAXED, __HIP_MEMORY_SCOPE_AGENT);
                }
        }
    }
};
struct EpiWout {
    static constexpr bool PERM = true, AFTER_DRAIN = false;
    const bf16_t* xin; bf16_t* xb; float* ssq_next;
    __device__ __forceinline__ void operator()(const f32x4 (&acc)[2][2][4][2], const Unit& u, int wr, int wc, int fr, int fq) const {
        const PG8_GAS bf16_t* xin_ = (const PG8_GAS bf16_t*)xin; PG8_GAS bf16_t* xb_ = (PG8_GAS bf16_t*)xb; PG8_GAS float* ssq_next_ = (PG8_GAS float*)ssq_next;
        asm volatile("" : "+s"(xin_), "+s"(xb_), "+s"(ssq_next_));
        const int rowb = u.pm * BM + wr * 64 + fr;
        u32x4 xv[2][4][2];
#pragma unroll
        for (int ai = 0; ai < 2; ++ai)
#pragma unroll
            for (int m = 0; m < 4; ++m)
#pragma unroll
                for (int bj = 0; bj < 2; ++bj) xv[ai][m][bj] = *(const PG8_GAS u32x4*)(xin_ + (size_t)(rowb + ai * HALF + m * 16) * 1024 + u.pn * BM + bj * HALF + wc * 32 + 8 * fq);
#pragma unroll
        for (int ai = 0; ai < 2; ++ai)
#pragma unroll
            for (int m = 0; m < 4; ++m) {
                const int row = rowb + ai * HALF + m * 16;
                float part = 0.f;
#pragma unroll
                for (int bj = 0; bj < 2; ++bj) {
                    const size_t off = (size_t)row * 1024 + u.pn * BM + bj * HALF + wc * 32 + 8 * fq;
                    const u32x4 xw = xv[ai][m][bj];
                    const f32x4 y0 = acc[ai][bj][m][0] + (f32x4){__uint_as_float(xw.x << 16), __uint_as_float(xw.x & 0xffff0000u), __uint_as_float(xw.y << 16), __uint_as_float(xw.y & 0xffff0000u)};
                    const f32x4 y1 = acc[ai][bj][m][1] + (f32x4){__uint_as_float(xw.z << 16), __uint_as_float(xw.z & 0xffff0000u), __uint_as_float(xw.w << 16), __uint_as_float(xw.w & 0xffff0000u)};
                    part += (y0[0] * y0[0] + y0[1] * y0[1]) + (y0[2] * y0[2] + y0[3] * y0[3]) + (y1[0] * y1[0] + y1[1] * y1[1]) + (y1[2] * y1[2] + y1[3] * y1[3]);
                    u32x4 w; w.x = cvt_pk_bf16(y0[0], y0[1]); w.y = cvt_pk_bf16(y0[2], y0[3]); w.z = cvt_pk_bf16(y1[0], y1[1]); w.w = cvt_pk_bf16(y1[2], y1[3]); *(PG8_GAS u32x4*)(xb_ + off) = w;
                }
                part += __shfl_xor(part, 16); part += __shfl_xor(part, 32);
                if (fq == 0) __hip_atomic_fetch_add(ssq_next_ + row, part, __ATOMIC_RELAXED, __HIP_MEMORY_SCOPE_AGENT);
            }
    }
};
struct EpiWoutFinal {
    static constexpr bool PERM = true, AFTER_DRAIN = true;
    const bf16_t* xin; float* out; float* part; unsigned* cnt; const float* fw; unsigned* tmo;
    __device__ __forceinline__ void fused(f32x4 (&acc)[2][2][4][2], const Unit& u, int wr, int wc, int fr, int fq, PG8_LAS unsigned char*, int wid, int lane) const {
        const PG8_GAS bf16_t* xin_ = (const PG8_GAS bf16_t*)xin; PG8_GAS float* out_ = (PG8_GAS float*)out; PG8_GAS float* part_ = (PG8_GAS float*)part; PG8_GAS unsigned* cnt_ = (PG8_GAS unsigned*)cnt;
        const PG8_GAS float* fw_ = (const PG8_GAS float*)fw; PG8_GAS unsigned* tmo_ = (PG8_GAS unsigned*)tmo;
        asm volatile("" : "+s"(xin_), "+s"(out_), "+s"(part_), "+s"(cnt_), "+s"(fw_), "+s"(tmo_));
        const int rowb = u.pm * BM + wr * 64 + fr;
#pragma unroll
        for (int ai = 0; ai < 2; ++ai) {
            u32x4 xv[4][2];
#pragma unroll
            for (int m = 0; m < 4; ++m)
#pragma unroll
                for (int bj = 0; bj < 2; ++bj) xv[m][bj] = *(const PG8_GAS u32x4*)(xin_ + (size_t)(rowb + ai * HALF + m * 16) * 1024 + u.pn * BM + bj * HALF + wc * 32 + 8 * fq);
#pragma unroll
            for (int m = 0; m < 4; ++m) {
                const int row = rowb + ai * HALF + m * 16; float ps = 0.f;
#pragma unroll
                for (int bj = 0; bj < 2; ++bj) {
                    const u32x4 xw = xv[m][bj];
                    acc[ai][bj][m][0] += (f32x4){__uint_as_float(xw.x << 16), __uint_as_float(xw.x & 0xffff0000u), __uint_as_float(xw.y << 16), __uint_as_float(xw.y & 0xffff0000u)};
                    acc[ai][bj][m][1] += (f32x4){__uint_as_float(xw.z << 16), __uint_as_float(xw.z & 0xffff0000u), __uint_as_float(xw.w << 16), __uint_as_float(xw.w & 0xffff0000u)};
                    const f32x4 y0 = acc[ai][bj][m][0], y1 = acc[ai][bj][m][1];
                    ps += (y0[0] * y0[0] + y0[1] * y0[1]) + (y0[2] * y0[2] + y0[3] * y0[3]) + (y1[0] * y1[0] + y1[1] * y1[1]) + (y1[2] * y1[2] + y1[3] * y1[3]);
                }
                ps += __shfl_xor(ps, 16); ps += __shfl_xor(ps, 32);
                if (fq == 0) __hip_atomic_store((PG8_GAS unsigned*)(part_ + (size_t)row * 16 + u.pn * 4 + wc), __float_as_uint(ps), __ATOMIC_RELAXED, __HIP_MEMORY_SCOPE_AGENT);
            }
        }
        asm volatile("s_waitcnt vmcnt(0)" ::: "memory");
        __syncthreads();
        if (wid == 0 && lane == 0) {
            __hip_atomic_fetch_add(cnt_ + 64 * u.pm, 1u, __ATOMIC_RELAXED, __HIP_MEMORY_SCOPE_AGENT);
            unsigned sp = 0;
            while (__hip_atomic_load(cnt_ + 64 * u.pm, __ATOMIC_RELAXED, __HIP_MEMORY_SCOPE_AGENT) < 4u) {
                __builtin_amdgcn_s_sleep(1);
                if ((++sp & 255u) == 0u) { if (__hip_atomic_load(tmo_, __ATOMIC_RELAXED, __HIP_MEMORY_SCOPE_AGENT) != 0u) break; if (sp > (1u << 20)) { __hip_atomic_store(tmo_, 1u, __ATOMIC_RELAXED, __HIP_MEMORY_SCOPE_AGENT); break; } }
            }
            __builtin_amdgcn_fence(__ATOMIC_ACQUIRE, "agent");
            asm volatile("s_waitcnt vmcnt(0)" ::: "memory");
        }
        __syncthreads();
        f32x4 wv[2][2];
#pragma unroll
        for (int bj = 0; bj < 2; ++bj) { const int col = u.pn * BM + bj * HALF + wc * 32 + 8 * fq; wv[bj][0] = *(const PG8_GAS f32x4*)(fw_ + col); wv[bj][1] = *(const PG8_GAS f32x4*)(fw_ + col + 4); }
#pragma unroll
        for (int ai = 0; ai < 2; ++ai)
#pragma unroll
            for (int m = 0; m < 4; ++m) {
                const int row = rowb + ai * HALF + m * 16;
                const PG8_GAS f32x4* sp4 = (const PG8_GAS f32x4*)(part_ + (size_t)row * 16); const f32x4 q0 = sp4[0], q1 = sp4[1], q2 = sp4[2], q3 = sp4[3];
                const float sq = ((q0[0] + q0[1]) + (q0[2] + q0[3])) + ((q1[0] + q1[1]) + (q1[2] + q1[3])) + ((q2[0] + q2[1]) + (q2[2] + q2[3])) + ((q3[0] + q3[1]) + (q3[2] + q3[3]));
                const float rs = rsqrtf(sq * (1.0f / 1024.0f) + 1e-6f);
#pragma unroll
                for (int bj = 0; bj < 2; ++bj) {
                    const size_t off = (size_t)row * 1024 + u.pn * BM + bj * HALF + wc * 32 + 8 * fq;
                    *(PG8_GAS f32x4*)(out_ + off) = acc[ai][bj][m][0] * rs * wv[bj][0]; *(PG8_GAS f32x4*)(out_ + off + 4) = acc[ai][bj][m][1] * rs * wv[bj][1];
                }
            }
    }
};
struct EpiNull {
    static constexpr bool PERM = true, AFTER_DRAIN = false;
    __device__ __forceinline__ void operator()(const f32x4 (&acc)[2][2][4][2], const Unit&, int, int, int, int) const {
#pragma unroll
        for (int ai = 0; ai < 2; ++ai)
#pragma unroll
            for (int bj = 0; bj < 2; ++bj)
#pragma unroll
                for (int m = 0; m < 4; ++m)
#pragma unroll
                    for (int n = 0; n < 2; ++n) asm volatile("" :: "v"(acc[ai][bj][m][n]));
    }
};
template <class Epi, class Sched, bool ALIGN_EPI = false, bool SP2 = false>
__device__ __forceinline__ void gemm_phase(PG8_LAS unsigned char* lds, const Gemm g, const Sched& S, const Epi& E, int tid_in) {
    int tid_ = tid_in; asm volatile("" : "+v"(tid_));
    const int tid = tid_, wid = __builtin_amdgcn_readfirstlane(tid >> 6), lane = tid & 63, wr = wid >> 2, wc = wid & 3, fr = lane & 15, fq = lane >> 4;
    const int K = g.K, nt = K / BK;
    unsigned voffA[2], voffB[2];
#pragma unroll
    for (int i = 0; i < 2; ++i) { int R, C; stage_rc(tid * 16 + i * 8192, R, C); const int Rb = Epi::PERM ? ((R & ~31) + perm32(R & 31)) : R;
        voffA[i] = (unsigned)(R * K + C) * 2u; voffB[i] = (unsigned)(Rb * K + C) * 2u; }
    const size_t kstep = (size_t)(BK * 2);
    const size_t hstep = (size_t)HALF * K * 2;
    const size_t tstep = 2 * hstep;
    const unsigned ldsw = (unsigned)wid * 1024u;
    const int aoff = lds_byte(wr * 64 + fr, fq * 8), boff = lds_byte(wc * 32 + fr, fq * 8);
#define PG8_SA(b, h) (((b) * 2 + (h)) * HTB)
#define PG8_SB(b, h) ((4 + (b) * 2 + (h)) * HTB)
#define PG8_STAGE(bufoff, gbase, voff) do { _Pragma("unroll") for (int _i = 0; _i < 2; ++_i) \
        __builtin_amdgcn_global_load_lds((const unsigned*)((const char*)(gbase) + (voff)[_i]), (PG8_LAS unsigned*)(lds + (bufoff) + ldsw + _i * 8192), 16, 0, 0); } while (0)
#define PG8_LDA(dst, b, h) do { _Pragma("unroll") for (int m = 0; m < 4; ++m) _Pragma("unroll") for (int k = 0; k < 2; ++k) dst[m][k] = *(const PG8_LAS bf16x8*)(lds + PG8_SA(b, h) + aoff + m * 2048 + k * 1024); } while (0)
#define PG8_LDB(dst, b, h) do { _Pragma("unroll") for (int n = 0; n < 2; ++n) _Pragma("unroll") for (int k = 0; k < 2; ++k) dst[n][k] = *(const PG8_LAS bf16x8*)(lds + PG8_SB(b, h) + boff + n * 2048 + k * 1024); } while (0)
#define PG8_MMA(ai, bj, At, Bt) do { __builtin_amdgcn_s_setprio(1); _Pragma("unroll") for (int m = 0; m < 4; ++m) _Pragma("unroll") for (int n = 0; n < 2; ++n) _Pragma("unroll") for (int k = 0; k < 2; ++k) \
        acc[ai][bj][m][n] = __builtin_amdgcn_mfma_f32_16x16x32_bf16(Bt[n][k], At[m][k], acc[ai][bj][m][n], 0, 0, 0); __builtin_amdgcn_s_setprio(0); } while (0)
#define PG8_WAIT_V(n) asm volatile("s_waitcnt vmcnt(" #n ")" ::: "memory")
#define PG8_WAIT_L(n) asm volatile("s_waitcnt lgkmcnt(" #n ")" ::: "memory")
#define PG8_BAR __builtin_amdgcn_s_barrier()
#define PG8_SCHED __builtin_amdgcn_sched_barrier(0)
    Unit cur, nxt; int ui = 0;
    if (!S.next(0, cur)) return;
    f32x4 acc[2][2][4][2];
#pragma unroll
    for (int a = 0; a < 2; ++a)
#pragma unroll
        for (int b = 0; b < 2; ++b)
#pragma unroll
            for (int m = 0; m < 4; ++m)
#pragma unroll
                for (int n = 0; n < 2; ++n) acc[a][b][m][n] = (f32x4){0.f, 0.f, 0.f, 0.f};
    bf16x8 At[4][2], B0[2][2], B1[2][2];
    const char* cA = (const char*)g.A + (size_t)cur.pm * tstep; const char* cB = (const char*)g.Bt + (size_t)cur.pn * tstep;
    S.a_ready(cur);
    if constexpr (SP2) {
        PG8_STAGE(PG8_SB(0, 0), cB, voffB); PG8_STAGE(PG8_SB(0, 1), cB + hstep, voffB); PG8_STAGE(PG8_SA(0, 0), cA, voffA); PG8_STAGE(PG8_SA(0, 1), cA + hstep, voffA);
        if (wr == 1) PG8_BAR;
        PG8_WAIT_V(2); PG8_BAR;
        PG8_STAGE(PG8_SB(1, 0), cB + kstep, voffB); PG8_STAGE(PG8_SA(1, 0), cA + kstep, voffA); PG8_STAGE(PG8_SB(1, 1), cB + hstep + kstep, voffB);
        PG8_WAIT_V(6); PG8_BAR;
    } else {
        PG8_STAGE(PG8_SB(0, 0), cB, voffB); PG8_STAGE(PG8_SA(0, 0), cA, voffA); PG8_STAGE(PG8_SB(0, 1), cB + hstep, voffB); PG8_STAGE(PG8_SA(0, 1), cA + hstep, voffA);
        if (wr == 1) PG8_BAR;
        PG8_WAIT_V(4); PG8_BAR;
        PG8_STAGE(PG8_SB(1, 0), cB + kstep, voffB); PG8_STAGE(PG8_SA(1, 0), cA + kstep, voffA); PG8_STAGE(PG8_SB(1, 1), cB + hstep + kstep, voffB);
        PG8_WAIT_V(6); PG8_BAR;
    }
    for (;;) {
        const bool has_next = S.next(ui + 1, nxt);
        const char* nA = has_next ? (const char*)g.A + (size_t)nxt.pm * tstep : cA; const char* nB = has_next ? (const char*)g.Bt + (size_t)nxt.pn * tstep : cB;
        for (int t = 0; t < nt; t += 2) {
            const bool last = (t == nt - 2);
            const char* a1 = cA + (size_t)(t + 1) * kstep;
            const char* a2 = last ? nA : cA + (size_t)(t + 2) * kstep; const char* b2 = last ? nB : cB + (size_t)(t + 2) * kstep;
            const char* a3 = a2 + kstep; const char* b3 = b2 + kstep;
            if (last && has_next) S.a_ready(nxt);
            if constexpr (SP2) {
            PG8_LDB(B0, 0, 0); PG8_LDB(B1, 0, 1); PG8_SCHED; PG8_LDA(At, 0, 0); PG8_STAGE(PG8_SA(1, 1), a1 + hstep, voffA);
            PG8_WAIT_V(8); PG8_WAIT_L(0); PG8_BAR; PG8_MMA(0, 0, At, B0); PG8_MMA(0, 1, At, B1); PG8_BAR; PG8_SCHED;
            PG8_LDA(At, 0, 1); PG8_STAGE(PG8_SB(0, 0), b2, voffB); PG8_STAGE(PG8_SB(0, 1), b2 + hstep, voffB); PG8_STAGE(PG8_SA(0, 0), a2, voffA);
            PG8_WAIT_V(8); PG8_WAIT_L(0); PG8_BAR; PG8_MMA(1, 0, At, B0); PG8_MMA(1, 1, At, B1); PG8_BAR; PG8_SCHED;
            PG8_LDB(B0, 1, 0); PG8_LDB(B1, 1, 1); PG8_SCHED; PG8_LDA(At, 1, 0); PG8_STAGE(PG8_SA(0, 1), a2 + hstep, voffA);
            PG8_WAIT_V(8); PG8_WAIT_L(0); PG8_BAR; PG8_MMA(0, 0, At, B0); PG8_MMA(0, 1, At, B1); PG8_BAR; PG8_SCHED;
            PG8_LDA(At, 1, 1); PG8_STAGE(PG8_SB(1, 0), b3, voffB); PG8_STAGE(PG8_SB(1, 1), b3 + hstep, voffB); PG8_STAGE(PG8_SA(1, 0), a3, voffA);
            PG8_WAIT_V(8); PG8_WAIT_L(0); PG8_BAR; PG8_MMA(1, 0, At, B0); PG8_MMA(1, 1, At, B1); PG8_BAR; PG8_SCHED;
            } else {
            PG8_LDB(B0, 0, 0); PG8_SCHED; PG8_LDA(At, 0, 0); PG8_STAGE(PG8_SA(1, 1), a1 + hstep, voffA);
            PG8_WAIT_L(8); PG8_BAR; PG8_WAIT_L(0); PG8_MMA(0, 0, At, B0); PG8_BAR; PG8_SCHED;
            PG8_LDB(B1, 0, 1); PG8_STAGE(PG8_SB(0, 0), b2, voffB);
            PG8_BAR; PG8_WAIT_L(0); PG8_MMA(0, 1, At, B1); PG8_BAR;
            PG8_LDA(At, 0, 1); PG8_STAGE(PG8_SA(0, 0), a2, voffA);
            PG8_BAR; PG8_WAIT_L(0); PG8_MMA(1, 0, At, B0); PG8_BAR; PG8_SCHED;
            PG8_STAGE(PG8_SB(0, 1), b2 + hstep, voffB);
            PG8_WAIT_V(6); PG8_BAR; PG8_MMA(1, 1, At, B1); PG8_BAR;
            PG8_LDB(B0, 1, 0); PG8_SCHED; PG8_LDA(At, 1, 0); PG8_STAGE(PG8_SA(0, 1), a2 + hstep, voffA);
            PG8_WAIT_L(8); PG8_BAR; PG8_WAIT_L(0); PG8_MMA(0, 0, At, B0); PG8_BAR; PG8_SCHED;
            PG8_LDB(B1, 1, 1); PG8_STAGE(PG8_SB(1, 0), b3, voffB);
            PG8_BAR; PG8_WAIT_L(0); PG8_MMA(0, 1, At, B1); PG8_BAR;
            PG8_LDA(At, 1, 1); PG8_STAGE(PG8_SA(1, 0), a3, voffA);
            PG8_BAR; PG8_WAIT_L(0); PG8_MMA(1, 0, At, B0); PG8_BAR; PG8_SCHED;
            PG8_STAGE(PG8_SB(1, 1), b3 + hstep, voffB);
            PG8_WAIT_V(6); PG8_BAR; PG8_MMA(1, 1, At, B1); PG8_BAR;
            }
        }
        if constexpr (ALIGN_EPI) { if (wr == 0) PG8_BAR; }
        if constexpr (!Epi::AFTER_DRAIN) { E(acc, cur, wr, wc, fr, fq); S.done(cur); }
        if (!has_next) break;
#pragma unroll
        for (int a = 0; a < 2; ++a)
#pragma unroll
            for (int b = 0; b < 2; ++b)
#pragma unroll
                for (int m = 0; m < 4; ++m)
#pragma unroll
                    for (int n = 0; n < 2; ++n) acc[a][b][m][n] = (f32x4){0.f, 0.f, 0.f, 0.f};
        cur = nxt; cA = nA; cB = nB; ++ui;
        if constexpr (ALIGN_EPI) { if (wr == 1) PG8_BAR; }
    }
    PG8_WAIT_V(0);
    if constexpr (!ALIGN_EPI) { if (wr == 0) PG8_BAR; }
    PG8_BAR;
    if constexpr (Epi::AFTER_DRAIN) { E.fused(acc, cur, wr, wc, fr, fq, lds, wid, lane); S.done(cur); }
#undef PG8_SA
#undef PG8_SB
#undef PG8_STAGE
#undef PG8_LDA
#undef PG8_LDB
#undef PG8_MMA
#undef PG8_WAIT_V
#undef PG8_WAIT_L
#undef PG8_BAR
#undef PG8_SCHED
}
}
#ifndef PG8_SP2
#define PG8_SP2 true
#endif
#ifndef PG8_ALIGN
#define PG8_ALIGN true
#endif
#ifndef PROBE_DUP
#define PROBE_DUP 0
#endif
#ifndef ATT_STAGGER
#define ATT_STAGGER 2
#endif
#ifndef PROBE_R1
#define PROBE_R1 0
#endif
#ifndef PROBE_ATT
#define PROBE_ATT 0
#endif
#ifndef MK_N_LAUNCHES
#define MK_N_LAUNCHES 1
#endif

constexpr int NWAVES = 8;
constexpr int BATCH = 8, T = 2048, D = 1024, M = BATCH * T, DEPTH = 2;
constexpr int GW = 256, NH = 4, HD = 64, LORA = 32;
constexpr int WCOLS = 4160, NPAD = 4352, NMAIN = 4096;
constexpr int N_PHASES = 7;
constexpr int N_LAUNCHES = MK_N_LAUNCHES;

constexpr size_t MiB = 1u << 20;
constexpr size_t WS_CTL = 0, CTL_ZERO_BYTES = 1 * MiB;
constexpr size_t CTL_KM = 131072;
constexpr size_t CTL_SSQ = 262144;
constexpr size_t CTL_Q = 65536;
constexpr size_t WS_TAB = 1 * MiB;
constexpr size_t TAB_SIN = 262144, TAB_LUT = 524288, TAB_THR = 528384, TAB_LUT2 = 532480;
constexpr size_t WS_WIN = 2 * MiB;
constexpr size_t WS_WOUT = 19 * MiB;
constexpr size_t WS_XA = 23 * MiB;
constexpr size_t WS_XB = 55 * MiB;
constexpr size_t WS_PB = 87 * MiB;
constexpr size_t WS_R1 = 217 * MiB;
constexpr size_t WS_YRAW = 233 * MiB;
constexpr size_t WS_SB = 249 * MiB;
constexpr size_t WS_SSQP = 250 * MiB;
constexpr size_t WS_END = 253 * MiB;
constexpr size_t PANEL = (size_t)M * 256;
constexpr int CW_BAR = 4096;

constexpr int RING_OFF = 0, RING_BYTES = 131072;
constexpr int LDSCTL_OFF = RING_BYTES, MISC_OFF = LDSCTL_OFF + 320;
constexpr int LDS_BYTES = 147456;

#define GAS __attribute__((address_space(1)))
#define LAS __attribute__((address_space(3)))
typedef unsigned short bf16;
typedef unsigned v4u __attribute__((ext_vector_type(4)));
typedef unsigned v2u __attribute__((ext_vector_type(2)));
typedef float f32x4 __attribute__((ext_vector_type(4)));
typedef GAS unsigned gu32;
#define RLX_AGENT __ATOMIC_RELAXED, __HIP_MEMORY_SCOPE_AGENT
#define LDS_WAIT() asm volatile("s_waitcnt lgkmcnt(0)" ::: "memory")
__device__ __forceinline__ float bf2f(unsigned b) { return __uint_as_float(b << 16); }
__device__ __forceinline__ unsigned f2bf(float f) { unsigned u = __float_as_uint(f); return (u + 0x7fffu + ((u >> 16) & 1u)) >> 16; }
__device__ __forceinline__ unsigned pk2(float lo, float hi) { return f2bf(lo) | (f2bf(hi) << 16); }
__device__ __forceinline__ float sigmoidf_(float x) { return __builtin_amdgcn_rcpf(1.0f + __expf(-x)); }
__device__ __forceinline__ float wave_sum(float v) {
#pragma unroll
    for (int o = 1; o < 64; o <<= 1) v += __shfl_xor(v, o);
    return v;
}
__device__ __forceinline__ void unpack8(const v4u w, float* f) {
    f[0] = bf2f(w.x & 0xffffu); f[1] = bf2f(w.x >> 16); f[2] = bf2f(w.y & 0xffffu); f[3] = bf2f(w.y >> 16);
    f[4] = bf2f(w.z & 0xffffu); f[5] = bf2f(w.z >> 16); f[6] = bf2f(w.w & 0xffffu); f[7] = bf2f(w.w >> 16);
}

__constant__ double THETA_D[32] = {1.0, 0.7429639507594948, 0.551995432128157, 0.4101127070551301, 0.30469895709035083, 0.22638034095214485, 0.168192432488087, 0.12496091412919871,
    0.09284145445194746, 0.06897785379387658, 0.05124805876960934, 0.03807546021222372, 0.028288694346259694, 0.021017480113324893, 0.015615230060004972, 0.011601553017399716,
    0.008619535664753031, 0.006404004271197283, 0.004757944314009414, 0.0035349811050301057, 0.0026263635276533325, 0.0019512934226359642, 0.0014497406703726315, 0.001077105056036769,
    0.0008002502278161054, 0.0005945570708544394, 0.0004417344703140073, 0.0003281927872511474, 0.00024383540982688293, 0.00018116091942004152, 0.00013459603241553644, 0.0001};


typedef GAS bf16 gbf; typedef GAS float gf32; typedef GAS unsigned char gu8; typedef GAS v4u gv4u; typedef GAS v2u gv2u; typedef GAS f32x4 gf32x4;
struct Args { const float* in[17]; float* out; unsigned char* ws; int ph_lo, ph_hi, li, pad; };
struct DArgs { const gf32* in[17]; gf32* out; gu8* ws; };
#define XB_TMO      128
#define XB_XCNT(j)  (256  + 64 * (j))
#define XB_XSUB(j)  (1280 + 64 * (j))
#define XB_XGEN(j)  (2304 + 64 * (j))
#define XB_TOP      3328
#define XB_TOPGEN   3392
#define XCD_BAR_WORDS 3456
#define XB_SPIN_CAP (1u << 18)

__device__ __forceinline__ unsigned xb_ld(unsigned* p)              { return __hip_atomic_load(p, __ATOMIC_RELAXED, __HIP_MEMORY_SCOPE_AGENT); }
__device__ __forceinline__ unsigned xb_add(unsigned* p, unsigned v) { return __hip_atomic_fetch_add(p, v, __ATOMIC_RELAXED, __HIP_MEMORY_SCOPE_AGENT); }
__device__ __forceinline__ unsigned xb_xcc_id() { return (unsigned)__builtin_amdgcn_s_getreg((3 << 11) | 20) & 0xFu; }
#define XB_SPIN(cond, bar) do { unsigned _sp = 0; while (cond) { __builtin_amdgcn_s_sleep(1); \
    if ((++_sp & 255u) == 0u) { if (xb_ld(&(bar)[XB_TMO])) break; if (_sp > XB_SPIN_CAP) { atomicAdd(&(bar)[XB_TMO], 1u); break; } } } } while (0)

struct XcdBarrier {
    unsigned* bar; unsigned x;
    volatile LAS unsigned* st;
};

__device__ __forceinline__ XcdBarrier xcd_barrier_post(unsigned* bar, volatile LAS unsigned* st) {
    XcdBarrier b; b.bar = bar; b.x = xb_xcc_id(); b.st = st;
    if (threadIdx.x == 0) (void)xb_add(&bar[XB_XCNT(b.x)], 1u);
    return b;
}
__device__ __forceinline__ void xcd_barrier_complete(unsigned* bar, unsigned x, unsigned& nloc, unsigned& nx) {
    const unsigned G = gridDim.x * gridDim.y * gridDim.z;
    unsigned sum, cnt, mine, sp = 0u;
    for (;;) {
        sum = 0u; cnt = 0u; mine = 0u;
#pragma unroll
        for (unsigned j = 0; j < 16; ++j) { const unsigned c = xb_ld(&bar[XB_XCNT(j)]); sum += c; cnt += (c > 0u) ? 1u : 0u; mine = (j == x) ? c : mine; }
        if (sum == G) break;
        __builtin_amdgcn_s_sleep(1);
        if ((++sp & 255u) == 0u) { if (xb_ld(&bar[XB_TMO])) break; if (sp > XB_SPIN_CAP) { atomicAdd(&bar[XB_TMO], 1u); break; } }
    }
    nloc = mine > 0u ? mine : 1u; nx = cnt > 0u ? cnt : 1u;
}

__device__ __forceinline__ void xcd_barrier(const XcdBarrier& b) {
    asm volatile("s_waitcnt vmcnt(0)" ::: "memory");
    __syncthreads();
    if (threadIdx.x == 0) {
        unsigned* bar = b.bar;
        __builtin_amdgcn_s_waitcnt(0);
        unsigned nloc = b.st[0], nx = b.st[1];
        if (nloc == 0u) { xcd_barrier_complete(bar, b.x, nloc, nx); b.st[0] = nloc; b.st[1] = nx; }
        const unsigned old = xb_add(&bar[XB_XSUB(b.x)], 1u);
        const unsigned gen = old / nloc;
        if (old + 1u == (gen + 1u) * nloc) {
            __builtin_amdgcn_fence(__ATOMIC_RELEASE, "agent");
            asm volatile("s_waitcnt vmcnt(0)" ::: "memory");
            const unsigned og = xb_add(&bar[XB_TOP], 1u);
            const unsigned tg = og / nx;
            if (og + 1u == (tg + 1u) * nx) xb_add(&bar[XB_TOPGEN], 1u);
            else XB_SPIN(xb_ld(&bar[XB_TOPGEN]) == tg, bar);
            __builtin_amdgcn_fence(__ATOMIC_ACQUIRE, "agent");
            xb_add(&bar[XB_XGEN(b.x)], 1u);
            asm volatile("s_waitcnt vmcnt(0)" ::: "memory");
        } else {
            XB_SPIN(xb_ld(&bar[XB_XGEN(b.x)]) == gen, bar);
            __builtin_amdgcn_fence(__ATOMIC_ACQUIRE, "agent");
            asm volatile("s_waitcnt vmcnt(0)" ::: "memory");
        }
    }
    __syncthreads();
}
typedef short bf16x8 __attribute__((ext_vector_type(8)));
typedef short s16x4 __attribute__((ext_vector_type(4)));
typedef short v4i16_t __attribute__((ext_vector_type(4)));
typedef float f32x16 __attribute__((ext_vector_type(16)));
typedef GAS bf16x8 gbf16x8;
constexpr int AT_NS = 4;
constexpr int AT_K = 0, AT_V = AT_NS * 8192, AT_LUT = 2 * AT_NS * 8192, AT_SEL = AT_LUT + 512, AT_BYTES = AT_SEL + 2048;
constexpr float LOG2E = 1.4426950408889634f;

__device__ __forceinline__ void glds16(const GAS void* gsrc, unsigned lds_dst) { unsigned keep;
    asm volatile("s_mov_b32 %0, m0\n\ts_mov_b32 m0, %2\n\ts_nop 0\n\tglobal_load_lds_dwordx4 %1, off\n\ts_mov_b32 m0, %0" : "=&s"(keep) : "v"(gsrc), "s"(lds_dst) : "memory"); }
#define AT_WAIT_BAR() asm volatile("s_waitcnt vmcnt(0) lgkmcnt(0)\n\ts_barrier" ::: "memory")
#define AT_WAIT_BAR_N(N) asm volatile("s_waitcnt vmcnt(" #N ") lgkmcnt(0)\n\ts_barrier" ::: "memory")
__device__ __forceinline__ s16x4 vtr(const LAS unsigned char* p) { return __builtin_bit_cast(s16x4, __builtin_amdgcn_ds_read_tr16_b64_v4i16((LAS v4i16_t*)p)); }
typedef float f32x2_t __attribute__((ext_vector_type(2))); typedef __bf16 bf16x2_t __attribute__((ext_vector_type(2)));
__device__ __forceinline__ unsigned cvtpk(float lo, float hi) { f32x2_t v = {lo, hi}; bf16x2_t b = __builtin_convertvector(v, bf16x2_t); return __builtin_bit_cast(unsigned, b); }
__device__ __forceinline__ float ex2(float x) { return __builtin_amdgcn_exp2f(x); }

constexpr float AT_THR = 6.0f;
template <int MODE, int PROBE = 0>
__device__ __forceinline__ void attn_unit(const gbf* Pq, const gbf* Pk, const gbf* Pv, const gbf* Pg, gbf* Y, int ycol, int b, int h, int qb,
                                          const gf32* KMl, const gf32* lut, LAS unsigned char* lds, int wave, int lane) {
    const int r32 = lane & 31, h2 = lane >> 5;
    const int q_abs = qb * 256 + wave * 32 + r32; const size_t qrow = (size_t)(b * T + q_abs);
    const unsigned lds0 = (unsigned)(uintptr_t)lds;
    const int NT = 4 * (qb + 1);
    const gbf* ksrc = Pk + (size_t)(b * T + lane) * 256 + h * 64 + wave * 8;
    const gbf* vsrc = Pv + (size_t)(b * T + 16 * (wave & 3) + (lane >> 2)) * 256 + h * 64 + (wave >> 2) * 32 + (lane & 3) * 8;
#define AT_DMA(t, buf) do { glds16(ksrc + (size_t)(t) * 64 * 256, (unsigned)__builtin_amdgcn_readfirstlane(lds0 + AT_K + (buf) * 8192 + wave * 1024)); \
                            glds16(vsrc + (size_t)(t) * 64 * 256, (unsigned)__builtin_amdgcn_readfirstlane(lds0 + AT_V + (buf) * 8192 + wave * 1024)); } while (0)
    if (PROBE != 2 && PROBE != 3) { AT_DMA(0, 0); AT_DMA(1, 1); AT_DMA(2, 2); }
    bf16x8 qf[4];
#pragma unroll
    for (int ks = 0; ks < 4; ++ks) qf[ks] = *(const gbf16x8*)(Pq + qrow * 256 + h * 64 + 16 * ks + 8 * h2);
    LAS float* lutL = (LAS float*)(lds + AT_LUT);
    unsigned sel = 0u;
    if (MODE == 0) {
        if (wave == 0) { const float c31 = lut[h * 128 + 127]; lutL[lane] = (lut[h * 128 + lane] - c31) * LOG2E; lutL[64 + lane] = (lut[h * 128 + 64 + lane] - c31) * LOG2E; }
        if (qb <= 3) sel = (1u << qb) - 1u;
        else {
            f32x16 gacc;
#pragma unroll
            for (int r = 0; r < 16; ++r) gacc[r] = 0.f;
            const gf32* km = KMl + (b * 8 + (r32 & 7)) * 256 + h * 64 + 8 * h2;
#pragma unroll
            for (int ks = 0; ks < 4; ++ks) {
                const f32x4 ka = *(const gf32x4*)(km + 16 * ks), kb = *(const gf32x4*)(km + 16 * ks + 4);
                v4u w; w.x = cvtpk(ka[0], ka[1]); w.y = cvtpk(ka[2], ka[3]); w.z = cvtpk(kb[0], kb[1]); w.w = cvtpk(kb[2], kb[3]);
                gacc = __builtin_amdgcn_mfma_f32_32x32x16_bf16(__builtin_bit_cast(bf16x8, w), qf[ks], gacc, 0, 0, 0);
            }
            float gv[8];
#pragma unroll
            for (int e = 0; e < 4; ++e) { const float mine = gacc[e], other = __shfl_xor(mine, 32); gv[e] = h2 ? other : mine; gv[4 + e] = h2 ? mine : other; }
            float g0 = -INFINITY, g1 = -INFINITY, g2 = -INFINITY; int i0 = 0, i1 = 0, i2 = 0;
#pragma unroll
            for (int n = 0; n < 8; ++n) {
                const float g = (n < qb) ? gv[n] : -INFINITY;
                if (g > g0) { g2 = g1; i2 = i1; g1 = g0; i1 = i0; g0 = g; i0 = n; }
                else if (g > g1) { g2 = g1; i2 = i1; g1 = g; i1 = n; }
                else if (g > g2) { g2 = g; i2 = n; }
            }
            sel = (1u << i0) | (1u << i1) | (1u << i2);
        }
    }
    const float g64 = (MODE == 1) ? ex2(64.0f * log2f(1.0f - ex2(-5.0f - (float)h))) : 1.0f;
    AT_WAIT_BAR_N(4);
    float m_run = 0.f, l_run = 0.f; f32x16 o0, o1, cinit;
#pragma unroll
    for (int r = 0; r < 16; ++r) { o0[r] = 0.f; o1[r] = 0.f; cinit[r] = 0.f; }
    for (int t = 0; t < NT; ++t) {
        const int cur = t & (AT_NS - 1);
        if (PROBE != 2 && PROBE != 3 && t + 3 < NT) AT_DMA(t + 3, (t + 3) & (AT_NS - 1));
        const int nb = t >> 2; const bool own = (nb == qb);
        const bool active = !own || ((t & 3) * 64 <= wave * 32 + 31);
        if (active && PROBE != 1) {
            if (MODE == 0 && (t & 3) == 0) {
                const float cv = (own || ((sel >> nb) & 1u)) ? -m_run : -1e30f;
#pragma unroll
                for (int r = 0; r < 16; ++r) cinit[r] = cv;
            }
            f32x16 s0 = cinit, s1 = cinit;
            const LAS unsigned char* kb = lds + AT_K + cur * 8192 + h2 * 1024 + r32 * 16;
#pragma unroll
            for (int ks = 0; ks < 4; ++ks) {
                const bf16x8 a0 = *(const LAS bf16x8*)(kb + ks * 2048), a1 = *(const LAS bf16x8*)(kb + ks * 2048 + 512);
                s0 = __builtin_amdgcn_mfma_f32_32x32x16_bf16(a0, qf[ks], s0, 0, 0, 0);
                s1 = __builtin_amdgcn_mfma_f32_32x32x16_bf16(a1, qf[ks], s1, 0, 0, 0);
            }
            const int dq = q_abs - (t * 64 + 4 * h2);
            if (PROBE == 3) {   } else if (MODE == 0) {
                const bool near = own || (qb * 256 + wave * 32 - (t * 64 + 63) < 113);
                if (near) {
#pragma unroll
                    for (int r = 0; r < 16; ++r) {
                        const int d0 = dq - ((r & 3) + 8 * (r >> 2)), d1 = d0 - 32;
                        const float b0 = lutL[min(max(d0, 0), 127)], b1 = lutL[min(max(d1, 0), 127)];
                        s0[r] = d0 >= 0 ? s0[r] + b0 : -1e30f;
                        s1[r] = d1 >= 0 ? s1[r] + b1 : -1e30f;
                    }
                }
                float mx = fmaxf(fmaxf(s0[0], s0[1]), fmaxf(s1[0], s1[1]));
#pragma unroll
                for (int r = 2; r < 16; r += 2) mx = fmaxf(mx, fmaxf(fmaxf(s0[r], s0[r + 1]), fmaxf(s1[r], s1[r + 1])));
                mx = fmaxf(mx, __shfl_xor(mx, 32));
                if (__any(mx > AT_THR)) {
                    const float dl = fmaxf(mx, 0.f), alpha = ex2(-dl); m_run += dl; l_run *= alpha;
#pragma unroll
                    for (int r = 0; r < 16; ++r) { s0[r] -= dl; s1[r] -= dl; o0[r] *= alpha; o1[r] *= alpha; cinit[r] -= dl; }
                }
                float ps = 0.f;
#pragma unroll
                for (int r = 0; r < 16; ++r) { s0[r] = ex2(s0[r]); s1[r] = ex2(s1[r]); ps += s0[r] + s1[r]; }
                l_run += ps;
            } else {
                if (t == qb * 4 + (wave >> 1)) {
#pragma unroll
                    for (int r = 0; r < 16; ++r) {
                        const int d0 = dq - ((r & 3) + 8 * (r >> 2)), d1 = d0 - 32;
                        s0[r] = d0 >= 0 ? s0[r] : 0.f; s1[r] = d1 >= 0 ? s1[r] : 0.f;
                    }
                }
#pragma unroll
                for (int r = 0; r < 16; ++r) { o0[r] *= g64; o1[r] *= g64; }
            }
            bf16x8 pf[4];
#pragma unroll
            for (int s = 0; s < 2; ++s) {
                v4u w0, w1;
                w0.x = cvtpk(s0[8 * s + 0], s0[8 * s + 1]); w0.y = cvtpk(s0[8 * s + 2], s0[8 * s + 3]); w0.z = cvtpk(s0[8 * s + 4], s0[8 * s + 5]); w0.w = cvtpk(s0[8 * s + 6], s0[8 * s + 7]);
                w1.x = cvtpk(s1[8 * s + 0], s1[8 * s + 1]); w1.y = cvtpk(s1[8 * s + 2], s1[8 * s + 3]); w1.z = cvtpk(s1[8 * s + 4], s1[8 * s + 5]); w1.w = cvtpk(s1[8 * s + 6], s1[8 * s + 7]);
                pf[s] = __builtin_bit_cast(bf16x8, w0); pf[2 + s] = __builtin_bit_cast(bf16x8, w1);
            }
            const LAS unsigned char* vb = lds + AT_V + cur * 8192 + ((lane >> 4) & 1) * 32 + (lane & 3) * 8 + (4 * h2 + ((lane & 15) >> 2)) * 64;
#pragma unroll
            for (int kk = 0; kk < 4; ++kk) {
                const s16x4 lo0 = vtr(vb + kk * 1024), hi0 = vtr(vb + kk * 1024 + 512), lo1 = vtr(vb + 4096 + kk * 1024), hi1 = vtr(vb + 4096 + kk * 1024 + 512);
                const bf16x8 v0 = (bf16x8){lo0[0], lo0[1], lo0[2], lo0[3], hi0[0], hi0[1], hi0[2], hi0[3]};
                const bf16x8 v1 = (bf16x8){lo1[0], lo1[1], lo1[2], lo1[3], hi1[0], hi1[1], hi1[2], hi1[3]};
                o0 = __builtin_amdgcn_mfma_f32_32x32x16_bf16(v0, pf[kk], o0, 0, 0, 0);
                o1 = __builtin_amdgcn_mfma_f32_32x32x16_bf16(v1, pf[kk], o1, 0, 0, 0);
            }
        }
        if (t + 3 < NT) AT_WAIT_BAR_N(4); else if (t + 3 == NT) AT_WAIT_BAR_N(2); else AT_WAIT_BAR();
    }
#undef AT_DMA
    if (PROBE != 0) { float sink = l_run + o0[0] + o1[3]; asm volatile("" :: "v"(sink)); return; }
    float scale;
    if (MODE == 0) { const float l = l_run + __shfl_xor(l_run, 32); scale = 1.0f / l; }
    else { float ss = 0.f;
#pragma unroll
        for (int r = 0; r < 16; ++r) ss += o0[r] * o0[r] + o1[r] * o1[r];
        ss += __shfl_xor(ss, 32); scale = rsqrtf(ss * (1.0f / 64.0f) + 1e-6f); }
#pragma unroll
    for (int g = 0; g < 4; ++g) {
        const int d0 = 8 * g + 4 * h2;
        const v2u g0 = *(const gv2u*)(Pg + qrow * 256 + h * 64 + d0), g1 = *(const gv2u*)(Pg + qrow * 256 + h * 64 + 32 + d0);
        v2u w0, w1;
        w0.x = cvtpk(o0[4 * g] * scale * bf2f(g0.x & 0xffffu), o0[4 * g + 1] * scale * bf2f(g0.x >> 16)); w0.y = cvtpk(o0[4 * g + 2] * scale * bf2f(g0.y & 0xffffu), o0[4 * g + 3] * scale * bf2f(g0.y >> 16));
        w1.x = cvtpk(o1[4 * g] * scale * bf2f(g1.x & 0xffffu), o1[4 * g + 1] * scale * bf2f(g1.x >> 16)); w1.y = cvtpk(o1[4 * g + 2] * scale * bf2f(g1.y & 0xffffu), o1[4 * g + 3] * scale * bf2f(g1.y >> 16));
        *(gv2u*)(Y + qrow * D + ycol + h * 64 + d0) = w0; *(gv2u*)(Y + qrow * D + ycol + h * 64 + 32 + d0) = w1;
    }
}

template <int MODE>
__device__ __forceinline__ void attn_unit_stg(const gbf* Pq, const gbf* Pk, const gbf* Pv, const gbf* Pg, gbf* Y, int ycol, int b, int h, int qb,
                                              const gf32* KMl, const gf32* lut, LAS unsigned char* lds, int wave, int lane) {
    const int r32 = lane & 31, h2 = lane >> 5, grp = wave >> 2;
    const int q_abs = qb * 256 + wave * 32 + r32; const size_t qrow = (size_t)(b * T + q_abs);
    const unsigned lds0 = (unsigned)(uintptr_t)lds;
    const int NT = 4 * (qb + 1);
    const gbf* ksrc = Pk + (size_t)(b * T + lane) * 256 + h * 64 + wave * 8;
    const gbf* vsrc = Pv + (size_t)(b * T + 16 * (wave & 3) + (lane >> 2)) * 256 + h * 64 + (wave >> 2) * 32 + (lane & 3) * 8;
#define AT_DMA(t, buf) do { glds16(ksrc + (size_t)(t) * 64 * 256, (unsigned)__builtin_amdgcn_readfirstlane(lds0 + AT_K + (buf) * 8192 + wave * 1024)); \
                            glds16(vsrc + (size_t)(t) * 64 * 256, (unsigned)__builtin_amdgcn_readfirstlane(lds0 + AT_V + (buf) * 8192 + wave * 1024)); } while (0)
    AT_DMA(0, 0); AT_DMA(1, 1);
    bf16x8 qf[4];
#pragma unroll
    for (int ks = 0; ks < 4; ++ks) qf[ks] = *(const gbf16x8*)(Pq + qrow * 256 + h * 64 + 16 * ks + 8 * h2);
    LAS float* lutL = (LAS float*)(lds + AT_LUT);
    unsigned sel = 0u;
    if (MODE == 0) {
        if (wave == 0) { const float c31 = lut[h * 128 + 127]; lutL[lane] = (lut[h * 128 + lane] - c31) * LOG2E; lutL[64 + lane] = (lut[h * 128 + 64 + lane] - c31) * LOG2E; }
        if (qb <= 3) sel = (1u << qb) - 1u;
        else {
            f32x16 gacc;
#pragma unroll
            for (int r = 0; r < 16; ++r) gacc[r] = 0.f;
            const gf32* km = KMl + (b * 8 + (r32 & 7)) * 256 + h * 64 + 8 * h2;
#pragma unroll
            for (int ks = 0; ks < 4; ++ks) {
                const f32x4 ka = *(const gf32x4*)(km + 16 * ks), kb = *(const gf32x4*)(km + 16 * ks + 4);
                v4u w; w.x = cvtpk(ka[0], ka[1]); w.y = cvtpk(ka[2], ka[3]); w.z = cvtpk(kb[0], kb[1]); w.w = cvtpk(kb[2], kb[3]);
                gacc = __builtin_amdgcn_mfma_f32_32x32x16_bf16(__builtin_bit_cast(bf16x8, w), qf[ks], gacc, 0, 0, 0);
            }
            float gv[8];
#pragma unroll
            for (int e = 0; e < 4; ++e) { const float mine = gacc[e], other = __shfl_xor(mine, 32); gv[e] = h2 ? other : mine; gv[4 + e] = h2 ? mine : other; }
            float g0 = -INFINITY, g1 = -INFINITY, g2 = -INFINITY; int i0 = 0, i1 = 0, i2 = 0;
#pragma unroll
            for (int n = 0; n < 8; ++n) {
                const float g = (n < qb) ? gv[n] : -INFINITY;
                if (g > g0) { g2 = g1; i2 = i1; g1 = g0; i1 = i0; g0 = g; i0 = n; }
                else if (g > g1) { g2 = g1; i2 = i1; g1 = g; i1 = n; }
                else if (g > g2) { g2 = g; i2 = n; }
            }
            sel = (1u << i0) | (1u << i1) | (1u << i2);
        }
    }
    LAS unsigned* selL = (LAS unsigned*)(lds + AT_SEL) + wave * 64 + lane;
    if (MODE == 0) *selL = sel;
    const float g64 = (MODE == 1) ? ex2(64.0f * log2f(1.0f - ex2(-5.0f - (float)h))) : 1.0f;
    AT_WAIT_BAR_N(2);
    float m_run = 0.f, l_run = 0.f; f32x16 o0, o1, cinit, s0, s1; bf16x8 pf[4];
#pragma unroll
    for (int r = 0; r < 16; ++r) { o0[r] = 0.f; o1[r] = 0.f; cinit[r] = 0.f; s0[r] = 0.f; s1[r] = 0.f; }
#pragma unroll
    for (int k = 0; k < 4; ++k) pf[k] = (bf16x8){0, 0, 0, 0, 0, 0, 0, 0};
#define AT_ACT(i_) (((i_) >> 2) != qb || ((i_) & 3) * 64 <= wave * 32 + 31)
    for (int ph = 0; ph < 2 * NT + 2; ++ph) {
        if (!(ph & 1)) { const int j = (ph >> 1) + 2; if (j < NT) AT_DMA(j, j & (AT_NS - 1)); }
        const int lp = ph - grp;
        if (lp >= 0 && lp <= 2 * NT) {
            const int i = lp >> 1;
            if (!(lp & 1)) {
                if (i >= 1 && AT_ACT(i - 1)) {
                    const LAS unsigned char* vb = lds + AT_V + ((i - 1) & (AT_NS - 1)) * 8192 + ((lane >> 4) & 1) * 32 + (lane & 3) * 8 + (4 * h2 + ((lane & 15) >> 2)) * 64;
#pragma unroll
                    for (int kk = 0; kk < 4; ++kk) {
                        const s16x4 lo0 = vtr(vb + kk * 1024), hi0 = vtr(vb + kk * 1024 + 512), lo1 = vtr(vb + 4096 + kk * 1024), hi1 = vtr(vb + 4096 + kk * 1024 + 512);
                        const bf16x8 v0 = (bf16x8){lo0[0], lo0[1], lo0[2], lo0[3], hi0[0], hi0[1], hi0[2], hi0[3]};
                        const bf16x8 v1 = (bf16x8){lo1[0], lo1[1], lo1[2], lo1[3], hi1[0], hi1[1], hi1[2], hi1[3]};
                        o0 = __builtin_amdgcn_mfma_f32_32x32x16_bf16(v0, pf[kk], o0, 0, 0, 0);
                        o1 = __builtin_amdgcn_mfma_f32_32x32x16_bf16(v1, pf[kk], o1, 0, 0, 0);
                    }
                }
                if (i < NT && AT_ACT(i)) {
                    if (MODE == 0 && (i & 3) == 0) {
                        const int nb = i >> 2; const float cv = (nb == qb || ((*selL >> nb) & 1u)) ? -m_run : -1e30f;
#pragma unroll
                        for (int r = 0; r < 16; ++r) cinit[r] = cv;
                    }
                    s0 = cinit; s1 = cinit;
                    const LAS unsigned char* kb = lds + AT_K + (i & (AT_NS - 1)) * 8192 + h2 * 1024 + r32 * 16;
#pragma unroll
                    for (int ks = 0; ks < 4; ++ks) {
                        const bf16x8 a0 = *(const LAS bf16x8*)(kb + ks * 2048), a1 = *(const LAS bf16x8*)(kb + ks * 2048 + 512);
                        s0 = __builtin_amdgcn_mfma_f32_32x32x16_bf16(a0, qf[ks], s0, 0, 0, 0);
                        s1 = __builtin_amdgcn_mfma_f32_32x32x16_bf16(a1, qf[ks], s1, 0, 0, 0);
                    }
                }
            } else if (AT_ACT(i)) {
                const bool own = ((i >> 2) == qb);
                const int dq = q_abs - (i * 64 + 4 * h2);
                if (MODE == 0) {
                    const bool near = own || (qb * 256 + wave * 32 - (i * 64 + 63) < 113);
                    if (near) {
#pragma unroll
                        for (int r = 0; r < 16; ++r) {
                            const int d0 = dq - ((r & 3) + 8 * (r >> 2)), d1 = d0 - 32;
                            const float b0 = lutL[min(max(d0, 0), 127)], b1 = lutL[min(max(d1, 0), 127)];
                            s0[r] = d0 >= 0 ? s0[r] + b0 : -1e30f;
                            s1[r] = d1 >= 0 ? s1[r] + b1 : -1e30f;
                        }
                    }
                    float mx = fmaxf(fmaxf(s0[0], s0[1]), fmaxf(s1[0], s1[1]));
#pragma unroll
                    for (int r = 2; r < 16; r += 2) mx = fmaxf(mx, fmaxf(fmaxf(s0[r], s0[r + 1]), fmaxf(s1[r], s1[r + 1])));
                    mx = fmaxf(mx, __shfl_xor(mx, 32));
                    if (__any(mx > AT_THR)) {
                        const float dl = fmaxf(mx, 0.f), alpha = ex2(-dl); m_run += dl; l_run *= alpha;
#pragma unroll
                        for (int r = 0; r < 16; ++r) { s0[r] -= dl; s1[r] -= dl; o0[r] *= alpha; o1[r] *= alpha; cinit[r] -= dl; }
                    }
                    float ps = 0.f;
#pragma unroll
                    for (int r = 0; r < 16; ++r) { s0[r] = ex2(s0[r]); s1[r] = ex2(s1[r]); ps += s0[r] + s1[r]; }
                    l_run += ps;
                } else {
                    if (i == qb * 4 + (wave >> 1)) {
#pragma unroll
                        for (int r = 0; r < 16; ++r) {
                            const int d0 = dq - ((r & 3) + 8 * (r >> 2)), d1 = d0 - 32;
                            s0[r] = d0 >= 0 ? s0[r] : 0.f; s1[r] = d1 >= 0 ? s1[r] : 0.f;
                        }
                    }
#pragma unroll
                    for (int r = 0; r < 16; ++r) { o0[r] *= g64; o1[r] *= g64; }
                }
#pragma unroll
                for (int s = 0; s < 2; ++s) {
                    v4u w0, w1;
                    w0.x = cvtpk(s0[8 * s + 0], s0[8 * s + 1]); w0.y = cvtpk(s0[8 * s + 2], s0[8 * s + 3]); w0.z = cvtpk(s0[8 * s + 4], s0[8 * s + 5]); w0.w = cvtpk(s0[8 * s + 6], s0[8 * s + 7]);
                    w1.x = cvtpk(s1[8 * s + 0], s1[8 * s + 1]); w1.y = cvtpk(s1[8 * s + 2], s1[8 * s + 3]); w1.z = cvtpk(s1[8 * s + 4], s1[8 * s + 5]); w1.w = cvtpk(s1[8 * s + 6], s1[8 * s + 7]);
                    pf[s] = __builtin_bit_cast(bf16x8, w0); pf[2 + s] = __builtin_bit_cast(bf16x8, w1);
                }
            }
        }
        if (ph & 1) { const int j = (ph + 1) >> 1; if (j + 1 < NT) AT_WAIT_BAR_N(2); else AT_WAIT_BAR(); }
        else asm volatile("s_waitcnt lgkmcnt(0)\n\ts_barrier" ::: "memory");
    }
#undef AT_DMA
#undef AT_ACT
    int qa2 = q_abs; asm volatile("" : "+v"(qa2));
    const size_t qrow_e = (size_t)(b * T + qa2);
    float scale;
    if (MODE == 0) { const float l = l_run + __shfl_xor(l_run, 32); scale = 1.0f / l; }
    else { float ss = 0.f;
#pragma unroll
        for (int r = 0; r < 16; ++r) ss += o0[r] * o0[r] + o1[r] * o1[r];
        ss += __shfl_xor(ss, 32); scale = rsqrtf(ss * (1.0f / 64.0f) + 1e-6f); }
#pragma unroll
    for (int g = 0; g < 4; ++g) {
        const int d0 = 8 * g + 4 * h2;
        const v2u g0 = *(const gv2u*)(Pg + qrow_e * 256 + h * 64 + d0), g1 = *(const gv2u*)(Pg + qrow_e * 256 + h * 64 + 32 + d0);
        v2u w0, w1;
        w0.x = cvtpk(o0[4 * g] * scale * bf2f(g0.x & 0xffffu), o0[4 * g + 1] * scale * bf2f(g0.x >> 16)); w0.y = cvtpk(o0[4 * g + 2] * scale * bf2f(g0.y & 0xffffu), o0[4 * g + 3] * scale * bf2f(g0.y >> 16));
        w1.x = cvtpk(o1[4 * g] * scale * bf2f(g1.x & 0xffffu), o1[4 * g + 1] * scale * bf2f(g1.x >> 16)); w1.y = cvtpk(o1[4 * g + 2] * scale * bf2f(g1.y & 0xffffu), o1[4 * g + 3] * scale * bf2f(g1.y >> 16));
        *(gv2u*)(Y + qrow_e * D + ycol + h * 64 + d0) = w0; *(gv2u*)(Y + qrow_e * D + ycol + h * 64 + 32 + d0) = w1;
    }
}

constexpr int AB_SLOT = 65536, AB_LUT = LDSCTL_OFF + 1024, AB_LUT2 = LDSCTL_OFF + 2048;
static_assert(2 * AB_SLOT <= RING_BYTES && AB_LUT2 + 6144 <= LDS_BYTES, "attention block ring");
template <int MODE>
__device__ __forceinline__ void attn_unit_blk(const gbf* Pq, const gbf* Pk, const gbf* Pv, const gbf* Pg, gbf* Y, int ycol, int b, int h, int qb,
                                              const gf32* KMl, const gf32* lut, LAS unsigned char* lds, int wave, int lane) {
    const int r32 = lane & 31, h2 = lane >> 5;
    const int q_abs = qb * 256 + wave * 32 + r32; const size_t qrow = (size_t)(b * T + q_abs);
    const unsigned lds0 = (unsigned)(uintptr_t)lds;
    const int NS = qb + 1;
    const int kkey_ = wave * 8 + (lane >> 3);
    const gbf* ksrc = Pk + (size_t)(b * T + kkey_) * 256 + h * 64 + (((lane & 7) ^ ((kkey_ >> 1) & 7)) * 8);
    int koff[4];
#pragma unroll
    for (int ks = 0; ks < 4; ++ks) koff[ks] = r32 * 128 + (((2 * ks + h2) ^ ((r32 >> 1) & 7)) * 16);
    const gbf* vsrc = Pv + (size_t)(b * T + 16 * (wave & 3) + (lane >> 2)) * 256 + h * 64 + (wave >> 2) * 32 + (lane & 3) * 8;
#define AB_DMA(S_, slot_) do { _Pragma("unroll") for (int u_ = 0; u_ < 4; ++u_) { \
        glds16(ksrc + (size_t)((S_) * 4 + u_) * 64 * 256, (unsigned)__builtin_amdgcn_readfirstlane(lds0 + (slot_) * AB_SLOT + u_ * 8192 + wave * 1024)); \
        glds16(vsrc + (size_t)((S_) * 4 + u_) * 64 * 256, (unsigned)__builtin_amdgcn_readfirstlane(lds0 + (slot_) * AB_SLOT + 32768 + u_ * 8192 + wave * 1024)); } } while (0)
    AB_DMA(0, 0);
    if (MODE == 0 && wave < 6) glds16((const GAS unsigned char*)lut + (TAB_LUT2 - TAB_LUT) + (size_t)h * 6144 + wave * 1024 + lane * 16, (unsigned)__builtin_amdgcn_readfirstlane(lds0 + AB_LUT2 + wave * 1024));
    bf16x8 qf[4];
#pragma unroll
    for (int ks = 0; ks < 4; ++ks) qf[ks] = *(const gbf16x8*)(Pq + qrow * 256 + h * 64 + 16 * ks + 8 * h2);
    LAS float* lutL = (LAS float*)(lds + AB_LUT);
    unsigned sel = 0u;
    if (MODE == 0) {
        if (qb <= 3) sel = (1u << qb) - 1u;
        else {
            f32x16 gacc;
#pragma unroll
            for (int r = 0; r < 16; ++r) gacc[r] = 0.f;
            const gf32* km = KMl + (b * 8 + (r32 & 7)) * 256 + h * 64 + 8 * h2;
#pragma unroll
            for (int ks = 0; ks < 4; ++ks) {
                const f32x4 ka = *(const gf32x4*)(km + 16 * ks), kb = *(const gf32x4*)(km + 16 * ks + 4);
                v4u w; w.x = cvtpk(ka[0], ka[1]); w.y = cvtpk(ka[2], ka[3]); w.z = cvtpk(kb[0], kb[1]); w.w = cvtpk(kb[2], kb[3]);
                gacc = __builtin_amdgcn_mfma_f32_32x32x16_bf16(__builtin_bit_cast(bf16x8, w), qf[ks], gacc, 0, 0, 0);
            }
            float gv[8];
#pragma unroll
            for (int e = 0; e < 4; ++e) { const float mine = gacc[e], other = __shfl_xor(mine, 32); gv[e] = h2 ? other : mine; gv[4 + e] = h2 ? mine : other; }
            float g0 = -INFINITY, g1 = -INFINITY, g2 = -INFINITY; int i0 = 0, i1 = 0, i2 = 0;
#pragma unroll
            for (int n = 0; n < 8; ++n) {
                const float g = (n < qb) ? gv[n] : -INFINITY;
                if (g > g0) { g2 = g1; i2 = i1; g1 = g0; i1 = i0; g0 = g; i0 = n; }
                else if (g > g1) { g2 = g1; i2 = i1; g1 = g; i1 = n; }
                else if (g > g2) { g2 = g; i2 = n; }
            }
            sel = (1u << i0) | (1u << i1) | (1u << i2);
        }
    }
    const float g64 = (MODE == 1) ? ex2(256.0f * log2f(1.0f - ex2(-5.0f - (float)h))) : 1.0f;
    float m_run = 0.f; f32x16 o0, o1, cinit, lacc;
#pragma unroll
    for (int r = 0; r < 16; ++r) { o0[r] = 0.f; o1[r] = 0.f; cinit[r] = 0.f; lacc[r] = 0.f; }
    const bf16x8 ones = (bf16x8){0x3F80, 0x3F80, 0x3F80, 0x3F80, 0x3F80, 0x3F80, 0x3F80, 0x3F80};
    if (wave >= 4) __builtin_amdgcn_s_setprio(1);
    for (int S = 0; S < NS; ++S) {
        if (S + 1 < NS) AB_DMA(S + 1, (S + 1) & 1);
        if (S == 0) { if (NS > 1) AT_WAIT_BAR_N(8); else AT_WAIT_BAR(); }
        const bool own = (S == qb);
        if (MODE == 0) { const float cv = (own || ((sel >> S) & 1u)) ? -m_run : -1e30f;
#pragma unroll
            for (int r = 0; r < 16; ++r) cinit[r] = cv; }
        if (MODE == 1 && S > 0) {
#pragma unroll
            for (int r = 0; r < 16; ++r) { o0[r] *= g64; o1[r] *= g64; } }
        const LAS unsigned char* slot = lds + (S & 1) * AB_SLOT;
        bf16x8 kf[8]; bool have = false;
#pragma unroll 1
        for (int u = 0; u < 4; ++u) {
            const int t = 4 * S + u;
            const bool active = !own || (u * 64 <= wave * 32 + 31);
            if (!active) break;
            const LAS unsigned char* kb = slot + u * 8192;
            if (!have) {
#pragma unroll
                for (int ks = 0; ks < 4; ++ks) { kf[2 * ks] = *(const LAS bf16x8*)(kb + koff[ks]); kf[2 * ks + 1] = *(const LAS bf16x8*)(kb + koff[ks] + 4096); }
            }
            f32x16 s0 = cinit, s1 = cinit;
#pragma unroll
            for (int ks = 0; ks < 4; ++ks) {
                s0 = __builtin_amdgcn_mfma_f32_32x32x16_bf16(kf[2 * ks], qf[ks], s0, 0, 0, 0);
                s1 = __builtin_amdgcn_mfma_f32_32x32x16_bf16(kf[2 * ks + 1], qf[ks], s1, 0, 0, 0);
            }
            __builtin_amdgcn_sched_barrier(0);
            const LAS unsigned char* vb = slot + 32768 + u * 8192 + ((lane >> 4) & 1) * 32 + (lane & 3) * 8 + (4 * h2 + ((lane & 15) >> 2)) * 64;
            s16x4 vlo0[4], vhi0[4], vlo1[4], vhi1[4];
#pragma unroll
            for (int kk = 0; kk < 4; ++kk) { vlo0[kk] = vtr(vb + kk * 1024); vhi0[kk] = vtr(vb + kk * 1024 + 512); vlo1[kk] = vtr(vb + 4096 + kk * 1024); vhi1[kk] = vtr(vb + 4096 + kk * 1024 + 512); }
            __builtin_amdgcn_sched_barrier(0);
            const int dq = q_abs - (t * 64 + 4 * h2);
            if (MODE == 0) {
                const bool near = own || (qb * 256 + wave * 32 - (t * 64 + 63) < 113);
                if (near) {
                    const int jb = 255 - dq, cpy = jb & 3;
                    const LAS unsigned char* lp = lds + AB_LUT2 + cpy * 1344 + (jb - cpy) * 4;
#pragma unroll
                    for (int g = 0; g < 4; ++g) {
                        const f32x4 b0 = *(const LAS f32x4*)(lp + 32 * g), b1 = *(const LAS f32x4*)(lp + 128 + 32 * g);
#pragma unroll
                        for (int k = 0; k < 4; ++k) { s0[4 * g + k] += b0[k]; s1[4 * g + k] += b1[k]; }
                    }
                }
                float mxa = fmaxf(s0[0], s1[0]), mxb = fmaxf(s0[1], s1[1]);
#pragma unroll
                for (int r = 2; r < 16; r += 2) { mxa = fmaxf(fmaxf(mxa, s0[r]), s1[r]); mxb = fmaxf(fmaxf(mxb, s0[r + 1]), s1[r + 1]); }
                float mx = fmaxf(mxa, mxb);
                { const auto sw = __builtin_amdgcn_permlane32_swap(__float_as_uint(mx), __float_as_uint(mx), false, false);
                  mx = fmaxf(__uint_as_float(sw[0]), __uint_as_float(sw[1])); }
                if (__any(mx > AT_THR)) {
                    const float dl = fmaxf(mx, 0.f), alpha = ex2(-dl); m_run += dl; lacc[0] *= alpha;
#pragma unroll
                    for (int r = 0; r < 16; ++r) { s0[r] -= dl; s1[r] -= dl; o0[r] *= alpha; o1[r] *= alpha; cinit[r] -= dl; }
                }
            } else {
                if (t == qb * 4 + (wave >> 1)) {
#pragma unroll
                    for (int r = 0; r < 16; ++r) {
                        const int d0 = dq - ((r & 3) + 8 * (r >> 2)), d1 = d0 - 32;
                        s0[r] = d0 >= 0 ? s0[r] : 0.f; s1[r] = d1 >= 0 ? s1[r] : 0.f;
                    }
                }
            }
            bf16x8 pf[4];
#define AT_EX(kk, e) do { if (MODE == 0) { if ((kk) < 2) s0[8 * ((kk) & 1) + (e)] = ex2(s0[8 * ((kk) & 1) + (e)]); else s1[8 * ((kk) & 1) + (e)] = ex2(s1[8 * ((kk) & 1) + (e)]); } } while (0)
#define AT_CVT(kk) do { const int b_ = 8 * ((kk) & 1); v4u w_; \
                if ((kk) < 2) { w_.x = cvtpk(s0[b_], s0[b_ + 1]); w_.y = cvtpk(s0[b_ + 2], s0[b_ + 3]); w_.z = cvtpk(s0[b_ + 4], s0[b_ + 5]); w_.w = cvtpk(s0[b_ + 6], s0[b_ + 7]); } \
                else { w_.x = cvtpk(s1[b_], s1[b_ + 1]); w_.y = cvtpk(s1[b_ + 2], s1[b_ + 3]); w_.z = cvtpk(s1[b_ + 4], s1[b_ + 5]); w_.w = cvtpk(s1[b_ + 6], s1[b_ + 7]); } \
                pf[kk] = __builtin_bit_cast(bf16x8, w_); } while (0)
#define AT_SB() __builtin_amdgcn_sched_barrier(0)
#pragma unroll
            for (int e = 0; e < 8; ++e) AT_EX(0, e);
            AT_CVT(0);
            AT_SB();
            have = (u < 3) && (!own || ((u + 1) * 64 <= wave * 32 + 31));
            if (have) {
#pragma unroll
                for (int ks = 0; ks < 4; ++ks) { kf[2 * ks] = *(const LAS bf16x8*)(kb + 8192 + koff[ks]); kf[2 * ks + 1] = *(const LAS bf16x8*)(kb + 8192 + koff[ks] + 4096); }
            }
            AT_SB();
#pragma unroll
            for (int kk = 0; kk < 4; ++kk) {
                const s16x4 lo0 = vlo0[kk], hi0 = vhi0[kk], lo1 = vlo1[kk], hi1 = vhi1[kk];
                const bf16x8 v0 = (bf16x8){lo0[0], lo0[1], lo0[2], lo0[3], hi0[0], hi0[1], hi0[2], hi0[3]};
                const bf16x8 v1 = (bf16x8){lo1[0], lo1[1], lo1[2], lo1[3], hi1[0], hi1[1], hi1[2], hi1[3]};
                o0 = __builtin_amdgcn_mfma_f32_32x32x16_bf16(v0, pf[kk], o0, 0, 0, 0);
                AT_SB();
                if (kk < 3) { if (MODE == 0) { AT_EX(kk + 1, 0); AT_EX(kk + 1, 1); AT_EX(kk + 1, 2); } else AT_CVT(kk + 1); }
                AT_SB();
                o1 = __builtin_amdgcn_mfma_f32_32x32x16_bf16(v1, pf[kk], o1, 0, 0, 0);
                if (MODE == 0) {
                    AT_SB();
                    if (kk < 3) { AT_EX(kk + 1, 3); AT_EX(kk + 1, 4); AT_EX(kk + 1, 5); }
                    AT_SB();
                    lacc = __builtin_amdgcn_mfma_f32_32x32x16_bf16(ones, pf[kk], lacc, 0, 0, 0);
                    AT_SB();
                    if (kk < 3) { AT_EX(kk + 1, 6); AT_EX(kk + 1, 7); AT_CVT(kk + 1); }
                    AT_SB();
                }
            }
#undef AT_EX
#undef AT_CVT
#undef AT_SB
        }
        AT_WAIT_BAR();
    }
    __builtin_amdgcn_s_setprio(0);
#undef AB_DMA
    int qa2 = q_abs; asm volatile("" : "+v"(qa2));
    const size_t qrow_e = (size_t)(b * T + qa2);
    float scale;
    if (MODE == 0) { scale = 1.0f / lacc[0]; }
    else { float ss = 0.f;
#pragma unroll
        for (int r = 0; r < 16; ++r) ss += o0[r] * o0[r] + o1[r] * o1[r];
        ss += __shfl_xor(ss, 32); scale = rsqrtf(ss * (1.0f / 64.0f) + 1e-6f); }
#pragma unroll
    for (int g = 0; g < 4; ++g) {
        const int d0 = 8 * g + 4 * h2;
        const v2u g0 = *(const gv2u*)(Pg + qrow_e * 256 + h * 64 + d0), g1 = *(const gv2u*)(Pg + qrow_e * 256 + h * 64 + 32 + d0);
        v2u w0, w1;
        w0.x = cvtpk(o0[4 * g] * scale * bf2f(g0.x & 0xffffu), o0[4 * g + 1] * scale * bf2f(g0.x >> 16)); w0.y = cvtpk(o0[4 * g + 2] * scale * bf2f(g0.y & 0xffffu), o0[4 * g + 3] * scale * bf2f(g0.y >> 16));
        w1.x = cvtpk(o1[4 * g] * scale * bf2f(g1.x & 0xffffu), o1[4 * g + 1] * scale * bf2f(g1.x >> 16)); w1.y = cvtpk(o1[4 * g + 2] * scale * bf2f(g1.y & 0xffffu), o1[4 * g + 3] * scale * bf2f(g1.y >> 16));
        *(gv2u*)(Y + qrow_e * D + ycol + h * 64 + d0) = w0; *(gv2u*)(Y + qrow_e * D + ycol + h * 64 + 32 + d0) = w1;
    }
}

__device__ __forceinline__ void attn_dispatch(const gu8* wsc, int l, int u, LAS unsigned char* lds, int wave, int lane) {
    gu8* ws = (gu8*)wsc;
    const gbf* PB = (const gbf*)(ws + WS_PB);
    const gf32* KMl = (const gf32*)(ws + WS_CTL + CTL_KM) + l * 64 * 256;
    const gf32* lut = (const gf32*)(ws + WS_TAB + TAB_LUT);
    gbf* Y = (gbf*)(ws + WS_XB);
    const int qb = 7 - (u >> 6), mode = (u >> 5) & 1, b = (u >> 2) & 7, h = u & 3;
#if ATT_STAGGER == 2
    if (mode == 0) attn_unit_blk<0>(PB + 8 * PANEL, PB + 9 * PANEL, PB + 10 * PANEL, PB + 11 * PANEL, Y, 512, b, h, qb, KMl, lut, lds, wave, lane);
    else           attn_unit_blk<1>(PB + 12 * PANEL, PB + 13 * PANEL, PB + 14 * PANEL, PB + 15 * PANEL, Y, 768, b, h, qb, KMl, lut, lds, wave, lane);
#elif ATT_STAGGER == 1
    if (mode == 0) attn_unit_stg<0>(PB + 8 * PANEL, PB + 9 * PANEL, PB + 10 * PANEL, PB + 11 * PANEL, Y, 512, b, h, qb, KMl, lut, lds, wave, lane);
    else           attn_unit_stg<1>(PB + 12 * PANEL, PB + 13 * PANEL, PB + 14 * PANEL, PB + 15 * PANEL, Y, 768, b, h, qb, KMl, lut, lds, wave, lane);
#else
    if (mode == 0) attn_unit<0>(PB + 8 * PANEL, PB + 9 * PANEL, PB + 10 * PANEL, PB + 11 * PANEL, Y, 512, b, h, qb, KMl, lut, lds, wave, lane);
    else           attn_unit<1>(PB + 12 * PANEL, PB + 13 * PANEL, PB + 14 * PANEL, PB + 15 * PANEL, Y, 768, b, h, qb, KMl, lut, lds, wave, lane);
#endif
#if PROBE_ATT
    if (mode == 0) attn_unit<0, PROBE_ATT>(PB + 8 * PANEL, PB + 9 * PANEL, PB + 10 * PANEL, PB + 11 * PANEL, Y, 512, b, h, qb, KMl, lut, lds, wave, lane);
    else           attn_unit<1, PROBE_ATT>(PB + 12 * PANEL, PB + 13 * PANEL, PB + 14 * PANEL, PB + 15 * PANEL, Y, 768, b, h, qb, KMl, lut, lds, wave, lane);
#endif
}
constexpr int RP = 144, TILE_B = 64 * RP;
constexpr int RW_LORA = 5 * TILE_B, RW_W2S = RW_LORA + 64 * 65 * 4, RW_A2S = RW_W2S + 8192;
constexpr int RW_TOT = 12 * TILE_B, RW_GL = RW_TOT + 2048, RW_END = RW_GL + 256;
constexpr int RW_W2P = 114688, RW_A2P = RW_W2P + 8192;
static_assert(2 * 64 * 68 * 4 <= 4 * TILE_B && RW_END <= RW_W2P && RW_W2P + 64 * RP <= RING_BYTES, "rwkv LDS map");

typedef GAS unsigned long long gu64;
__device__ __forceinline__ void st_wt64(GAS void* p, v2u v) { __hip_atomic_store((gu64*)p, ((unsigned long long)v.y << 32) | v.x, __ATOMIC_RELAXED, __HIP_MEMORY_SCOPE_AGENT); }
__device__ __forceinline__ void st_wt128(GAS void* p, v4u v) { st_wt64(p, (v2u){v.x, v.y}); st_wt64((GAS unsigned char*)p + 8, (v2u){v.z, v.w}); }
__device__ __forceinline__ void st_wt128f(GAS void* p, f32x4 v) { st_wt128(p, __builtin_bit_cast(v4u, v)); }
__device__ __forceinline__ bf16x8 rowfrag(const LAS unsigned char* tile, int idx0, int k0, int r32, int h2) { return *(const LAS bf16x8*)(tile + (idx0 + r32) * RP + (k0 + 8 * h2) * 2); }
__device__ __forceinline__ bf16x8 trfrag(const LAS unsigned char* tile, int k0, int idx0, int lane) {
    const int g = lane >> 4, i = lane & 15;
    const LAS unsigned char* p = tile + (k0 + 8 * (g >> 1) + (i >> 2)) * RP + (idx0 + 16 * (g & 1) + 4 * (i & 3)) * 2;
    const s16x4 lo = vtr(p), hi = vtr(p + 4 * RP);
    return (bf16x8){lo[0], lo[1], lo[2], lo[3], hi[0], hi[1], hi[2], hi[3]};
}
template <bool ATR, bool BTR>
__device__ __forceinline__ void quad_mma(f32x16& acc, const LAS unsigned char* At, int a0, const LAS unsigned char* Bt, int b0, int klo, int khi, int lane) {
    const int r32 = lane & 31, h2 = lane >> 5;
    const int nk = (khi - klo) >> 4;
    bf16x8 af[4], bfr[4];
#pragma unroll
    for (int i = 0; i < 4; ++i) { const int k0 = klo + 16 * i;
        af[i] = ATR ? trfrag(At, k0, a0, lane) : rowfrag(At, a0, k0, r32, h2);
        bfr[i] = BTR ? trfrag(Bt, k0, b0, lane) : rowfrag(Bt, b0, k0, r32, h2); }
    __builtin_amdgcn_sched_barrier(0);
    if (nk > 0) acc = __builtin_amdgcn_mfma_f32_32x32x16_bf16(bfr[0], af[0], acc, 0, 0, 0);
    if (nk > 1) acc = __builtin_amdgcn_mfma_f32_32x32x16_bf16(bfr[1], af[1], acc, 0, 0, 0);
    if (nk > 2) acc = __builtin_amdgcn_mfma_f32_32x32x16_bf16(bfr[2], af[2], acc, 0, 0, 0);
    if (nk > 3) acc = __builtin_amdgcn_mfma_f32_32x32x16_bf16(bfr[3], af[3], acc, 0, 0, 0);
}
__device__ __forceinline__ void quad_store_lds(const f32x16& acc, LAS unsigned char* tile, int a0, int b0, int lane) {
    const int r32 = lane & 31, h2 = lane >> 5;
#pragma unroll
    for (int g = 0; g < 4; ++g) { v2u w; w.x = cvtpk(acc[4 * g], acc[4 * g + 1]); w.y = cvtpk(acc[4 * g + 2], acc[4 * g + 3]);
        *(LAS v2u*)(tile + (a0 + r32) * RP + (b0 + 8 * g + 4 * h2) * 2) = w; }
}
#define RW_BAR() __syncthreads()

struct R1In { v4u l0, l1, r0, r1, k0, k1, v0, v1; };
__device__ __forceinline__ void r1_load(R1In& in, const gu8* wsc, int item, int tid) {
    const gbf* PB = (const gbf*)((gu8*)wsc + WS_PB); const gbf*P0 = PB, *P1 = PB + PANEL, *P2 = PB + 2 * PANEL, *P16 = PB + 16 * PANEL;
    const int c = item & 31, h = (item >> 5) & 3, b = (item >> 7) & 7, t = tid >> 3, cg = tid & 7, c0 = h * 64 + 8 * cg, tl = c * 64 + t;
    const size_t tok = (size_t)b * T + tl, prv = tok - (tl > 0 ? 1 : 0);
    in.l0 = *(const gv4u*)(P16 + tok * 64 + 8 * cg); in.l1 = *(const gv4u*)(P16 + prv * 64 + 8 * cg);
    in.r0 = *(const gv4u*)(P0 + tok * 256 + c0); in.r1 = *(const gv4u*)(P0 + prv * 256 + c0);
    in.k0 = *(const gv4u*)(P1 + tok * 256 + c0); in.k1 = *(const gv4u*)(P1 + prv * 256 + c0);
    in.v0 = *(const gv4u*)(P2 + tok * 256 + c0); in.v1 = *(const gv4u*)(P2 + prv * 256 + c0);
}
constexpr int RW_PAR = RW_W2P + 64 * RP;
static_assert(RW_PAR + 9 * 64 * 4 <= RING_BYTES, "rwkv parameter block");
__device__ __forceinline__ void r1_stage_lora_w(const DArgs& a, int l, int h, LAS unsigned char* lds, int tid) {
    const gf32*w2 = a.in[6] + l * 32 * 256, *a2 = a.in[8] + l * 32 * 256;
    const int idx = tid * 4, m = idx >> 6, j = idx & 63;
    const f32x4 wv = *(const gf32x4*)(w2 + m * 256 + h * 64 + j), av = *(const gf32x4*)(a2 + m * 256 + h * 64 + j);
    v2u ww, aw; ww.x = cvtpk(wv[0], wv[1]); ww.y = cvtpk(wv[2], wv[3]); aw.x = cvtpk(av[0], av[1]); aw.y = cvtpk(av[2], av[3]);
    *(LAS v2u*)(lds + RW_W2P + m * RP + j * 2) = ww; *(LAS v2u*)(lds + RW_W2P + 32 * RP + m * RP + j * 2) = aw;
}
__device__ __forceinline__ void rwkv_chunk_item(const gu8* wsc, const DArgs& a, int l, int item, const R1In& in, int next_item, R1In& nxt, LAS unsigned char* lds, int wave, int lane, int tid) {
    gu8* ws = (gu8*)wsc;
    const int c = item & 31, h = (item >> 5) & 3, b = (item >> 7) & 7;
    const gf32*mu = a.in[4] + l * 832, *w0 = a.in[5] + l * 256, *a0p = a.in[7] + l * 256,
                *k_k = a.in[9] + l * 256, *k_a = a.in[10] + l * 256, *r_k = a.in[11] + l * 256;
    gu8* tmpb = (gu8*)a.out;
    gbf* QtG = (gbf*)(tmpb) + (size_t)item * 4096; gbf* PG = (gbf*)(tmpb + 8 * MiB) + (size_t)item * 4096;
    gf32* YiG = (gf32*)(tmpb + 16 * MiB) + (size_t)item * 4096; gf32* GG = (gf32*)(ws + WS_R1) + (size_t)item * 4096;
    gf32* SB = (gf32*)(ws + WS_SB);
    const int r32 = lane & 31, h2 = lane >> 5;
#define TL(s) (lds + (s) * TILE_B)
    {
        const int t = tid >> 3, cg = tid & 7, c0 = h * 64 + 8 * cg, tl = c * 64 + t; const size_t tok = (size_t)b * T + tl; const bool hp = tl > 0;
        { float fc[8], fp[8], xl[8]; unpack8(in.l0, fc); unpack8(in.l1, fp);
#pragma unroll
          for (int e = 0; e < 8; ++e) { float x = fc[e] + ((hp ? fp[e] : 0.f) - fc[e]) * mu[768 + 8 * cg + e]; if (cg < 4) x = 1.0f - 2.0f * __builtin_amdgcn_rcpf(1.0f + __expf(2.0f * x)); xl[e] = x; }
          v4u w_; w_.x = cvtpk(xl[0], xl[1]); w_.y = cvtpk(xl[2], xl[3]); w_.z = cvtpk(xl[4], xl[5]); w_.w = cvtpk(xl[6], xl[7]); *(LAS v4u*)(TL(5) + t * RP + cg * 16) = w_; }
        float xr[8], xk[8], xv[8];
        { float f0[8], f1[8];
          unpack8(in.r0, f0); unpack8(in.r1, f1);
#pragma unroll
          for (int e = 0; e < 8; ++e) xr[e] = f0[e] + ((hp ? f1[e] : 0.f) - f0[e]) * mu[c0 + e];
          unpack8(in.k0, f0); unpack8(in.k1, f1);
#pragma unroll
          for (int e = 0; e < 8; ++e) xk[e] = f0[e] + ((hp ? f1[e] : 0.f) - f0[e]) * mu[256 + c0 + e];
          unpack8(in.v0, f0); unpack8(in.v1, f1);
#pragma unroll
          for (int e = 0; e < 8; ++e) xv[e] = f0[e] + ((hp ? f1[e] : 0.f) - f0[e]) * mu[512 + c0 + e]; }
        RW_BAR();
        { const int kind = wave >> 2, q = wave & 3, qa = (q >> 1) * 32, qb_ = (q & 1) * 32; f32x16 acc;
#pragma unroll
          for (int r = 0; r < 16; ++r) acc[r] = 0.f;
          quad_mma<false, true>(acc, TL(5) + kind * 64, qa, lds + RW_W2P + kind * 32 * RP, qb_, 0, 32, lane);
          LAS float* od = (LAS float*)(lds + 8 * TILE_B) + kind * (64 * 68) + (qa + r32) * 68 + qb_ + 4 * h2;
#pragma unroll
          for (int g = 0; g < 4; ++g) *(LAS f32x4*)(od + 8 * g) = (f32x4){acc[4 * g], acc[4 * g + 1], acc[4 * g + 2], acc[4 * g + 3]}; }
        RW_BAR();
        float lw[8], la[8];
        { const LAS float* lwp = (const LAS float*)(lds + 8 * TILE_B) + t * 68 + 8 * cg; const LAS float* lap = lwp + 64 * 68;
          const f32x4 w0_ = *(const LAS f32x4*)lwp, w1_ = *(const LAS f32x4*)(lwp + 4), a0_ = *(const LAS f32x4*)lap, a1_ = *(const LAS f32x4*)(lap + 4);
#pragma unroll
          for (int e = 0; e < 4; ++e) { lw[e] = w0_[e]; lw[4 + e] = w1_[e]; la[e] = a0_[e]; la[4 + e] = a1_[e]; } }
        float l2w[8], av[8], kk[8], kp[8]; float ssum = 0.f, sb = 0.f;
#pragma unroll
        for (int e = 0; e < 8; ++e) {
            l2w[e] = (-0.6065306597126334f * LOG2E) * sigmoidf_(w0[c0 + e] + lw[e]);
            av[e] = sigmoidf_(a0p[c0 + e] + la[e]);
            kk[e] = xk[e] * k_k[c0 + e]; ssum += kk[e] * kk[e];
            kp[e] = xk[e] * (1.0f + (av[e] - 1.0f) * k_a[c0 + e]);
            sb += xr[e] * kp[e] * r_k[c0 + e];
        }
        ssum += __shfl_xor(ssum, 1); ssum += __shfl_xor(ssum, 2); ssum += __shfl_xor(ssum, 4);
        sb += __shfl_xor(sb, 1); sb += __shfl_xor(sb, 2); sb += __shfl_xor(sb, 4);
        if (cg == 0) SB[tok * 4 + h] = sb;
        const float rn = __builtin_amdgcn_rsqf(fmaxf(ssum, 1e-24f));
        float cs[8];
#pragma unroll
        for (int e = 0; e < 8; ++e) cs[e] = l2w[e];
#pragma unroll
        for (int off = 8; off < 64; off <<= 1) {
#pragma unroll
            for (int e = 0; e < 8; ++e) { const float v = __shfl_up(cs[e], off); if (lane >= off) cs[e] += v; }
        }
        LAS float* tot = (LAS float*)(lds + RW_TOT);
        if (lane >= 56) {
#pragma unroll
            for (int e = 0; e < 8; ++e) tot[wave * 64 + 8 * cg + e] = cs[e]; }
        RW_BAR();
        for (int w = 0; w < wave; ++w) {
            const f32x4 ta = *(const LAS f32x4*)(tot + w * 64 + 8 * cg), tb = *(const LAS f32x4*)(tot + w * 64 + 8 * cg + 4);
#pragma unroll
            for (int e = 0; e < 4; ++e) { cs[e] += ta[e]; cs[4 + e] += tb[e]; }
        }
        float vRb[8], vAb[8], vBb[8], vKb[8];
#pragma unroll
        for (int e = 0; e < 8; ++e) {
            const float g = ex2(cs[e]), gp = ex2(cs[e] - l2w[e]), gi = ex2(-cs[e]); const float kn = kk[e] * rn;
            vRb[e] = xr[e] * g; vAb[e] = kn * gp; vBb[e] = -kn * av[e] * gi; vKb[e] = kp[e] * gi;
            if (t == 63) ((LAS float*)(lds + RW_GL))[8 * cg + e] = g;
        }
#define ST8(slot, v) do { v4u w_; w_.x = cvtpk(v[0], v[1]); w_.y = cvtpk(v[2], v[3]); w_.z = cvtpk(v[4], v[5]); w_.w = cvtpk(v[6], v[7]); *(LAS v4u*)(TL(slot) + t * RP + cg * 16) = w_; } while (0)
        ST8(0, vRb); ST8(1, vAb); ST8(2, vBb); ST8(3, vKb); ST8(4, xv);
#undef ST8
        RW_BAR();
    }
    if (PROBE_R1 == 1 && item >= 4096) return;
    f32x16 macc;
#pragma unroll
    for (int r = 0; r < 16; ++r) macc[r] = 0.f;
#pragma unroll
    for (int rnd = 0; rnd < 2; ++rnd) {
        const int id = rnd * 8 + wave;
        if (id < 12) {
            const int mi = id / 3, qi = id % 3, qa = qi >= 1 ? 32 : 0, qb_ = qi == 2 ? 32 : 0;
            f32x16 acc;
#pragma unroll
            for (int r = 0; r < 16; ++r) acc[r] = 0.f;
            quad_mma<false, false>(acc, TL(mi < 2 ? 1 : 0), qa, TL((mi & 1) ? 3 : 2), qb_, 0, 64, lane);
            const int trow = qa + r32; const bool strict = mi < 2;
#pragma unroll
            for (int r = 0; r < 16; ++r) { const int tau = qb_ + (r & 3) + 8 * (r >> 2) + 4 * h2; const bool keep = strict ? (tau < trow) : (tau <= trow); acc[r] = keep ? acc[r] : 0.f; }
            quad_store_lds(acc, TL(5 + mi), qa, qb_, lane);
            if (mi == 0) {
#pragma unroll
                for (int r = 0; r < 16; ++r) { const int tau = qb_ + (r & 3) + 8 * (r >> 2) + 4 * h2; macc[r] = acc[r] + (tau == trow ? 1.0f : 0.f); }
                quad_store_lds(macc, TL(10), qa, qb_, lane);
            }
        }
    }
    RW_BAR();
    {
        const int qi = wave < 3 ? wave : wave - 3, qa = qi >= 1 ? 32 : 0, qb_ = qi == 2 ? 32 : 0;
        if (wave >= 3 && wave < 6) { f32x16 acc;
#pragma unroll
            for (int r = 0; r < 16; ++r) acc[r] = 0.f;
            quad_mma<false, true>(acc, TL(5), qa, TL(5), qb_, qb_, qa + 32, lane); quad_store_lds(acc, TL(9), qa, qb_, lane); }
        RW_BAR();
#pragma unroll
        for (int k = 1; k <= 5; ++k) {
            const int xs = (k & 1) ? 9 : 5, xd = (k & 1) ? 5 : 9, ms = (k & 1) ? 10 : 11, md = (k & 1) ? 11 : 10;
            if (wave < 3) { quad_mma<false, true>(macc, TL(ms), qa, TL(xs), qb_, qb_, qa + 32, lane); quad_store_lds(macc, TL(md), qa, qb_, lane); }
            else if (wave < 6 && k < 5) { f32x16 acc;
#pragma unroll
                for (int r = 0; r < 16; ++r) acc[r] = 0.f;
                quad_mma<false, true>(acc, TL(xs), qa, TL(xs), qb_, qb_, qa + 32, lane); quad_store_lds(acc, TL(xd), qa, qb_, lane); }
            RW_BAR();
        }
    }
    {
        const int q = wave & 3, qa = (q >> 1) * 32, qb_ = (q & 1) * 32; f32x16 acc;
#pragma unroll
        for (int r = 0; r < 16; ++r) acc[r] = 0.f;
        if (wave < 4) { quad_mma<false, true>(acc, TL(11), qa, TL(1), qb_, 0, qa + 32, lane); quad_store_lds(acc, TL(5), qa, qb_, lane); }
        else          { quad_mma<false, true>(acc, TL(6), qa, TL(4), qb_, 0, qa + 32, lane); quad_store_lds(acc, TL(9), qa, qb_, lane); }
    }
    RW_BAR();
    if (next_item >= 0) r1_load(nxt, wsc, next_item, tid);
    const LAS float* gl = (const LAS float*)(lds + RW_GL);
#pragma unroll
    for (int rnd = 0; rnd < 2; ++rnd) {
        const int id = rnd * 8 + wave;
        if (id < 12) {
            const int kind = id >> 2, q = id & 3, qa = (q >> 1) * 32, qb_ = (q & 1) * 32; const int row = qa + r32; f32x16 acc;
#pragma unroll
            for (int r = 0; r < 16; ++r) acc[r] = 0.f;
            if (kind == 0) { quad_mma<false, true>(acc, TL(11), qa, TL(9), qb_, 0, qa + 32, lane); quad_store_lds(acc, TL(10), qa, qb_, lane); }
            else if (kind == 1) {
#pragma unroll
                for (int g = 0; g < 4; ++g) { const v2u w = *(const LAS v2u*)(TL(0) + row * RP + (qb_ + 8 * g + 4 * h2) * 2);
                    acc[4 * g] = bf2f(w.x & 0xffffu); acc[4 * g + 1] = bf2f(w.x >> 16); acc[4 * g + 2] = bf2f(w.y & 0xffffu); acc[4 * g + 3] = bf2f(w.y >> 16); }
                quad_mma<false, true>(acc, TL(7), qa, TL(5), qb_, 0, qa + 32, lane);
#pragma unroll
                for (int g = 0; g < 4; ++g) { v2u w; w.x = cvtpk(acc[4 * g], acc[4 * g + 1]); w.y = cvtpk(acc[4 * g + 2], acc[4 * g + 3]); *(gv2u*)(QtG + row * 64 + qb_ + 8 * g + 4 * h2) = w; }
            } else {
                quad_mma<true, true>(acc, TL(2), qa, TL(5), qb_, 0, 64, lane);
                const float gL = gl[row];
                float p[16];
#pragma unroll
                for (int r = 0; r < 16; ++r) { const int col = qb_ + 8 * (r >> 2) + 4 * h2 + (r & 3); p[r] = gL * (acc[r] + (col == row ? 1.0f : 0.f)); }
#pragma unroll
                for (int s = 0; s < 2; ++s) { v4u w; w.x = cvtpk(p[8 * s], p[8 * s + 1]); w.y = cvtpk(p[8 * s + 2], p[8 * s + 3]); w.z = cvtpk(p[8 * s + 4], p[8 * s + 5]); w.w = cvtpk(p[8 * s + 6], p[8 * s + 7]);
                    *(gv4u*)(PG + (((qa >> 5) * 4 + (qb_ >> 4) + s) * 64 + lane) * 8) = w; }
            }
        }
    }
    RW_BAR();
    {
        const int q = wave & 3, qa = (q >> 1) * 32, qb_ = (q & 1) * 32; const int row = qa + r32; f32x16 acc;
#pragma unroll
        for (int r = 0; r < 16; ++r) acc[r] = 0.f;
        if (wave < 4) {
            quad_mma<false, true>(acc, TL(7), qa, TL(10), qb_, 0, qa + 32, lane); quad_mma<false, true>(acc, TL(8), qa, TL(4), qb_, 0, qa + 32, lane);
#pragma unroll
            for (int g = 0; g < 4; ++g) *(gf32x4*)(YiG + row * 64 + qb_ + 8 * g + 4 * h2) = (f32x4){acc[4 * g], acc[4 * g + 1], acc[4 * g + 2], acc[4 * g + 3]};
        } else {
            for (int k0 = 0; k0 < 64; k0 += 16) { acc = __builtin_amdgcn_mfma_f32_32x32x16_bf16(trfrag(TL(2), k0, qa, lane), trfrag(TL(10), k0, qb_, lane), acc, 0, 0, 0);
                                                  acc = __builtin_amdgcn_mfma_f32_32x32x16_bf16(trfrag(TL(3), k0, qa, lane), trfrag(TL(4), k0, qb_, lane), acc, 0, 0, 0); }
            gf32* gp = GG + ((((qb_ >> 5) * 2 + (qa >> 5)) * 4) * 64 + lane) * 4;
#pragma unroll
            for (int g = 0; g < 4; ++g) { const f32x4 gv = *(const LAS f32x4*)(gl + qa + 8 * g + 4 * h2);
                *(gf32x4*)(gp + g * 256) = (f32x4){gv[0] * acc[4 * g], gv[1] * acc[4 * g + 1], gv[2] * acc[4 * g + 2], gv[3] * acc[4 * g + 3]}; }
        }
    }
    RW_BAR();
#undef TL
}

constexpr int SC_NS = 5, SC_SLOT = 24576;
static_assert(SC_NS * SC_SLOT <= RING_BYTES, "scan ring");
__device__ __forceinline__ void rwkv_scan(const gu8* wsc, const gu8* tmpc, int bh, LAS unsigned char* lds, int wave, int lane) {
    gu8* ws = (gu8*)wsc;
    const gbf* PGb = (const gbf*)(tmpc + 8 * MiB) + (size_t)bh * 32 * 4096; const gf32* GGb = (const gf32*)(ws + WS_R1) + (size_t)bh * 32 * 4096;
    gbf* TGb = (gbf*)(ws + WS_YRAW) + (size_t)bh * 32 * 4096;
    const int r32 = lane & 31, h2 = lane >> 5, cb = wave & 1;
    const unsigned lds0 = (unsigned)(uintptr_t)lds;
#define SC_DMA(c_, slot_) do { _Pragma("unroll") for (int q_ = 0; q_ < 4; ++q_) { const int p_ = (wave - 2) * 4 + q_; \
        const GAS void* src_ = p_ < 8 ? (const GAS void*)(PGb + (size_t)(c_) * 4096 + p_ * 512 + lane * 8) : (const GAS void*)(GGb + (size_t)(c_) * 4096 + (p_ - 8) * 256 + lane * 4); \
        glds16(src_, (unsigned)__builtin_amdgcn_readfirstlane(lds0 + (slot_) * SC_SLOT + p_ * 1024)); } } while (0)
    if (wave >= 2) { SC_DMA(0, 0); SC_DMA(1, 1); SC_DMA(2, 2); SC_DMA(3, 3); asm volatile("s_waitcnt vmcnt(12)" ::: "memory"); }
    asm volatile("s_waitcnt lgkmcnt(0)\n\ts_barrier" ::: "memory");
    f32x16 T0, T1;
#pragma unroll
    for (int r = 0; r < 16; ++r) { T0[r] = 0.f; T1[r] = 0.f; }
    for (int c = 0; c < 32; ++c) {
        if (wave >= 2) { if (c + 4 < 32) SC_DMA(c + 4, (c + 4) % SC_NS); }
        else {
            const LAS unsigned char* sl = lds + (c % SC_NS) * SC_SLOT;
            gbf* Tp = TGb + (size_t)c * 4096 + (32 * cb + r32) * 64;
            bf16x8 tb[4];
#pragma unroll
            for (int g = 0; g < 4; ++g) {
                v2u w0, w1; w0.x = cvtpk(T0[4 * g], T0[4 * g + 1]); w0.y = cvtpk(T0[4 * g + 2], T0[4 * g + 3]); w1.x = cvtpk(T1[4 * g], T1[4 * g + 1]); w1.y = cvtpk(T1[4 * g + 2], T1[4 * g + 3]);
                *(gv2u*)(Tp + 8 * g + 4 * h2) = w0; *(gv2u*)(Tp + 32 + 8 * g + 4 * h2) = w1;
            }
#pragma unroll
            for (int s = 0; s < 2; ++s) {
                v4u w0, w1;
                w0.x = cvtpk(T0[8 * s], T0[8 * s + 1]); w0.y = cvtpk(T0[8 * s + 2], T0[8 * s + 3]); w0.z = cvtpk(T0[8 * s + 4], T0[8 * s + 5]); w0.w = cvtpk(T0[8 * s + 6], T0[8 * s + 7]);
                w1.x = cvtpk(T1[8 * s], T1[8 * s + 1]); w1.y = cvtpk(T1[8 * s + 2], T1[8 * s + 3]); w1.z = cvtpk(T1[8 * s + 4], T1[8 * s + 5]); w1.w = cvtpk(T1[8 * s + 6], T1[8 * s + 7]);
                tb[s] = __builtin_bit_cast(bf16x8, w0); tb[2 + s] = __builtin_bit_cast(bf16x8, w1);
            }
            f32x16 N0, N1;
#pragma unroll
            for (int g = 0; g < 4; ++g) {
                const f32x4 ga = *(const LAS f32x4*)(sl + 8192 + (((cb * 2 + 0) * 4 + g) * 64 + lane) * 16), gb = *(const LAS f32x4*)(sl + 8192 + (((cb * 2 + 1) * 4 + g) * 64 + lane) * 16);
                N0[4 * g] = ga[0]; N0[4 * g + 1] = ga[1]; N0[4 * g + 2] = ga[2]; N0[4 * g + 3] = ga[3]; N1[4 * g] = gb[0]; N1[4 * g + 1] = gb[1]; N1[4 * g + 2] = gb[2]; N1[4 * g + 3] = gb[3];
            }
#pragma unroll
            for (int ks = 0; ks < 4; ++ks) {
                const bf16x8 a0 = *(const LAS bf16x8*)(sl + ((0 * 4 + ks) * 64 + lane) * 16), a1 = *(const LAS bf16x8*)(sl + ((1 * 4 + ks) * 64 + lane) * 16);
                N0 = __builtin_amdgcn_mfma_f32_32x32x16_bf16(a0, tb[ks], N0, 0, 0, 0);
                N1 = __builtin_amdgcn_mfma_f32_32x32x16_bf16(a1, tb[ks], N1, 0, 0, 0);
            }
            T0 = N0; T1 = N1;
        }
        if (wave >= 2) { if (c + 4 < 32) asm volatile("s_waitcnt vmcnt(12)" ::: "memory"); else if (c + 3 < 32) asm volatile("s_waitcnt vmcnt(8)" ::: "memory");
                         else if (c + 2 < 32) asm volatile("s_waitcnt vmcnt(4)" ::: "memory"); else asm volatile("s_waitcnt vmcnt(0)" ::: "memory"); }
        asm volatile("s_waitcnt lgkmcnt(0)\n\ts_barrier" ::: "memory");
    }
#undef SC_DMA
}

__device__ __forceinline__ void rwkv_out_item(const gu8* wsc, const DArgs& a, int l, int e, int wave, int lane) {
    gu8* ws = (gu8*)wsc;
    const gu8* tmpb = (const gu8*)a.out;
    const gbf* QtGb = (const gbf*)(tmpb); const gf32* YiGb = (const gf32*)(tmpb + 16 * MiB); const gbf* TGb = (const gbf*)(ws + WS_YRAW);
    const gf32* SB = (const gf32*)(ws + WS_SB);
    const gbf* P2 = (const gbf*)(ws + WS_PB) + 2 * PANEL; const gbf* P3 = (const gbf*)(ws + WS_PB) + 3 * PANEL;
    const gf32*mu_v = a.in[4] + l * 832 + 512, *lnx_w = a.in[12] + l * 256, *lnx_b = a.in[13] + l * 256;
    gbf* Y = (gbf*)(ws + WS_XB);
    const int r32 = lane & 31, h2 = lane >> 5;
    {
        const int tb_ = wave & 1, item = (e >> 3) * 32 + (e & 7) * 4 + (wave >> 1), c = item & 31, h = (item >> 5) & 3, b = item >> 7;
        const int tl = c * 64 + 32 * tb_ + r32; const size_t tok = (size_t)b * T + tl;
        const gbf* Qp = QtGb + (size_t)item * 4096 + (32 * tb_ + r32) * 64; const gf32* Yp = YiGb + (size_t)item * 4096 + (32 * tb_ + r32) * 64; const gbf* Tp = TGb + (size_t)item * 4096;
        f32x16 acc[2];
#pragma unroll
        for (int ib = 0; ib < 2; ++ib)
#pragma unroll
            for (int g = 0; g < 4; ++g) { const f32x4 y = *(const gf32x4*)(Yp + 32 * ib + 8 * g + 4 * h2); acc[ib][4 * g] = y[0]; acc[ib][4 * g + 1] = y[1]; acc[ib][4 * g + 2] = y[2]; acc[ib][4 * g + 3] = y[3]; }
#pragma unroll
        for (int ks = 0; ks < 4; ++ks) {
            const bf16x8 qf = *(const gbf16x8*)(Qp + 16 * ks + 8 * h2);
#pragma unroll
            for (int ib = 0; ib < 2; ++ib) { const bf16x8 tf = *(const gbf16x8*)(Tp + (32 * ib + r32) * 64 + 16 * ks + 8 * h2);
                acc[ib] = __builtin_amdgcn_mfma_f32_32x32x16_bf16(tf, qf, acc[ib], 0, 0, 0); }
        }
        float s = 0.f;
#pragma unroll
        for (int r = 0; r < 16; ++r) s += acc[0][r] + acc[1][r];
        s += __shfl_xor(s, 32); const float mean = s * (1.0f / 64.0f);
        float vs = 0.f;
#pragma unroll
        for (int r = 0; r < 16; ++r) { const float d0 = acc[0][r] - mean, d1 = acc[1][r] - mean; vs += d0 * d0 + d1 * d1; }
        vs += __shfl_xor(vs, 32); const float rstd = rsqrtf(vs * (1.0f / 64.0f) + 64e-5f);
        const float sb = SB[tok * 4 + h]; const bool hp = tl > 0;
        const size_t tokp = hp ? tok - 1 : tok;
#pragma unroll
        for (int ib = 0; ib < 2; ++ib) {
            f32x4 lw[4], lb[4], mv[4]; v2u vc[4], gt[4], vp[4];
#pragma unroll
            for (int g = 0; g < 4; ++g) { const int ch = h * 64 + 32 * ib + 8 * g + 4 * h2;
                lw[g] = *(const gf32x4*)(lnx_w + ch); lb[g] = *(const gf32x4*)(lnx_b + ch); mv[g] = *(const gf32x4*)(mu_v + ch);
                vc[g] = *(const gv2u*)(P2 + tok * 256 + ch); gt[g] = *(const gv2u*)(P3 + tok * 256 + ch); vp[g] = *(const gv2u*)(P2 + tokp * 256 + ch); }
#pragma unroll
            for (int g = 0; g < 4; ++g) {
                const int ch = h * 64 + 32 * ib + 8 * g + 4 * h2;
                float o[4];
#pragma unroll
                for (int e = 0; e < 4; ++e) {
                    const unsigned sh = (e & 1) * 16; const float v0 = bf2f(((e >> 1 ? vc[g].y : vc[g].x) >> sh) & 0xffffu), v1 = hp ? bf2f(((e >> 1 ? vp[g].y : vp[g].x) >> sh) & 0xffffu) : 0.f, gg = bf2f(((e >> 1 ? gt[g].y : gt[g].x) >> sh) & 0xffffu);
                    const float xv = v0 + (v1 - v0) * mv[g][e];
                    o[e] = ((acc[ib][4 * g + e] - mean) * rstd * lw[g][e] + lb[g][e] + sb * xv) * gg;
                }
                v2u w; w.x = cvtpk(o[0], o[1]); w.y = cvtpk(o[2], o[3]);
                *(gv2u*)(Y + tok * D + ch) = w;
            }
        }
    }
}

constexpr int LR_PITCH = 68;
static_assert(4 * 64 * LR_PITCH * 4 <= RING_BYTES, "lora partials fit the LDS scratch");
__device__ __forceinline__ void lora_proj(const gu8* wsc, int l, LAS unsigned char* lds, int wave, int lane, int tid) {
    gu8* ws = (gu8*)wsc;
    const gbf* XA = (const gbf*)(ws + WS_XA); const gbf* WL = (const gbf*)(ws + WS_WIN) + (size_t)l * NPAD * D + (size_t)4096 * D;
    const gf32* ssq = (const gf32*)(ws + WS_CTL + CTL_SSQ) + (size_t)l * M; gbf* P16 = (gbf*)(ws + WS_PB) + 16 * PANEL;
    const int r32 = lane & 31, h2 = lane >> 5, ksl = wave & 3, a = wave >> 2;
    LAS float* part = (LAS float*)lds;
    for (int blk = blockIdx.x; blk < M / 64; blk += gridDim.x) {
        const int r0 = blk * 64;
        f32x16 acc0, acc1;
#pragma unroll
        for (int r = 0; r < 16; ++r) { acc0[r] = 0.f; acc1[r] = 0.f; }
#pragma unroll 4
        for (int s = 0; s < 16; ++s) {
            const int k = 256 * ksl + 16 * s + 8 * h2;
            const bf16x8 af = *(const gbf16x8*)(XA + (size_t)(r0 + 32 * a + r32) * D + k);
            const bf16x8 b0 = *(const gbf16x8*)(WL + (size_t)r32 * D + k), b1 = *(const gbf16x8*)(WL + (size_t)(32 + r32) * D + k);
            acc0 = __builtin_amdgcn_mfma_f32_32x32x16_bf16(b0, af, acc0, 0, 0, 0); acc1 = __builtin_amdgcn_mfma_f32_32x32x16_bf16(b1, af, acc1, 0, 0, 0);
        }
#pragma unroll
        for (int g = 0; g < 4; ++g) {
            *(LAS f32x4*)(part + (ksl * 64 + 32 * a + r32) * LR_PITCH + 8 * g + 4 * h2) = (f32x4){acc0[4 * g], acc0[4 * g + 1], acc0[4 * g + 2], acc0[4 * g + 3]};
            *(LAS f32x4*)(part + (ksl * 64 + 32 * a + r32) * LR_PITCH + 32 + 8 * g + 4 * h2) = (f32x4){acc1[4 * g], acc1[4 * g + 1], acc1[4 * g + 2], acc1[4 * g + 3]};
        }
        __syncthreads();
        { const int row = tid >> 3, cg = tid & 7; f32x4 s0 = {0.f, 0.f, 0.f, 0.f}, s1 = {0.f, 0.f, 0.f, 0.f};
#pragma unroll
          for (int w = 0; w < 4; ++w) { s0 += *(const LAS f32x4*)(part + (w * 64 + row) * LR_PITCH + 8 * cg); s1 += *(const LAS f32x4*)(part + (w * 64 + row) * LR_PITCH + 8 * cg + 4); }
          const float rs = rsqrtf(ssq[r0 + row] * (1.0f / 1024.0f) + 1e-6f);
          v4u o; o.x = cvtpk(s0[0] * rs, s0[1] * rs); o.y = cvtpk(s0[2] * rs, s0[3] * rs); o.z = cvtpk(s1[0] * rs, s1[1] * rs); o.w = cvtpk(s1[2] * rs, s1[3] * rs);
          *(gv4u*)(P16 + (size_t)(r0 + row) * 64 + 8 * cg) = o; }
        __syncthreads();
    }
}

__device__ __forceinline__ int src_col(int n) { return n < 768 ? n : (n < 4096 ? n + 64 : n - 4096 + 768); }

__device__ __forceinline__ void p0_transpose_item(const gf32* W, int N, int K, const gf32* kscale, gbf* WT, int dst_row0, int src_col0, int k0, LAS float* scr, int lane) {
    float wv[32];
#pragma unroll
    for (int i = 0; i < 32; ++i) wv[i] = W[(size_t)(k0 + 2 * i + (lane >> 5)) * N + src_col0 + (lane & 31)];
    if (kscale) {
#pragma unroll
        for (int i = 0; i < 32; ++i) wv[i] *= kscale[k0 + 2 * i + (lane >> 5)];
    }
#pragma unroll
    for (int i = 0; i < 32; ++i) scr[(2 * i + (lane >> 5)) * 33 + (lane & 31)] = wv[i];
    LDS_WAIT(); asm volatile("" ::: "memory");
    const int c = lane & 7;
#pragma unroll
    for (int j = 0; j < 4; ++j) { const int n = (lane >> 3) + 8 * j; const LAS float* s = scr + (8 * c) * 33 + n;
        v4u o; o.x = pk2(s[0 * 33], s[1 * 33]); o.y = pk2(s[2 * 33], s[3 * 33]); o.z = pk2(s[4 * 33], s[5 * 33]); o.w = pk2(s[6 * 33], s[7 * 33]);
        *(gv4u*)(WT + (size_t)(dst_row0 + n) * K + k0 + 8 * c) = o; }
    LDS_WAIT(); asm volatile("" ::: "memory");
}

__device__ __forceinline__ void convert_weights(const DArgs& a, int l0, int l1, int w, int nw, LAS unsigned char* lds, int wave, int lane) {
    gu8* ws = a.ws;
    LAS float* scr = (LAS float*)(lds + RING_OFF + wave * 16384);
    constexpr int I_IN = 16 * 130, I_OUT = 16 * 32, I_L = I_IN + I_OUT;
    for (int it = l0 * I_L + w; it < l1 * I_L; it += nw) {
        const int l = it / I_L; int r = it % I_L;
        if (r < I_IN) { const int kb = r / 130, nb = r % 130;
            p0_transpose_item(a.in[2] + (size_t)l * D * WCOLS, WCOLS, D, a.in[1] + l * D, (gbf*)(ws + WS_WIN) + (size_t)l * NPAD * D, 32 * nb, src_col(32 * nb), 64 * kb, scr, lane); }
        else { r -= I_IN; const int kb = r / 32, nb = r % 32;
            p0_transpose_item(a.in[3] + (size_t)l * D * D, D, D, nullptr, (gbf*)(ws + WS_WOUT) + (size_t)l * D * D, 32 * nb, 32 * nb, 64 * kb, scr, lane); }
    }
}
constexpr int W_LATER = 1;
__device__ __forceinline__ void phase_prologue(const DArgs& a, LAS unsigned char* lds, int wave, int lane, int tid) {
    gu8* ws = a.ws;
    const int G = gridDim.x, gw = blockIdx.x * NWAVES + wave, NGW = G * NWAVES;
    convert_weights(a, 0, (G == 256) ? W_LATER : DEPTH, gw, NGW, lds, wave, lane);
    { const gf32* x = a.in[0]; gbf* xa = (gbf*)(ws + WS_XA); gf32* ssq0 = (gf32*)(ws + WS_CTL + CTL_SSQ);
      for (int m0 = gw * 4; m0 < M; m0 += NGW * 4) {
          f32x4 v[4][4];
#pragma unroll
          for (int r = 0; r < 4; ++r) { const gf32x4* xr = (const gf32x4*)(x + (size_t)(m0 + r) * D) + lane;
#pragma unroll
              for (int j = 0; j < 4; ++j) v[r][j] = xr[64 * j]; }
#pragma unroll
          for (int r = 0; r < 4; ++r) { float s = 0.f;
#pragma unroll
              for (int j = 0; j < 4; ++j) s += (v[r][j].x * v[r][j].x + v[r][j].y * v[r][j].y) + (v[r][j].z * v[r][j].z + v[r][j].w * v[r][j].w);
              s = wave_sum(s); if (lane == 0) ssq0[m0 + r] = s;
              gv2u* o8 = (gv2u*)(xa + (size_t)(m0 + r) * D) + lane;
#pragma unroll
              for (int j = 0; j < 4; ++j) { v2u o; o.x = pk2(v[r][j].x, v[r][j].y); o.y = pk2(v[r][j].z, v[r][j].w); o8[64 * j] = o; } }
      } }
    { const int gt = blockIdx.x * (NWAVES * 64) + tid, NT = G * NWAVES * 64;
      gf32* lut = (gf32*)(ws + WS_TAB + TAB_LUT);
      if (gt < 32) ((gf32*)(ws + WS_TAB + TAB_THR))[gt] = (float)(THETA_D[gt] * 0.15915494309189535);
      for (int idx = gt; idx < NH * 128; idx += NT) { const int h = idx >> 7, d = idx & 127;
          int bk = d; if (d >= 16) { bk = 16 + (int)(logf((float)d * (1.0f / 16.0f)) / 2.0794415416798357f * 16.0f); if (bk > 31) bk = 31; }
          lut[idx] = a.in[15][bk * NH + h]; }
      gf32* lut2 = (gf32*)(ws + WS_TAB + TAB_LUT2);
      for (int idx = gt; idx < NH * 1536; idx += NT) { const int h = idx / 1536, w = idx % 1536, c = w / 336, i = w % 336;
          float v = -1e30f;
          if (c < 4) { const int d = 255 - (i + c);
              if (d > 127) v = 0.f;
              else if (d >= 0) { int bk = d; if (d >= 16) { bk = 16 + (int)(logf((float)d * (1.0f / 16.0f)) / 2.0794415416798357f * 16.0f); if (bk > 31) bk = 31; }
                  v = (a.in[15][bk * NH + h] - a.in[15][31 * NH + h]) * 1.4426950408889634f; } }
          lut2[idx] = v; }
    }
}

__device__ __forceinline__ void conv_item(const DArgs& a, int l, int e, int wave, int lane) {
    gu8* ws = a.ws; const gf32* cw = a.in[14] + l * 768;
    const gbf* PB = (const gbf*)(ws + WS_PB);
    const gbf*Pb = PB + 4 * PANEL, *Pc = PB + 5 * PANEL, *Ph = PB + 6 * PANEL, *Pg = PB + 7 * PANEL;
    gbf* Y = (gbf*)(ws + WS_XB);
    const int tok0 = e * 64 + wave * 8, t0 = tok0 & (T - 1); const size_t o0 = (size_t)tok0 * 256 + 4 * lane;
    v2u bb[8], gg[8], cc[10], hh[10];
#pragma unroll
    for (int i = 0; i < 8; ++i) { bb[i] = *(const gv2u*)(Pb + o0 + i * 256); gg[i] = *(const gv2u*)(Pg + o0 + i * 256); cc[i + 2] = *(const gv2u*)(Pc + o0 + i * 256); hh[i + 2] = *(const gv2u*)(Ph + o0 + i * 256); }
    cc[0] = cc[1] = hh[0] = hh[1] = (v2u){0u, 0u};
    if (t0 >= 2) { cc[0] = *(const gv2u*)(Pc + o0 - 512); hh[0] = *(const gv2u*)(Ph + o0 - 512); cc[1] = *(const gv2u*)(Pc + o0 - 256); hh[1] = *(const gv2u*)(Ph + o0 - 256); }
    const f32x4 w0 = *(const gf32x4*)(cw + 4 * lane), w1 = *(const gf32x4*)(cw + 256 + 4 * lane), w2 = *(const gf32x4*)(cw + 512 + 4 * lane);
#pragma unroll
    for (int i = 0; i < 8; ++i) {
        float out[4];
#pragma unroll
        for (int j = 0; j < 4; ++j) {
            const unsigned sh = (j & 1) * 16; const int hi = j >> 1;
#define EL(v) bf2f(((hi ? (v).y : (v).x) >> sh) & 0xffffu)
            const float u0 = EL(cc[i + 2]) * EL(hh[i + 2]), u1 = EL(cc[i + 1]) * EL(hh[i + 1]), u2 = EL(cc[i]) * EL(hh[i]);
            out[j] = EL(bb[i]) * (w0[j] * u2 + w1[j] * u1 + w2[j] * u0) * EL(gg[i]);
#undef EL
        }
        v2u w; w.x = cvtpk(out[0], out[1]); w.y = cvtpk(out[2], out[3]);
        *(gv2u*)(Y + (size_t)(tok0 + i) * D + 256 + 4 * lane) = w;
    }
}

constexpr int QN_SCAN = 32, QN_ATT = 512, QN_CONV = M / 64, QN_OUT = 256, QN_ALL = QN_SCAN + QN_ATT + QN_CONV + QN_OUT;
constexpr int QW_HEAD = 0, QW_CNT = 64, QW_SCANDONE = 64 * 40, QW_LAYER = 4096;
__device__ __forceinline__ bool q_wait_ge(GAS unsigned* w, unsigned need, GAS unsigned* tmo) {
    unsigned sp = 0; bool ok = true;
    while (__hip_atomic_load(w, __ATOMIC_RELAXED, __HIP_MEMORY_SCOPE_AGENT) < need) {
        __builtin_amdgcn_s_sleep(2);
        if ((++sp & 255u) == 0u) { if (__hip_atomic_load(tmo, __ATOMIC_RELAXED, __HIP_MEMORY_SCOPE_AGENT) != 0u) { ok = false; break; }
                                   if (sp > (1u << 20)) { __hip_atomic_store(tmo, 1u, __ATOMIC_RELAXED, __HIP_MEMORY_SCOPE_AGENT); ok = false; break; } }
    }
    __builtin_amdgcn_fence(__ATOMIC_ACQUIRE, "agent");
    asm volatile("s_waitcnt vmcnt(0)" ::: "memory");
    return ok;
}
__device__ __forceinline__ void q_publish(GAS unsigned* w, unsigned add) {
    __builtin_amdgcn_fence(__ATOMIC_RELEASE, "agent");
    asm volatile("s_waitcnt vmcnt(0)" ::: "memory");
    __hip_atomic_fetch_add(w, add, __ATOMIC_RELAXED, __HIP_MEMORY_SCOPE_AGENT);
}
__device__ __forceinline__ void mix_phase(const DArgs& a0_, int l, int qblk, LAS unsigned char* lds, int wave, int lane0_, int tid) {
    GAS unsigned* qw = (GAS unsigned*)(a0_.ws + WS_CTL + CTL_Q) + qblk * QW_LAYER;
    GAS unsigned* tmo = (GAS unsigned*)(a0_.ws + WS_CTL) + 8;
    volatile LAS unsigned* qslot = (volatile LAS unsigned*)(lds + MISC_OFF + 64);
    {
        R1In inA, inB; int staged_h = -1;
        if ((int)blockIdx.x < BATCH * NH * 32) r1_load(inA, a0_.ws, blockIdx.x, tid);
        for (int item = blockIdx.x; item < BATCH * NH * 32; item += gridDim.x) {
            int ln2; asm volatile("v_mbcnt_lo_u32_b32 %0, -1, 0\n\tv_mbcnt_hi_u32_b32 %0, -1, %0" : "=v"(ln2));
            const int td2 = wave * 64 + ln2;
            const int h = (item >> 5) & 3;
            if (h != staged_h) { __syncthreads(); r1_stage_lora_w(a0_, l, h, lds, td2); staged_h = h; }
            const int nx = item + (int)gridDim.x < BATCH * NH * 32 ? item + (int)gridDim.x : -1;
            rwkv_chunk_item(a0_.ws, a0_, l, item, inA, nx, inB, lds, wave, ln2, td2);
            inA = inB;
        }
    }
    asm volatile("s_waitcnt vmcnt(0)" ::: "memory"); __syncthreads();
    if (tid == 0) { __builtin_amdgcn_fence(__ATOMIC_RELEASE, "agent"); asm volatile("s_waitcnt vmcnt(0)" ::: "memory");
        for (int item = blockIdx.x; item < BATCH * NH * 32; item += gridDim.x) __hip_atomic_fetch_add(qw + QW_CNT + 64 * (item >> 5), 1u, __ATOMIC_RELAXED, __HIP_MEMORY_SCOPE_AGENT);
    }
    bool out_ready = false;
    for (int it = 0;; ++it) {
        if (tid == 0) qslot[it & 1] = __hip_atomic_fetch_add(qw + QW_HEAD, 1u, __ATOMIC_RELAXED, __HIP_MEMORY_SCOPE_AGENT);
        __syncthreads();
        const int u = (int)__builtin_amdgcn_readfirstlane(qslot[it & 1]);
        if (u >= QN_ALL) break;
        DArgs al = a0_;
        { _Pragma("unroll") for (int i_ = 0; i_ < 17; ++i_) asm volatile("" : "+s"(al.in[i_])); asm volatile("" : "+s"(al.out), "+s"(al.ws)); }
        int lane; asm volatile("v_mbcnt_lo_u32_b32 %0, -1, 0\n\tv_mbcnt_hi_u32_b32 %0, -1, %0" : "=v"(lane));
        if (u < QN_SCAN) {
            if (tid == 0) (void)q_wait_ge(qw + QW_CNT + 64 * u, 32u, tmo);
            __syncthreads();
            rwkv_scan(al.ws, (const gu8*)al.out, u, lds, wave, lane);
            asm volatile("s_waitcnt vmcnt(0)" ::: "memory"); __syncthreads();
            if (tid == 0) q_publish(qw + QW_SCANDONE, 1u);
        } else if (u < QN_SCAN + QN_ATT) {
            attn_dispatch(al.ws, l, u - QN_SCAN, lds, wave, lane);
            if (PROBE_DUP == 20 || (PROBE_DUP == 21 && ((u - QN_SCAN) >> 5 & 1) == 0) || (PROBE_DUP == 22 && ((u - QN_SCAN) >> 5 & 1) == 1)) { __syncthreads(); attn_dispatch(al.ws, l, u - QN_SCAN, lds, wave, lane); }
        } else if (u < QN_SCAN + QN_ATT + QN_CONV) {
            conv_item(al, l, u - QN_SCAN - QN_ATT, wave, lane);
        } else {
            if (!out_ready) { if (tid == 0) (void)q_wait_ge(qw + QW_SCANDONE, (unsigned)QN_SCAN, tmo); __syncthreads(); out_ready = true; }
            rwkv_out_item(al.ws, al, l, u - QN_SCAN - QN_ATT - QN_CONV, wave, lane);
        }
    }
}

__global__ void __launch_bounds__(NWAVES * 64, 2) hybrid_fwd(Args args) {
    extern __shared__ __attribute__((aligned(16))) unsigned char lds_raw[];
    LAS unsigned char* lds = (LAS unsigned char*)lds_raw;
    const int tid = threadIdx.x; const int wave = __builtin_amdgcn_readfirstlane(tid >> 6);
    volatile LAS unsigned* MISC = (volatile LAS unsigned*)(lds + MISC_OFF);
    for (int u = tid; u < (LDS_BYTES - LDSCTL_OFF) / 4; u += NWAVES * 64) ((LAS unsigned*)(lds + LDSCTL_OFF))[u] = 0u;
    __syncthreads();
    unsigned char* ws = args.ws;
    unsigned* ctl = (unsigned*)(ws + WS_CTL);
    const int lo = (N_LAUNCHES == 1) ? 0 : args.ph_lo, hi = (N_LAUNCHES == 1) ? N_PHASES : args.ph_hi;
    XcdBarrier bar; bar.bar = ctl + CW_BAR; bar.x = 0; bar.st = nullptr;
    if (hi - lo > 1) bar = xcd_barrier_post(ctl + CW_BAR, MISC + 8);
#define IN(k) (lo <= (k) && (k) < hi)
#define SEAM(k) do { if (IN(k) && IN((k) + 1)) { XcdBarrier b_ = bar; asm volatile("" : "+s"(b_.bar), "+s"(b_.x)); xcd_barrier(b_); } } while (0)

#define FRESH_ARGS() DArgs A; { _Pragma("unroll") for (int i_ = 0; i_ < 17; ++i_) { A.in[i_] = (const gf32*)args.in[i_]; asm volatile("" : "+s"(A.in[i_])); } A.out = (gf32*)args.out; A.ws = (gu8*)args.ws; asm volatile("" : "+s"(A.out), "+s"(A.ws)); } \
    int wv = wave; asm volatile("" : "+s"(wv)); int ln; asm volatile("v_mbcnt_lo_u32_b32 %0, -1, 0\n\tv_mbcnt_hi_u32_b32 %0, -1, %0" : "=v"(ln)); int td = wv * 64 + ln;
    if (IN(0)) { for (int rep = 0; rep < (PROBE_DUP == 7 ? 2 : 1); ++rep) { FRESH_ARGS(); phase_prologue(A, lds, wv, ln, td); } }
    SEAM(0);
    for (int l = 0; l < DEPTH; ++l) {
        const int pb = 1 + 3 * l;
        if (IN(pb)) {
            for (int rep = 0; rep < (PROBE_DUP == 6 ? 2 : 1); ++rep) {
            FRESH_ARGS(); unsigned char* w_ = (unsigned char*)A.ws;
            pg8::Gemm g{(const pg8::bf16_t*)(w_ + WS_XA), (const pg8::bf16_t*)(w_ + WS_WIN) + (size_t)l * NPAD * D, M, NPAD, D};
            pg8::StaticOrder S; S.init(M, NPAD, gridDim.x, (int)blockIdx.x);
            pg8::EpiWin E{(pg8::bf16_t*)(w_ + WS_PB), (const float*)(w_ + WS_CTL + CTL_SSQ) + (size_t)l * M, (const float*)(w_ + WS_TAB + TAB_THR), (float*)(w_ + WS_CTL + CTL_KM) + l * 64 * 256};
            pg8::gemm_phase<pg8::EpiWin, pg8::StaticOrder, PG8_ALIGN, PG8_SP2>(lds + RING_OFF, g, S, E, td);
            if (l == 0 && gridDim.x == 256 && W_LATER < DEPTH) {
                pg8::Unit u5; if (!S.next(4, u5)) convert_weights(A, W_LATER, DEPTH, ((int)blockIdx.x - 64) * NWAVES + wv, 192 * NWAVES, lds, wv, ln);
            }
            if (PROBE_DUP == 6) __syncthreads();
            if (PROBE_DUP == 12) { __syncthreads(); pg8::EpiNull EN; pg8::gemm_phase<pg8::EpiNull, pg8::StaticOrder, PG8_ALIGN, PG8_SP2>(lds + RING_OFF, g, S, EN, td); }
            }
        }
        SEAM(pb);
        if (IN(pb + 1)) { for (int rep = 0; rep < (PROBE_DUP == 10 ? 2 : 1); ++rep) { FRESH_ARGS(); mix_phase(A, l, l + 2 * rep, lds, wv, ln, td); } }
        SEAM(pb + 1);
        if (IN(pb + 2)) {
            FRESH_ARGS(); unsigned char* w_ = (unsigned char*)A.ws;
            pg8::Gemm g{(const pg8::bf16_t*)(w_ + WS_XB), (const pg8::bf16_t*)(w_ + WS_WOUT) + (size_t)l * D * D, M, D, D};
            pg8::StaticOrder S; S.init(M, D, gridDim.x, (int)blockIdx.x);
            if (l + 1 < DEPTH) {
                pg8::EpiWout E{(const pg8::bf16_t*)(w_ + WS_XA), (pg8::bf16_t*)(w_ + WS_XA), (float*)(w_ + WS_CTL + CTL_SSQ) + (size_t)(l + 1) * M};
                pg8::gemm_phase<pg8::EpiWout, pg8::StaticOrder, PG8_ALIGN, PG8_SP2>(lds + RING_OFF, g, S, E, td);
            } else {
                pg8::EpiWoutFinal E{(const pg8::bf16_t*)(w_ + WS_XA), (float*)A.out, (float*)(w_ + WS_SSQP), (unsigned*)(w_ + WS_CTL + CTL_Q) + 3 * QW_LAYER, (const float*)A.in[16], (unsigned*)(w_ + WS_CTL) + 8};
                pg8::gemm_phase<pg8::EpiWoutFinal, pg8::StaticOrder, false, PG8_SP2>(lds + RING_OFF, g, S, E, td);
            }
        }
        if (l + 1 < DEPTH) SEAM(pb + 2);
    }
#undef IN
#undef SEAM
}

extern "C" void kernel_launch(void* const* d_in, const int* in_sizes, int n_in, void* d_out, int out_size, void* d_ws, size_t ws_size, hipStream_t stream) {
    static int grid = 0;
    if (grid == 0) {
        if (n_in != 17 || in_sizes[0] != M * D || out_size != M * D || ws_size < WS_END) { fprintf(stderr, "kernel_launch: unexpected shapes (n_in %d, in0 %d, out %d, ws %zu); nothing launched\n", n_in, n_in > 0 ? in_sizes[0] : -1, out_size, ws_size); grid = -1; return; }
        int dev = 0, cus = 0, per_cu = 0;
        if (hipGetDevice(&dev) != hipSuccess || hipDeviceGetAttribute(&cus, hipDeviceAttributeMultiprocessorCount, dev) != hipSuccess) { grid = -1; return; }
        if (hipFuncSetAttribute((const void*)hybrid_fwd, hipFuncAttributeMaxDynamicSharedMemorySize, LDS_BYTES) != hipSuccess) { fprintf(stderr, "kernel_launch: hipFuncSetAttribute failed\n"); grid = -1; return; }
        if (hipOccupancyMaxActiveBlocksPerMultiprocessor(&per_cu, (const void*)hybrid_fwd, NWAVES * 64, LDS_BYTES) != hipSuccess || per_cu < 1)
            fprintf(stderr, "kernel_launch: note: occupancy query reports %d workgroups per CU\n", per_cu);
        (void)hipGetLastError();
        grid = cus;
    }
    if (grid < 0) return;
    if (hipMemsetAsync((char*)d_ws + WS_CTL, 0, CTL_ZERO_BYTES, stream) != hipSuccess) { fprintf(stderr, "kernel_launch: hipMemsetAsync failed\n"); return; }
    Args a{};
    for (int i = 0; i < 17; ++i) a.in[i] = (const float*)d_in[i];
    a.out = (float*)d_out; a.ws = (unsigned char*)d_ws;
    if (N_LAUNCHES == 1) {
        a.ph_lo = 0; a.ph_hi = N_PHASES; a.li = 0;
        hipLaunchKernelGGL(hybrid_fwd, dim3(grid), dim3(NWAVES * 64), LDS_BYTES, stream, a);
    } else {
        for (int p = 0; p < N_PHASES; ++p) { a.ph_lo = p; a.ph_hi = p + 1; a.li = p;
            hipLaunchKernelGGL(hybrid_fwd, dim3(grid), dim3(NWAVES * 64), LDS_BYTES, stream, a); }
    }
    const hipError_t le = hipPeekAtLastError();
    if (le != hipSuccess) fprintf(stderr, "kernel_launch: launch failed: %s\n", hipGetErrorName(le));
}
```

```cpp
#include <hip/hip_runtime.h>
#include <cstdio>
#include <cstdint>
namespace pg8 {
#define PG8_LAS __attribute__((address_space(3)))
typedef unsigned short bf16_t;
typedef short bf16x8 __attribute__((ext_vector_type(8)));
typedef float f32x4 __attribute__((ext_vector_type(4)));
typedef unsigned u32x4 __attribute__((ext_vector_type(4)));
constexpr int BM = 256, BK = 64, HALF = 128, HTB = HALF * BK * 2  , STAGE_BYTES = 8 * HTB, NXCD = 8, WGM = 8;

__host__ __device__ __forceinline__ int lds_byte(int r, int c) { const int st = (r >> 4) * 2 + (c >> 5), rr = r & 15, cc = c & 31, ob = rr * 64 + cc * 2; return st * 1024 + (ob ^ (((ob >> 9) & 1) << 5)); }
__host__ __device__ __forceinline__ void stage_rc(int b, int& R, int& C) { const int st = b / 1024, sb = b % 1024, swz = sb ^ (((sb >> 9) & 1) << 5); R = (st >> 1) * 16 + swz / 64; C = (st & 1) * 32 + (swz % 64) / 2; }
__host__ __device__ __forceinline__ int perm32(int rho) { const int n = rho >> 4, i = rho & 15; return 8 * (i >> 2) + 4 * n + (i & 3); }

struct Unit { int pm, pn; };
struct Gemm { const bf16_t* A; const bf16_t* Bt; int M, N, K; };

struct StaticOrder {
    int nM, nN, nwg, G, c;
    __host__ __device__ void init(int M, int N, int G_, int c_) { nM = M / BM; nN = N / BM; nwg = nM * nN; G = G_; c = c_; }
    __host__ __device__ bool next(int i, Unit& u) const {
        const long L = (long)i * G + c; if (L >= nwg) return false;
        int wgid = (int)L; { const int q = nwg / NXCD, r = nwg % NXCD, xcd = wgid % NXCD, off = wgid / NXCD; wgid = (xcd < r ? xcd * (q + 1) : r * (q + 1) + (xcd - r) * q) + off; }
        const int nig = WGM * nN, gid = wgid / nig, fm = gid * WGM, gsz = (nM - fm) < WGM ? (nM - fm) : WGM;
        u.pm = fm + ((wgid % nig) % gsz); u.pn = (wgid % nig) / gsz; return true;
    }
    __device__ __forceinline__ void a_ready(const Unit&) const {}
    __device__ __forceinline__ void done(const Unit&) const {}
};
typedef float f32x2_e __attribute__((ext_vector_type(2))); typedef __bf16 bf16x2_e __attribute__((ext_vector_type(2)));
__device__ __forceinline__ unsigned cvt_pk_bf16(float lo, float hi) { f32x2_e v = {lo, hi}; bf16x2_e b = __builtin_convertvector(v, bf16x2_e); return __builtin_bit_cast(unsigned, b); }

constexpr int EP_M = 16384;
#define PG8_GAS __attribute__((address_space(1)))
struct EpiWin {
    static constexpr bool PERM = true, AFTER_DRAIN = false;
    bf16_t* PB; const float* ssq; const float* thr; float* KM;
    __device__ __forceinline__ void operator()(const f32x4 (&acc)[2][2][4][2], const Unit& u, int wr, int wc, int fr, int fq) const {
        const int pn = u.pn;
        PG8_GAS bf16_t* PB_ = (PG8_GAS bf16_t*)PB; const PG8_GAS float* ssq_ = (const PG8_GAS float*)ssq; const PG8_GAS float* thr_ = (const PG8_GAS float*)thr; PG8_GAS float* KM_ = (PG8_GAS float*)KM;
        asm volatile("" : "+s"(PB_), "+s"(ssq_), "+s"(thr_), "+s"(KM_));
        const int rowb = u.pm * BM + wr * 64 + fr;
        const bool do_silu = (pn == 3 || pn == 7 || pn == 11 || pn == 15);
        const bool do_rot = (pn == 12 || pn == 13);
        const float scl = pn == 8 ? 0.125f * 1.4426950408889634f : (pn == 13 ? 0.125f : 1.0f);
        const bool do_km = (pn == 9);
        const bool lora = (pn == 16);
        PG8_GAS bf16_t* base = PB_ + (size_t)pn * ((size_t)EP_M * 256);
        const int ldc = lora ? 64 : 256;
        float rsv[2][4];
#pragma unroll
        for (int ai = 0; ai < 2; ++ai)
#pragma unroll
            for (int m = 0; m < 4; ++m) rsv[ai][m] = ssq_[rowb + ai * HALF + m * 16];
        f32x4 th[2] = {{0.f, 0.f, 0.f, 0.f}, {0.f, 0.f, 0.f, 0.f}};
        if (do_rot) {
#pragma unroll
            for (int bj = 0; bj < 2; ++bj) th[bj] = *(const PG8_GAS f32x4*)(thr_ + (((bj * HALF + wc * 32 + 8 * fq) & 63) >> 1));
        }
#pragma unroll
        for (int ai = 0; ai < 2; ++ai)
#pragma unroll
            for (int m = 0; m < 4; ++m) rsv[ai][m] = rsqrtf(rsv[ai][m] * (1.0f / 1024.0f) + 1e-6f);
        float cs[2][8];
#pragma unroll
        for (int bj = 0; bj < 2; ++bj)
#pragma unroll
            for (int j = 0; j < 8; ++j) cs[bj][j] = 0.f;
#pragma unroll
        for (int ai = 0; ai < 2; ++ai)
#pragma unroll
            for (int m = 0; m < 4; ++m) {
                const int row = rowb + ai * HALF + m * 16;
                const float rs = rsv[ai][m];
#pragma unroll
                for (int bj = 0; bj < 2; ++bj) {
                    const int c8 = bj * HALF + wc * 32 + 8 * fq;
                    float v[8];
#pragma unroll
                    for (int j = 0; j < 4; ++j) { v[j] = acc[ai][bj][m][0][j] * rs; v[4 + j] = acc[ai][bj][m][1][j] * rs; }
                    if (do_silu) {
#pragma unroll
                        for (int j = 0; j < 8; ++j) v[j] = v[j] * __builtin_amdgcn_rcpf(1.0f + __expf(-v[j]));
                    }
                    if (do_rot) {
                        const int pos = row & 2047; const float fpos = (float)pos;
#pragma unroll
                        for (int j = 0; j < 4; ++j) {
                            float rev = fpos * th[bj][j]; rev = rev - floorf(rev);
                            const float cj = __builtin_amdgcn_cosf(rev), sj = __builtin_amdgcn_sinf(rev);
                            const float a = v[2 * j], b = v[2 * j + 1]; v[2 * j] = a * cj - b * sj; v[2 * j + 1] = a * sj + b * cj; }
                        const float lgm = __log2f(1.0f - __builtin_amdgcn_exp2f(-5.0f - (float)(c8 >> 6))) * (float)(pos & 255);
                        const float fdec = __builtin_amdgcn_exp2f(pn == 12 ? lgm : -lgm);
#pragma unroll
                        for (int j = 0; j < 8; ++j) v[j] *= fdec;
                    }
#pragma unroll
                    for (int j = 0; j < 8; ++j) v[j] *= scl;
                    if (do_km) {
#pragma unroll
                        for (int j = 0; j < 8; ++j) cs[bj][j] += v[j];
                    }
                    u32x4 w; w.x = cvt_pk_bf16(v[0], v[1]); w.y = cvt_pk_bf16(v[2], v[3]); w.z = cvt_pk_bf16(v[4], v[5]); w.w = cvt_pk_bf16(v[6], v[7]);
                    if (!lora || c8 < 64) *(PG8_GAS u32x4*)(base + (size_t)row * ldc + c8) = w;
                }
            }
        if (do_km) {
#pragma unroll
            for (int bj = 0; bj < 2; ++bj)
#pragma unroll
                for (int j = 0; j < 8; ++j) {
                    float s = cs[bj][j];
                    s += __shfl_xor(s, 1); s += __shfl_xor(s, 2); s += __shfl_xor(s, 4); s += __shfl_xor(s, 8);
                    if (fr == 0) __hip_atomic_fetch_add(KM_ + u.pm * 256 + bj * HALF + wc * 32 + 8 * fq + j, s, __ATOMIC_RELAXED, __HIP_MEMORY_SCOPE_AGENT);
                }
        }
    }
};
struct EpiWout {
    static constexpr bool PERM = true, AFTER_DRAIN = false;
    const bf16_t* xin; bf16_t* xb; float* ssq_next;
    __device__ __forceinline__ void operator()(const f32x4 (&acc)[2][2][4][2], const Unit& u, int wr, int wc, int fr, int fq) const {
        const PG8_GAS bf16_t* xin_ = (const PG8_GAS bf16_t*)xin; PG8_GAS bf16_t* xb_ = (PG8_GAS bf16_t*)xb; PG8_GAS float* ssq_next_ = (PG8_GAS float*)ssq_next;
        asm volatile("" : "+s"(xin_), "+s"(xb_), "+s"(ssq_next_));
        const int rowb = u.pm * BM + wr * 64 + fr;
        u32x4 xv[2][4][2];
#pragma unroll
        for (int ai = 0; ai < 2; ++ai)
#pragma unroll
            for (int m = 0; m < 4; ++m)
#pragma unroll
                for (int bj = 0; bj < 2; ++bj) xv[ai][m][bj] = *(const PG8_GAS u32x4*)(xin_ + (size_t)(rowb + ai * HALF + m * 16) * 1024 + u.pn * BM + bj * HALF + wc * 32 + 8 * fq);
#pragma unroll
        for (int ai = 0; ai < 2; ++ai)
#pragma unroll
            for (int m = 0; m < 4; ++m) {
                const int row = rowb + ai * HALF + m * 16;
                float part = 0.f;
#pragma unroll
                for (int bj = 0; bj < 2; ++bj) {
                    const size_t off = (size_t)row * 1024 + u.pn * BM + bj * HALF + wc * 32 + 8 * fq;
                    const u32x4 xw = xv[ai][m][bj];
                    const f32x4 y0 = acc[ai][bj][m][0] + (f32x4){__uint_as_float(xw.x << 16), __uint_as_float(xw.x & 0xffff0000u), __uint_as_float(xw.y << 16), __uint_as_float(xw.y & 0xffff0000u)};
                    const f32x4 y1 = acc[ai][bj][m][1] + (f32x4){__uint_as_float(xw.z << 16), __uint_as_float(xw.z & 0xffff0000u), __uint_as_float(xw.w << 16), __uint_as_float(xw.w & 0xffff0000u)};
                    part += (y0[0] * y0[0] + y0[1] * y0[1]) + (y0[2] * y0[2] + y0[3] * y0[3]) + (y1[0] * y1[0] + y1[1] * y1[1]) + (y1[2] * y1[2] + y1[3] * y1[3]);
                    u32x4 w; w.x = cvt_pk_bf16(y0[0], y0[1]); w.y = cvt_pk_bf16(y0[2], y0[3]); w.z = cvt_pk_bf16(y1[0], y1[1]); w.w = cvt_pk_bf16(y1[2], y1[3]); *(PG8_GAS u32x4*)(xb_ + off) = w;
                }
                part += __shfl_xor(part, 16); part += __shfl_xor(part, 32);
                if (fq == 0) __hip_atomic_fetch_add(ssq_next_ + row, part, __ATOMIC_RELAXED, __HIP_MEMORY_SCOPE_AGENT);
            }
    }
};
struct EpiWoutFinal {
    static constexpr bool PERM = true, AFTER_DRAIN = true;
    const bf16_t* xin; float* out; float* part; unsigned* cnt; const float* fw; unsigned* tmo;
    __device__ __forceinline__ void fused(f32x4 (&acc)[2][2][4][2], const Unit& u, int wr, int wc, int fr, int fq, PG8_LAS unsigned char*, int wid, int lane) const {
        const PG8_GAS bf16_t* xin_ = (const PG8_GAS bf16_t*)xin; PG8_GAS float* out_ = (PG8_GAS float*)out; PG8_GAS float* part_ = (PG8_GAS float*)part; PG8_GAS unsigned* cnt_ = (PG8_GAS unsigned*)cnt;
        const PG8_GAS float* fw_ = (const PG8_GAS float*)fw; PG8_GAS unsigned* tmo_ = (PG8_GAS unsigned*)tmo;
        asm volatile("" : "+s"(xin_), "+s"(out_), "+s"(part_), "+s"(cnt_), "+s"(fw_), "+s"(tmo_));
        const int rowb = u.pm * BM + wr * 64 + fr;
#pragma unroll
        for (int ai = 0; ai < 2; ++ai) {
            u32x4 xv[4][2];
#pragma unroll
            for (int m = 0; m < 4; ++m)
#pragma unroll
                for (int bj = 0; bj < 2; ++bj) xv[m][bj] = *(const PG8_GAS u32x4*)(xin_ + (size_t)(rowb + ai * HALF + m * 16) * 1024 + u.pn * BM + bj * HALF + wc * 32 + 8 * fq);
#pragma unroll
            for (int m = 0; m < 4; ++m) {
                const int row = rowb + ai * HALF + m * 16; float ps = 0.f;
#pragma unroll
                for (int bj = 0; bj < 2; ++bj) {
                    const u32x4 xw = xv[m][bj];
                    acc[ai][bj][m][0] += (f32x4){__uint_as_float(xw.x << 16), __uint_as_float(xw.x & 0xffff0000u), __uint_as_float(xw.y << 16), __uint_as_float(xw.y & 0xffff0000u)};
                    acc[ai][bj][m][1] += (f32x4){__uint_as_float(xw.z << 16), __uint_as_float(xw.z & 0xffff0000u), __uint_as_float(xw.w << 16), __uint_as_float(xw.w & 0xffff0000u)};
                    const f32x4 y0 = acc[ai][bj][m][0], y1 = acc[ai][bj][m][1];
                    ps += (y0[0] * y0[0] + y0[1] * y0[1]) + (y0[2] * y0[2] + y0[3] * y0[3]) + (y1[0] * y1[0] + y1[1] * y1[1]) + (y1[2] * y1[2] + y1[3] * y1[3]);
                }
                ps += __shfl_xor(ps, 16); ps += __shfl_xor(ps, 32);
                if (fq == 0) __hip_atomic_store((PG8_GAS unsigned*)(part_ + (size_t)row * 16 + u.pn * 4 + wc), __float_as_uint(ps), __ATOMIC_RELAXED, __HIP_MEMORY_SCOPE_AGENT);
            }
        }
        asm volatile("s_waitcnt vmcnt(0)" ::: "memory");
        __syncthreads();
        if (wid == 0 && lane == 0) {
            __hip_atomic_fetch_add(cnt_ + 64 * u.pm, 1u, __ATOMIC_RELAXED, __HIP_MEMORY_SCOPE_AGENT);
            unsigned sp = 0;
            while (__hip_atomic_load(cnt_ + 64 * u.pm, __ATOMIC_RELAXED, __HIP_MEMORY_SCOPE_AGENT) < 4u) {
                __builtin_amdgcn_s_sleep(1);
                if ((++sp & 255u) == 0u) { if (__hip_atomic_load(tmo_, __ATOMIC_RELAXED, __HIP_MEMORY_SCOPE_AGENT) != 0u) break; if (sp > (1u << 20)) { __hip_atomic_store(tmo_, 1u, __ATOMIC_RELAXED, __HIP_MEMORY_SCOPE_AGENT); break; } }
            }
            __builtin_amdgcn_fence(__ATOMIC_ACQUIRE, "agent");
            asm volatile("s_waitcnt vmcnt(0)" ::: "memory");
        }
        __syncthreads();
        f32x4 wv[2][2];
#pragma unroll
        for (int bj = 0; bj < 2; ++bj) { const int col = u.pn * BM + bj * HALF + wc * 32 + 8 * fq; wv[bj][0] = *(const PG8_GAS f32x4*)(fw_ + col); wv[bj][1] = *(const PG8_GAS f32x4*)(fw_ + col + 4); }
#pragma unroll
        for (int ai = 0; ai < 2; ++ai)
#pragma unroll
            for (int m = 0; m < 4; ++m) {
                const int row = rowb + ai * HALF + m * 16;
                const PG8_GAS f32x4* sp4 = (const PG8_GAS f32x4*)(part_ + (size_t)row * 16); const f32x4 q0 = sp4[0], q1 = sp4[1], q2 = sp4[2], q3 = sp4[3];
                const float sq = ((q0[0] + q0[1]) + (q0[2] + q0[3])) + ((q1[0] + q1[1]) + (q1[2] + q1[3])) + ((q2[0] + q2[1]) + (q2[2] + q2[3])) + ((q3[0] + q3[1]) + (q3[2] + q3[3]));
                const float rs = rsqrtf(sq * (1.0f / 1024.0f) + 1e-6f);
#pragma unroll
                for (int bj = 0; bj < 2; ++bj) {
                    const size_t off = (size_t)row * 1024 + u.pn * BM + bj * HALF + wc * 32 + 8 * fq;
                    *(PG8_GAS f32x4*)(out_ + off) = acc[ai][bj][m][0] * rs * wv[bj][0]; *(PG8_GAS f32x4*)(out_ + off + 4) = acc[ai][bj][m][1] * rs * wv[bj][1];
                }
            }
    }
};
struct EpiNull {
    static constexpr bool PERM = true, AFTER_DRAIN = false;
    __device__ __forceinline__ void operator()(const f32x4 (&acc)[2][2][4][2], const Unit&, int, int, int, int) const {
#pragma unroll
        for (int ai = 0; ai < 2; ++ai)
#pragma unroll
            for (int bj = 0; bj < 2; ++bj)
#pragma unroll
                for (int m = 0; m < 4; ++m)
#pragma unroll
                    for (int n = 0; n < 2; ++n) asm volatile("" :: "v"(acc[ai][bj][m][n]));
    }
};
template <class Epi, class Sched, bool ALIGN_EPI = false, bool SP2 = false>
__device__ __forceinline__ void gemm_phase(PG8_LAS unsigned char* lds, const Gemm g, const Sched& S, const Epi& E, int tid_in) {
    int tid_ = tid_in; asm volatile("" : "+v"(tid_));
    const int tid = tid_, wid = __builtin_amdgcn_readfirstlane(tid >> 6), lane = tid & 63, wr = wid >> 2, wc = wid & 3, fr = lane & 15, fq = lane >> 4;
    const int K = g.K, nt = K / BK;
    unsigned voffA[2], voffB[2];
#pragma unroll
    for (int i = 0; i < 2; ++i) { int R, C; stage_rc(tid * 16 + i * 8192, R, C); const int Rb = Epi::PERM ? ((R & ~31) + perm32(R & 31)) : R;
        voffA[i] = (unsigned)(R * K + C) * 2u; voffB[i] = (unsigned)(Rb * K + C) * 2u; }
    const size_t kstep = (size_t)(BK * 2);
    const size_t hstep = (size_t)HALF * K * 2;
    const size_t tstep = 2 * hstep;
    const unsigned ldsw = (unsigned)wid * 1024u;
    const int aoff = lds_byte(wr * 64 + fr, fq * 8), boff = lds_byte(wc * 32 + fr, fq * 8);
#define PG8_SA(b, h) (((b) * 2 + (h)) * HTB)
#define PG8_SB(b, h) ((4 + (b) * 2 + (h)) * HTB)
#define PG8_STAGE(bufoff, gbase, voff) do { _Pragma("unroll") for (int _i = 0; _i < 2; ++_i) \
        __builtin_amdgcn_global_load_lds((const unsigned*)((const char*)(gbase) + (voff)[_i]), (PG8_LAS unsigned*)(lds + (bufoff) + ldsw + _i * 8192), 16, 0, 0); } while (0)
#define PG8_LDA(dst, b, h) do { _Pragma("unroll") for (int m = 0; m < 4; ++m) _Pragma("unroll") for (int k = 0; k < 2; ++k) dst[m][k] = *(const PG8_LAS bf16x8*)(lds + PG8_SA(b, h) + aoff + m * 2048 + k * 1024); } while (0)
#define PG8_LDB(dst, b, h) do { _Pragma("unroll") for (int n = 0; n < 2; ++n) _Pragma("unroll") for (int k = 0; k < 2; ++k) dst[n][k] = *(const PG8_LAS bf16x8*)(lds + PG8_SB(b, h) + boff + n * 2048 + k * 1024); } while (0)
#define PG8_MMA(ai, bj, At, Bt) do { __builtin_amdgcn_s_setprio(1); _Pragma("unroll") for (int m = 0; m < 4; ++m) _Pragma("unroll") for (int n = 0; n < 2; ++n) _Pragma("unroll") for (int k = 0; k < 2; ++k) \
        acc[ai][bj][m][n] = __builtin_amdgcn_mfma_f32_16x16x32_bf16(Bt[n][k], At[m][k], acc[ai][bj][m][n], 0, 0, 0); __builtin_amdgcn_s_setprio(0); } while (0)
#define PG8_WAIT_V(n) asm volatile("s_waitcnt vmcnt(" #n ")" ::: "memory")
#define PG8_WAIT_L(n) asm volatile("s_waitcnt lgkmcnt(" #n ")" ::: "memory")
#define PG8_BAR __builtin_amdgcn_s_barrier()
#define PG8_SCHED __builtin_amdgcn_sched_barrier(0)
    Unit cur, nxt; int ui = 0;
    if (!S.next(0, cur)) return;
    f32x4 acc[2][2][4][2];
#pragma unroll
    for (int a = 0; a < 2; ++a)
#pragma unroll
        for (int b = 0; b < 2; ++b)
#pragma unroll
            for (int m = 0; m < 4; ++m)
#pragma unroll
                for (int n = 0; n < 2; ++n) acc[a][b][m][n] = (f32x4){0.f, 0.f, 0.f, 0.f};
    bf16x8 At[4][2], B0[2][2], B1[2][2];
    const char* cA = (const char*)g.A + (size_t)cur.pm * tstep; const char* cB = (const char*)g.Bt + (size_t)cur.pn * tstep;
    S.a_ready(cur);
    if constexpr (SP2) {
        PG8_STAGE(PG8_SB(0, 0), cB, voffB); PG8_STAGE(PG8_SB(0, 1), cB + hstep, voffB); PG8_STAGE(PG8_SA(0, 0), cA, voffA); PG8_STAGE(PG8_SA(0, 1), cA + hstep, voffA);
        if (wr == 1) PG8_BAR;
        PG8_WAIT_V(2); PG8_BAR;
        PG8_STAGE(PG8_SB(1, 0), cB + kstep, voffB); PG8_STAGE(PG8_SA(1, 0), cA + kstep, voffA); PG8_STAGE(PG8_SB(1, 1), cB + hstep + kstep, voffB);
        PG8_WAIT_V(6); PG8_BAR;
    } else {
        PG8_STAGE(PG8_SB(0, 0), cB, voffB); PG8_STAGE(PG8_SA(0, 0), cA, voffA); PG8_STAGE(PG8_SB(0, 1), cB + hstep, voffB); PG8_STAGE(PG8_SA(0, 1), cA + hstep, voffA);
        if (wr == 1) PG8_BAR;
        PG8_WAIT_V(4); PG8_BAR;
        PG8_STAGE(PG8_SB(1, 0), cB + kstep, voffB); PG8_STAGE(PG8_SA(1, 0), cA + kstep, voffA); PG8_STAGE(PG8_SB(1, 1), cB + hstep + kstep, voffB);
        PG8_WAIT_V(6); PG8_BAR;
    }
    for (;;) {
        const bool has_next = S.next(ui + 1, nxt);
        const char* nA = has_next ? (const char*)g.A + (size_t)nxt.pm * tstep : cA; const char* nB = has_next ? (const char*)g.Bt + (size_t)nxt.pn * tstep : cB;
        for (int t = 0; t < nt; t += 2) {
            const bool last = (t == nt - 2);
            const char* a1 = cA + (size_t)(t + 1) * kstep;
            const char* a2 = last ? nA : cA + (size_t)(t + 2) * kstep; const char* b2 = last ? nB : cB + (size_t)(t + 2) * kstep;
            const char* a3 = a2 + kstep; const char* b3 = b2 + kstep;
            if (last && has_next) S.a_ready(nxt);
            if constexpr (SP2) {
            PG8_LDB(B0, 0, 0); PG8_LDB(B1, 0, 1); PG8_SCHED; PG8_LDA(At, 0, 0); PG8_STAGE(PG8_SA(1, 1), a1 + hstep, voffA);
            PG8_WAIT_V(8); PG8_WAIT_L(0); PG8_BAR; PG8_MMA(0, 0, At, B0); PG8_MMA(0, 1, At, B1); PG8_BAR; PG8_SCHED;
            PG8_LDA(At, 0, 1); PG8_STAGE(PG8_SB(0, 0), b2, voffB); PG8_STAGE(PG8_SB(0, 1), b2 + hstep, voffB); PG8_STAGE(PG8_SA(0, 0), a2, voffA);
            PG8_WAIT_V(8); PG8_WAIT_L(0); PG8_BAR; PG8_MMA(1, 0, At, B0); PG8_MMA(1, 1, At, B1); PG8_BAR; PG8_SCHED;
            PG8_LDB(B0, 1, 0); PG8_LDB(B1, 1, 1); PG8_SCHED; PG8_LDA(At, 1, 0); PG8_STAGE(PG8_SA(0, 1), a2 + hstep, voffA);
            PG8_WAIT_V(8); PG8_WAIT_L(0); PG8_BAR; PG8_MMA(0, 0, At, B0); PG8_MMA(0, 1, At, B1); PG8_BAR; PG8_SCHED;
            PG8_LDA(At, 1, 1); PG8_STAGE(PG8_SB(1, 0), b3, voffB); PG8_STAGE(PG8_SB(1, 1), b3 + hstep, voffB); PG8_STAGE(PG8_SA(1, 0), a3, voffA);
            PG8_WAIT_V(8); PG8_WAIT_L(0); PG8_BAR; PG8_MMA(1, 0, At, B0); PG8_MMA(1, 1, At, B1); PG8_BAR; PG8_SCHED;
            } else {
            PG8_LDB(B0, 0, 0); PG8_SCHED; PG8_LDA(At, 0, 0); PG8_STAGE(PG8_SA(1, 1), a1 + hstep, voffA);
            PG8_WAIT_L(8); PG8_BAR; PG8_WAIT_L(0); PG8_MMA(0, 0, At, B0); PG8_BAR; PG8_SCHED;
            PG8_LDB(B1, 0, 1); PG8_STAGE(PG8_SB(0, 0), b2, voffB);
            PG8_BAR; PG8_WAIT_L(0); PG8_MMA(0, 1, At, B1); PG8_BAR;
            PG8_LDA(At, 0, 1); PG8_STAGE(PG8_SA(0, 0), a2, voffA);
            PG8_BAR; PG8_WAIT_L(0); PG8_MMA(1, 0, At, B0); PG8_BAR; PG8_SCHED;
            PG8_STAGE(PG8_SB(0, 1), b2 + hstep, voffB);
            PG8_WAIT_V(6); PG8_BAR; PG8_MMA(1, 1, At, B1); PG8_BAR;
            PG8_LDB(B0, 1, 0); PG8_SCHED; PG8_LDA(At, 1, 0); PG8_STAGE(PG8_SA(0, 1), a2 + hstep, voffA);
            PG8_WAIT_L(8); PG8_BAR; PG8_WAIT_L(0); PG8_MMA(0, 0, At, B0); PG8_BAR; PG8_SCHED;
            PG8_LDB(B1, 1, 1); PG8_STAGE(PG8_SB(1, 0), b3, voffB);
            PG8_BAR; PG8_WAIT_L(0); PG8_MMA(0, 1, At, B1); PG8_BAR;
            PG8_LDA(At, 1, 1); PG8_STAGE(PG8_SA(1, 0), a3, voffA);
            PG8_BAR; PG8_WAIT_L(0); PG8_MMA(1, 0, At, B0); PG8_BAR; PG8_SCHED;
            PG8_STAGE(PG8_SB(1, 1), b3 + hstep, voffB);
            PG8_WAIT_V(6); PG8_BAR; PG8_MMA(1, 1, At, B1); PG8_BAR;
            }
        }
        if constexpr (ALIGN_EPI) { if (wr == 0) PG8_BAR; }
        if constexpr (!Epi::AFTER_DRAIN) { E(acc, cur, wr, wc, fr, fq); S.done(cur); }
        if (!has_next) break;
#pragma unroll
        for (int a = 0; a < 2; ++a)
#pragma unroll
            for (int b = 0; b < 2; ++b)
#pragma unroll
                for (int m = 0; m < 4; ++m)
#pragma unroll
                    for (int n = 0; n < 2; ++n) acc[a][b][m][n] = (f32x4){0.f, 0.f, 0.f, 0.f};
        cur = nxt; cA = nA; cB = nB; ++ui;
        if constexpr (ALIGN_EPI) { if (wr == 1) PG8_BAR; }
    }
    PG8_WAIT_V(0);
    if constexpr (!ALIGN_EPI) { if (wr == 0) PG8_BAR; }
    PG8_BAR;
    if constexpr (Epi::AFTER_DRAIN) { E.fused(acc, cur, wr, wc, fr, fq, lds, wid, lane); S.done(cur); }
#undef PG8_SA
#undef PG8_SB
#undef PG8_STAGE
#undef PG8_LDA
#undef PG8_LDB
#undef PG8_MMA
#undef PG8_WAIT_V
#undef PG8_WAIT_L
#undef PG8_BAR
#undef PG8_SCHED
}
}
#ifndef PG8_SP2
#define PG8_SP2 true
#endif
#ifndef PG8_ALIGN
#define PG8_ALIGN true
#endif
#ifndef PROBE_DUP
#define PROBE_DUP 0
#endif
#ifndef ATT_STAGGER
#define ATT_STAGGER 2
#endif
#ifndef PROBE_R1
#define PROBE_R1 0
#endif
#ifndef PROBE_ATT
#define PROBE_ATT 0
#endif
#ifndef MK_N_LAUNCHES
#define MK_N_LAUNCHES 1
#endif

constexpr int NWAVES = 8;
constexpr int BATCH = 8, T = 2048, D = 1024, M = BATCH * T, DEPTH = 2;
constexpr int GW = 256, NH = 4, HD = 64, LORA = 32;
constexpr int WCOLS = 4160, NPAD = 4352, NMAIN = 4096;
constexpr int N_PHASES = 7;
constexpr int N_LAUNCHES = MK_N_LAUNCHES;

constexpr size_t MiB = 1u << 20;
constexpr size_t WS_CTL = 0, CTL_ZERO_BYTES = 1 * MiB;
constexpr size_t CTL_KM = 131072;
constexpr size_t CTL_SSQ = 262144;
constexpr size_t CTL_Q = 65536;
constexpr size_t WS_TAB = 1 * MiB;
constexpr size_t TAB_SIN = 262144, TAB_LUT = 524288, TAB_THR = 528384, TAB_LUT2 = 532480;
constexpr size_t WS_WIN = 2 * MiB;
constexpr size_t WS_WOUT = 19 * MiB;
constexpr size_t WS_XA = 23 * MiB;
constexpr size_t WS_XB = 55 * MiB;
constexpr size_t WS_PB = 87 * MiB;
constexpr size_t WS_R1 = 217 * MiB;
constexpr size_t WS_YRAW = 233 * MiB;
constexpr size_t WS_SB = 249 * MiB;
constexpr size_t WS_SSQP = 250 * MiB;
constexpr size_t WS_END = 253 * MiB;
constexpr size_t PANEL = (size_t)M * 256;
constexpr int CW_BAR = 4096;

constexpr int RING_OFF = 0, RING_BYTES = 131072;
constexpr int LDSCTL_OFF = RING_BYTES, MISC_OFF = LDSCTL_OFF + 320;
constexpr int LDS_BYTES = 147456;

#define GAS __attribute__((address_space(1)))
#define LAS __attribute__((address_space(3)))
typedef unsigned short bf16;
typedef unsigned v4u __attribute__((ext_vector_type(4)));
typedef unsigned v2u __attribute__((ext_vector_type(2)));
typedef float f32x4 __attribute__((ext_vector_type(4)));
typedef GAS unsigned gu32;
#define RLX_AGENT __ATOMIC_RELAXED, __HIP_MEMORY_SCOPE_AGENT
#define LDS_WAIT() asm volatile("s_waitcnt lgkmcnt(0)" ::: "memory")
__device__ __forceinline__ float bf2f(unsigned b) { return __uint_as_float(b << 16); }
__device__ __forceinline__ unsigned f2bf(float f) { unsigned u = __float_as_uint(f); return (u + 0x7fffu + ((u >> 16) & 1u)) >> 16; }
__device__ __forceinline__ unsigned pk2(float lo, float hi) { return f2bf(lo) | (f2bf(hi) << 16); }
__device__ __forceinline__ float sigmoidf_(float x) { return __builtin_amdgcn_rcpf(1.0f + __expf(-x)); }
__device__ __forceinline__ float wave_sum(float v) {
#pragma unroll
    for (int o = 1; o < 64; o <<= 1) v += __shfl_xor(v, o);
    return v;
}
__device__ __forceinline__ void unpack8(const v4u w, float* f) {
    f[0] = bf2f(w.x & 0xffffu); f[1] = bf2f(w.x >> 16); f[2] = bf2f(w.y & 0xffffu); f[3] = bf2f(w.y >> 16);
    f[4] = bf2f(w.z & 0xffffu); f[5] = bf2f(w.z >> 16); f[6] = bf2f(w.w & 0xffffu); f[7] = bf2f(w.w >> 16);
}

__constant__ double THETA_D[32] = {1.0, 0.7429639507594948, 0.551995432128157, 0.4101127070551301, 0.30469895709035083, 0.22638034095214485, 0.168192432488087, 0.12496091412919871,
    0.09284145445194746, 0.06897785379387658, 0.05124805876960934, 0.03807546021222372, 0.028288694346259694, 0.021017480113324893, 0.015615230060004972, 0.011601553017399716,
    0.008619535664753031, 0.006404004271197283, 0.004757944314009414, 0.0035349811050301057, 0.0026263635276533325, 0.0019512934226359642, 0.0014497406703726315, 0.001077105056036769,
    0.0008002502278161054, 0.0005945570708544394, 0.0004417344703140073, 0.0003281927872511474, 0.00024383540982688293, 0.00018116091942004152, 0.00013459603241553644, 0.0001};


typedef GAS bf16 gbf; typedef GAS float gf32; typedef GAS unsigned char gu8; typedef GAS v4u gv4u; typedef GAS v2u gv2u; typedef GAS f32x4 gf32x4;
struct Args { const float* in[17]; float* out; unsigned char* ws; int ph_lo, ph_hi, li, pad; };
struct DArgs { const gf32* in[17]; gf32* out; gu8* ws; };
#define XB_TMO      128
#define XB_XCNT(j)  (256  + 64 * (j))
#define XB_XSUB(j)  (1280 + 64 * (j))
#define XB_XGEN(j)  (2304 + 64 * (j))
#define XB_TOP      3328
#define XB_TOPGEN   3392
#define XCD_BAR_WORDS 3456
#define XB_SPIN_CAP (1u << 18)

__device__ __forceinline__ unsigned xb_ld(unsigned* p)              { return __hip_atomic_load(p, __ATOMIC_RELAXED, __HIP_MEMORY_SCOPE_AGENT); }
__device__ __forceinline__ unsigned xb_add(unsigned* p, unsigned v) { return __hip_atomic_fetch_add(p, v, __ATOMIC_RELAXED, __HIP_MEMORY_SCOPE_AGENT); }
__device__ __forceinline__ unsigned xb_xcc_id() { return (unsigned)__builtin_amdgcn_s_getreg((3 << 11) | 20) & 0xFu; }
#define XB_SPIN(cond, bar) do { unsigned _sp = 0; while (cond) { __builtin_amdgcn_s_sleep(1); \
    if ((++_sp & 255u) == 0u) { if (xb_ld(&(bar)[XB_TMO])) break; if (_sp > XB_SPIN_CAP) { atomicAdd(&(bar)[XB_TMO], 1u); break; } } } } while (0)

struct XcdBarrier {
    unsigned* bar; unsigned x;
    volatile LAS unsigned* st;
};

__device__ __forceinline__ XcdBarrier xcd_barrier_post(unsigned* bar, volatile LAS unsigned* st) {
    XcdBarrier b; b.bar = bar; b.x = xb_xcc_id(); b.st = st;
    if (threadIdx.x == 0) (void)xb_add(&bar[XB_XCNT(b.x)], 1u);
    return b;
}
__device__ __forceinline__ void xcd_barrier_complete(unsigned* bar, unsigned x, unsigned& nloc, unsigned& nx) {
    const unsigned G = gridDim.x * gridDim.y * gridDim.z;
    unsigned sum, cnt, mine, sp = 0u;
    for (;;) {
        sum = 0u; cnt = 0u; mine = 0u;
#pragma unroll
        for (unsigned j = 0; j < 16; ++j) { const unsigned c = xb_ld(&bar[XB_XCNT(j)]); sum += c; cnt += (c > 0u) ? 1u : 0u; mine = (j == x) ? c : mine; }
        if (sum == G) break;
        __builtin_amdgcn_s_sleep(1);
        if ((++sp & 255u) == 0u) { if (xb_ld(&bar[XB_TMO])) break; if (sp > XB_SPIN_CAP) { atomicAdd(&bar[XB_TMO], 1u); break; } }
    }
    nloc = mine > 0u ? mine : 1u; nx = cnt > 0u ? cnt : 1u;
}

__device__ __forceinline__ void xcd_barrier(const XcdBarrier& b) {
    asm volatile("s_waitcnt vmcnt(0)" ::: "memory");
    __syncthreads();
    if (threadIdx.x == 0) {
        unsigned* bar = b.bar;
        __builtin_amdgcn_s_waitcnt(0);
        unsigned nloc = b.st[0], nx = b.st[1];
        if (nloc == 0u) { xcd_barrier_complete(bar, b.x, nloc, nx); b.st[0] = nloc; b.st[1] = nx; }
        const unsigned old = xb_add(&bar[XB_XSUB(b.x)], 1u);
        const unsigned gen = old / nloc;
        if (old + 1u == (gen + 1u) * nloc) {
            __builtin_amdgcn_fence(__ATOMIC_RELEASE, "agent");
            asm volatile("s_waitcnt vmcnt(0)" ::: "memory");
            const unsigned og = xb_add(&bar[XB_TOP], 1u);
            const unsigned tg = og / nx;
            if (og + 1u == (tg + 1u) * nx) xb_add(&bar[XB_TOPGEN], 1u);
            else XB_SPIN(xb_ld(&bar[XB_TOPGEN]) == tg, bar);
            __builtin_amdgcn_fence(__ATOMIC_ACQUIRE, "agent");
            xb_add(&bar[XB_XGEN(b.x)], 1u);
            asm volatile("s_waitcnt vmcnt(0)" ::: "memory");
        } else {
            XB_SPIN(xb_ld(&bar[XB_XGEN(b.x)]) == gen, bar);
            __builtin_amdgcn_fence(__ATOMIC_ACQUIRE, "agent");
            asm volatile("s_waitcnt vmcnt(0)" ::: "memory");
        }
    }
    __syncthreads();
}
typedef short bf16x8 __attribute__((ext_vector_type(8)));
typedef short s16x4 __attribute__((ext_vector_type(4)));
typedef short v4i16_t __attribute__((ext_vector_type(4)));
typedef float f32x16 __attribute__((ext_vector_type(16)));
typedef GAS bf16x8 gbf16x8;
constexpr int AT_NS = 4;
constexpr int AT_K = 0, AT_V = AT_NS * 8192, AT_LUT = 2 * AT_NS * 8192, AT_SEL = AT_LUT + 512, AT_BYTES = AT_SEL + 2048;
constexpr float LOG2E = 1.4426950408889634f;

__device__ __forceinline__ void glds16(const GAS void* gsrc, unsigned lds_dst) { unsigned keep;
    asm volatile("s_mov_b32 %0, m0\n\ts_mov_b32 m0, %2\n\ts_nop 0\n\tglobal_load_lds_dwordx4 %1, off\n\ts_mov_b32 m0, %0" : "=&s"(keep) : "v"(gsrc), "s"(lds_dst) : "memory"); }
#define AT_WAIT_BAR() asm volatile("s_waitcnt vmcnt(0) lgkmcnt(0)\n\ts_barrier" ::: "memory")
#define AT_WAIT_BAR_N(N) asm volatile("s_waitcnt vmcnt(" #N ") lgkmcnt(0)\n\ts_barrier" ::: "memory")
__device__ __forceinline__ s16x4 vtr(const LAS unsigned char* p) { return __builtin_bit_cast(s16x4, __builtin_amdgcn_ds_read_tr16_b64_v4i16((LAS v4i16_t*)p)); }
typedef float f32x2_t __attribute__((ext_vector_type(2))); typedef __bf16 bf16x2_t __attribute__((ext_vector_type(2)));
__device__ __forceinline__ unsigned cvtpk(float lo, float hi) { f32x2_t v = {lo, hi}; bf16x2_t b = __builtin_convertvector(v, bf16x2_t); return __builtin_bit_cast(unsigned, b); }
__device__ __forceinline__ float ex2(float x) { return __builtin_amdgcn_exp2f(x); }

constexpr float AT_THR = 6.0f;
template <int MODE, int PROBE = 0>
__device__ __forceinline__ void attn_unit(const gbf* Pq, const gbf* Pk, const gbf* Pv, const gbf* Pg, gbf* Y, int ycol, int b, int h, int qb,
                                          const gf32* KMl, const gf32* lut, LAS unsigned char* lds, int wave, int lane) {
    const int r32 = lane & 31, h2 = lane >> 5;
    const int q_abs = qb * 256 + wave * 32 + r32; const size_t qrow = (size_t)(b * T + q_abs);
    const unsigned lds0 = (unsigned)(uintptr_t)lds;
    const int NT = 4 * (qb + 1);
    const gbf* ksrc = Pk + (size_t)(b * T + lane) * 256 + h * 64 + wave * 8;
    const gbf* vsrc = Pv + (size_t)(b * T + 16 * (wave & 3) + (lane >> 2)) * 256 + h * 64 + (wave >> 2) * 32 + (lane & 3) * 8;
#define AT_DMA(t, buf) do { glds16(ksrc + (size_t)(t) * 64 * 256, (unsigned)__builtin_amdgcn_readfirstlane(lds0 + AT_K + (buf) * 8192 + wave * 1024)); \
                            glds16(vsrc + (size_t)(t) * 64 * 256, (unsigned)__builtin_amdgcn_readfirstlane(lds0 + AT_V + (buf) * 8192 + wave * 1024)); } while (0)
    if (PROBE != 2 && PROBE != 3) { AT_DMA(0, 0); AT_DMA(1, 1); AT_DMA(2, 2); }
    bf16x8 qf[4];
#pragma unroll
    for (int ks = 0; ks < 4; ++ks) qf[ks] = *(const gbf16x8*)(Pq + qrow * 256 + h * 64 + 16 * ks + 8 * h2);
    LAS float* lutL = (LAS float*)(lds + AT_LUT);
    unsigned sel = 0u;
    if (MODE == 0) {
        if (wave == 0) { const float c31 = lut[h * 128 + 127]; lutL[lane] = (lut[h * 128 + lane] - c31) * LOG2E; lutL[64 + lane] = (lut[h * 128 + 64 + lane] - c31) * LOG2E; }
        if (qb <= 3) sel = (1u << qb) - 1u;
        else {
            f32x16 gacc;
#pragma unroll
            for (int r = 0; r < 16; ++r) gacc[r] = 0.f;
            const gf32* km = KMl + (b * 8 + (r32 & 7)) * 256 + h * 64 + 8 * h2;
#pragma unroll
            for (int ks = 0; ks < 4; ++ks) {
                const f32x4 ka = *(const gf32x4*)(km + 16 * ks), kb = *(const gf32x4*)(km + 16 * ks + 4);
                v4u w; w.x = cvtpk(ka[0], ka[1]); w.y = cvtpk(ka[2], ka[3]); w.z = cvtpk(kb[0], kb[1]); w.w = cvtpk(kb[2], kb[3]);
                gacc = __builtin_amdgcn_mfma_f32_32x32x16_bf16(__builtin_bit_cast(bf16x8, w), qf[ks], gacc, 0, 0, 0);
            }
            float gv[8];
#pragma unroll
            for (int e = 0; e < 4; ++e) { const float mine = gacc[e], other = __shfl_xor(mine, 32); gv[e] = h2 ? other : mine; gv[4 + e] = h2 ? mine : other; }
            float g0 = -INFINITY, g1 = -INFINITY, g2 = -INFINITY; int i0 = 0, i1 = 0, i2 = 0;
#pragma unroll
            for (int n = 0; n < 8; ++n) {
                const float g = (n < qb) ? gv[n] : -INFINITY;
                if (g > g0) { g2 = g1; i2 = i1; g1 = g0; i1 = i0; g0 = g; i0 = n; }
                else if (g > g1) { g2 = g1; i2 = i1; g1 = g; i1 = n; }
                else if (g > g2) { g2 = g; i2 = n; }
            }
            sel = (1u << i0) | (1u << i1) | (1u << i2);
        }
    }
    const float g64 = (MODE == 1) ? ex2(64.0f * log2f(1.0f - ex2(-5.0f - (float)h))) : 1.0f;
    AT_WAIT_BAR_N(4);
    float m_run = 0.f, l_run = 0.f; f32x16 o0, o1, cinit;
#pragma unroll
    for (int r = 0; r < 16; ++r) { o0[r] = 0.f; o1[r] = 0.f; cinit[r] = 0.f; }
    for (int t = 0; t < NT; ++t) {
        const int cur = t & (AT_NS - 1);
        if (PROBE != 2 && PROBE != 3 && t + 3 < NT) AT_DMA(t + 3, (t + 3) & (AT_NS - 1));
        const int nb = t >> 2; const bool own = (nb == qb);
        const bool active = !own || ((t & 3) * 64 <= wave * 32 + 31);
        if (active && PROBE != 1) {
            if (MODE == 0 && (t & 3) == 0) {
                const float cv = (own || ((sel >> nb) & 1u)) ? -m_run : -1e30f;
#pragma unroll
                for (int r = 0; r < 16; ++r) cinit[r] = cv;
            }
            f32x16 s0 = cinit, s1 = cinit;
            const LAS unsigned char* kb = lds + AT_K + cur * 8192 + h2 * 1024 + r32 * 16;
#pragma unroll
            for (int ks = 0; ks < 4; ++ks) {
                const bf16x8 a0 = *(const LAS bf16x8*)(kb + ks * 2048), a1 = *(const LAS bf16x8*)(kb + ks * 2048 + 512);
                s0 = __builtin_amdgcn_mfma_f32_32x32x16_bf16(a0, qf[ks], s0, 0, 0, 0);
                s1 = __builtin_amdgcn_mfma_f32_32x32x16_bf16(a1, qf[ks], s1, 0, 0, 0);
            }
            const int dq = q_abs - (t * 64 + 4 * h2);
            if (PROBE == 3) {   } else if (MODE == 0) {
                const bool near = own || (qb * 256 + wave * 32 - (t * 64 + 63) < 113);
                if (near) {
#pragma unroll
                    for (int r = 0; r < 16; ++r) {
                        const int d0 = dq - ((r & 3) + 8 * (r >> 2)), d1 = d0 - 32;
                        const float b0 = lutL[min(max(d0, 0), 127)], b1 = lutL[min(max(d1, 0), 127)];
                        s0[r] = d0 >= 0 ? s0[r] + b0 : -1e30f;
                        s1[r] = d1 >= 0 ? s1[r] + b1 : -1e30f;
                    }
                }
                float mx = fmaxf(fmaxf(s0[0], s0[1]), fmaxf(s1[0], s1[1]));
#pragma unroll
                for (int r = 2; r < 16; r += 2) mx = fmaxf(mx, fmaxf(fmaxf(s0[r], s0[r + 1]), fmaxf(s1[r], s1[r + 1])));
                mx = fmaxf(mx, __shfl_xor(mx, 32));
                if (__any(mx > AT_THR)) {
                    const float dl = fmaxf(mx, 0.f), alpha = ex2(-dl); m_run += dl; l_run *= alpha;
#pragma unroll
                    for (int r = 0; r < 16; ++r) { s0[r] -= dl; s1[r] -= dl; o0[r] *= alpha; o1[r] *= alpha; cinit[r] -= dl; }
                }
                float ps = 0.f;
#pragma unroll
                for (int r = 0; r < 16; ++r) { s0[r] = ex2(s0[r]); s1[r] = ex2(s1[r]); ps += s0[r] + s1[r]; }
                l_run += ps;
            } else {
                if (t == qb * 4 + (wave >> 1)) {
#pragma unroll
                    for (int r = 0; r < 16; ++r) {
                        const int d0 = dq - ((r & 3) + 8 * (r >> 2)), d1 = d0 - 32;
                        s0[r] = d0 >= 0 ? s0[r] : 0.f; s1[r] = d1 >= 0 ? s1[r] : 0.f;
                    }
                }
#pragma unroll
                for (int r = 0; r < 16; ++r) { o0[r] *= g64; o1[r] *= g64; }
            }
            bf16x8 pf[4];
#pragma unroll
            for (int s = 0; s < 2; ++s) {
                v4u w0, w1;
                w0.x = cvtpk(s0[8 * s + 0], s0[8 * s + 1]); w0.y = cvtpk(s0[8 * s + 2], s0[8 * s + 3]); w0.z = cvtpk(s0[8 * s + 4], s0[8 * s + 5]); w0.w = cvtpk(s0[8 * s + 6], s0[8 * s + 7]);
                w1.x = cvtpk(s1[8 * s + 0], s1[8 * s + 1]); w1.y = cvtpk(s1[8 * s + 2], s1[8 * s + 3]); w1.z = cvtpk(s1[8 * s + 4], s1[8 * s + 5]); w1.w = cvtpk(s1[8 * s + 6], s1[8 * s + 7]);
                pf[s] = __builtin_bit_cast(bf16x8, w0); pf[2 + s] = __builtin_bit_cast(bf16x8, w1);
            }
            const LAS unsigned char* vb = lds + AT_V + cur * 8192 + ((lane >> 4) & 1) * 32 + (lane & 3) * 8 + (4 * h2 + ((lane & 15) >> 2)) * 64;
#pragma unroll
            for (int kk = 0; kk < 4; ++kk) {
                const s16x4 lo0 = vtr(vb + kk * 1024), hi0 = vtr(vb + kk * 1024 + 512), lo1 = vtr(vb + 4096 + kk * 1024), hi1 = vtr(vb + 4096 + kk * 1024 + 512);
                const bf16x8 v0 = (bf16x8){lo0[0], lo0[1], lo0[2], lo0[3], hi0[0], hi0[1], hi0[2], hi0[3]};
                const bf16x8 v1 = (bf16x8){lo1[0], lo1[1], lo1[2], lo1[3], hi1[0], hi1[1], hi1[2], hi1[3]};
                o0 = __builtin_amdgcn_mfma_f32_32x32x16_bf16(v0, pf[kk], o0, 0, 0, 0);
                o1 = __builtin_amdgcn_mfma_f32_32x32x16_bf16(v1, pf[kk], o1, 0, 0, 0);
            }
        }
        if (t + 3 < NT) AT_WAIT_BAR_N(4); else if (t + 3 == NT) AT_WAIT_BAR_N(2); else AT_WAIT_BAR();
    }
#undef AT_DMA
    if (PROBE != 0) { float sink = l_run + o0[0] + o1[3]; asm volatile("" :: "v"(sink)); return; }
    float scale;
    if (MODE == 0) { const float l = l_run + __shfl_xor(l_run, 32); scale = 1.0f / l; }
    else { float ss = 0.f;
#pragma unroll
        for (int r = 0; r < 16; ++r) ss += o0[r] * o0[r] + o1[r] * o1[r];
        ss += __shfl_xor(ss, 32); scale = rsqrtf(ss * (1.0f / 64.0f) + 1e-6f); }
#pragma unroll
    for (int g = 0; g < 4; ++g) {
        const int d0 = 8 * g + 4 * h2;
        const v2u g0 = *(const gv2u*)(Pg + qrow * 256 + h * 64 + d0), g1 = *(const gv2u*)(Pg + qrow * 256 + h * 64 + 32 + d0);
        v2u w0, w1;
        w0.x = cvtpk(o0[4 * g] * scale * bf2f(g0.x & 0xffffu), o0[4 * g + 1] * scale * bf2f(g0.x >> 16)); w0.y = cvtpk(o0[4 * g + 2] * scale * bf2f(g0.y & 0xffffu), o0[4 * g + 3] * scale * bf2f(g0.y >> 16));
        w1.x = cvtpk(o1[4 * g] * scale * bf2f(g1.x & 0xffffu), o1[4 * g + 1] * scale * bf2f(g1.x >> 16)); w1.y = cvtpk(o1[4 * g + 2] * scale * bf2f(g1.y & 0xffffu), o1[4 * g + 3] * scale * bf2f(g1.y >> 16));
        *(gv2u*)(Y + qrow * D + ycol + h * 64 + d0) = w0; *(gv2u*)(Y + qrow * D + ycol + h * 64 + 32 + d0) = w1;
    }
}

template <int MODE>
__device__ __forceinline__ void attn_unit_stg(const gbf* Pq, const gbf* Pk, const gbf* Pv, const gbf* Pg, gbf* Y, int ycol, int b, int h, int qb,
                                              const gf32* KMl, const gf32* lut, LAS unsigned char* lds, int wave, int lane) {
    const int r32 = lane & 31, h2 = lane >> 5, grp = wave >> 2;
    const int q_abs = qb * 256 + wave * 32 + r32; const size_t qrow = (size_t)(b * T + q_abs);
    const unsigned lds0 = (unsigned)(uintptr_t)lds;
    const int NT = 4 * (qb + 1);
    const gbf* ksrc = Pk + (size_t)(b * T + lane) * 256 + h * 64 + wave * 8;
    const gbf* vsrc = Pv + (size_t)(b * T + 16 * (wave & 3) + (lane >> 2)) * 256 + h * 64 + (wave >> 2) * 32 + (lane & 3) * 8;
#define AT_DMA(t, buf) do { glds16(ksrc + (size_t)(t) * 64 * 256, (unsigned)__builtin_amdgcn_readfirstlane(lds0 + AT_K + (buf) * 8192 + wave * 1024)); \
                            glds16(vsrc + (size_t)(t) * 64 * 256, (unsigned)__builtin_amdgcn_readfirstlane(lds0 + AT_V + (buf) * 8192 + wave * 1024)); } while (0)
    AT_DMA(0, 0); AT_DMA(1, 1);
    bf16x8 qf[4];
#pragma unroll
    for (int ks = 0; ks < 4; ++ks) qf[ks] = *(const gbf16x8*)(Pq + qrow * 256 + h * 64 + 16 * ks + 8 * h2);
    LAS float* lutL = (LAS float*)(lds + AT_LUT);
    unsigned sel = 0u;
    if (MODE == 0) {
        if (wave == 0) { const float c31 = lut[h * 128 + 127]; lutL[lane] = (lut[h * 128 + lane] - c31) * LOG2E; lutL[64 + lane] = (lut[h * 128 + 64 + lane] - c31) * LOG2E; }
        if (qb <= 3) sel = (1u << qb) - 1u;
        else {
            f32x16 gacc;
#pragma unroll
            for (int r = 0; r < 16; ++r) gacc[r] = 0.f;
            const gf32* km = KMl + (b * 8 + (r32 & 7)) * 256 + h * 64 + 8 * h2;
#pragma unroll
            for (int ks = 0; ks < 4; ++ks) {
                const f32x4 ka = *(const gf32x4*)(km + 16 * ks), kb = *(const gf32x4*)(km + 16 * ks + 4);
                v4u w; w.x = cvtpk(ka[0], ka[1]); w.y = cvtpk(ka[2], ka[3]); w.z = cvtpk(kb[0], kb[1]); w.w = cvtpk(kb[2], kb[3]);
                gacc = __builtin_amdgcn_mfma_f32_32x32x16_bf16(__builtin_bit_cast(bf16x8, w), qf[ks], gacc, 0, 0, 0);
            }
            float gv[8];
#pragma unroll
            for (int e = 0; e < 4; ++e) { const float mine = gacc[e], other = __shfl_xor(mine, 32); gv[e] = h2 ? other : mine; gv[4 + e] = h2 ? mine : other; }
            float g0 = -INFINITY, g1 = -INFINITY, g2 = -INFINITY; int i0 = 0, i1 = 0, i2 = 0;
#pragma unroll
            for (int n = 0; n < 8; ++n) {
                const float g = (n < qb) ? gv[n] : -INFINITY;
                if (g > g0) { g2 = g1; i2 = i1; g1 = g0; i1 = i0; g0 = g; i0 = n; }
                else if (g > g1) { g2 = g1; i2 = i1; g1 = g; i1 = n; }
                else if (g > g2) { g2 = g; i2 = n; }
            }
            sel = (1u << i0) | (1u << i1) | (1u << i2);
        }
    }
    LAS unsigned* selL = (LAS unsigned*)(lds + AT_SEL) + wave * 64 + lane;
    if (MODE == 0) *selL = sel;
    const float g64 = (MODE == 1) ? ex2(64.0f * log2f(1.0f - ex2(-5.0f - (float)h))) : 1.0f;
    AT_WAIT_BAR_N(2);
    float m_run = 0.f, l_run = 0.f; f32x16 o0, o1, cinit, s0, s1; bf16x8 pf[4];
#pragma unroll
    for (int r = 0; r < 16; ++r) { o0[r] = 0.f; o1[r] = 0.f; cinit[r] = 0.f; s0[r] = 0.f; s1[r] = 0.f; }
#pragma unroll
    for (int k = 0; k < 4; ++k) pf[k] = (bf16x8){0, 0, 0, 0, 0, 0, 0, 0};
#define AT_ACT(i_) (((i_) >> 2) != qb || ((i_) & 3) * 64 <= wave * 32 + 31)
    for (int ph = 0; ph < 2 * NT + 2; ++ph) {
        if (!(ph & 1)) { const int j = (ph >> 1) + 2; if (j < NT) AT_DMA(j, j & (AT_NS - 1)); }
        const int lp = ph - grp;
        if (lp >= 0 && lp <= 2 * NT) {
            const int i = lp >> 1;
            if (!(lp & 1)) {
                if (i >= 1 && AT_ACT(i - 1)) {
                    const LAS unsigned char* vb = lds + AT_V + ((i - 1) & (AT_NS - 1)) * 8192 + ((lane >> 4) & 1) * 32 + (lane & 3) * 8 + (4 * h2 + ((lane & 15) >> 2)) * 64;
#pragma unroll
                    for (int kk = 0; kk < 4; ++kk) {
                        const s16x4 lo0 = vtr(vb + kk * 1024), hi0 = vtr(vb + kk * 1024 + 512), lo1 = vtr(vb + 4096 + kk * 1024), hi1 = vtr(vb + 4096 + kk * 1024 + 512);
                        const bf16x8 v0 = (bf16x8){lo0[0], lo0[1], lo0[2], lo0[3], hi0[0], hi0[1], hi0[2], hi0[3]};
                        const bf16x8 v1 = (bf16x8){lo1[0], lo1[1], lo1[2], lo1[3], hi1[0], hi1[1], hi1[2], hi1[3]};
                        o0 = __builtin_amdgcn_mfma_f32_32x32x16_bf16(v0, pf[kk], o0, 0, 0, 0);
                        o1 = __builtin_amdgcn_mfma_f32_32x32x16_bf16(v1, pf[kk], o1, 0, 0, 0);
                    }
                }
                if (i < NT && AT_ACT(i)) {
                    if (MODE == 0 && (i & 3) == 0) {
                        const int nb = i >> 2; const float cv = (nb == qb || ((*selL >> nb) & 1u)) ? -m_run : -1e30f;
#pragma unroll
                        for (int r = 0; r < 16; ++r) cinit[r] = cv;
                    }
                    s0 = cinit; s1 = cinit;
                    const LAS unsigned char* kb = lds + AT_K + (i & (AT_NS - 1)) * 8192 + h2 * 1024 + r32 * 16;
#pragma unroll
                    for (int ks = 0; ks < 4; ++ks) {
                        const bf16x8 a0 = *(const LAS bf16x8*)(kb + ks * 2048), a1 = *(const LAS bf16x8*)(kb + ks * 2048 + 512);
                        s0 = __builtin_amdgcn_mfma_f32_32x32x16_bf16(a0, qf[ks], s0, 0, 0, 0);
                        s1 = __builtin_amdgcn_mfma_f32_32x32x16_bf16(a1, qf[ks], s1, 0, 0, 0);
                    }
                }
            } else if (AT_ACT(i)) {
                const bool own = ((i >> 2) == qb);
                const int dq = q_abs - (i * 64 + 4 * h2);
                if (MODE == 0) {
                    const bool near = own || (qb * 256 + wave * 32 - (i * 64 + 63) < 113);
                    if (near) {
#pragma unroll
                        for (int r = 0; r < 16; ++r) {
                            const int d0 = dq - ((r & 3) + 8 * (r >> 2)), d1 = d0 - 32;
                            const float b0 = lutL[min(max(d0, 0), 127)], b1 = lutL[min(max(d1, 0), 127)];
                            s0[r] = d0 >= 0 ? s0[r] + b0 : -1e30f;
                            s1[r] = d1 >= 0 ? s1[r] + b1 : -1e30f;
                        }
                    }
                    float mx = fmaxf(fmaxf(s0[0], s0[1]), fmaxf(s1[0], s1[1]));
#pragma unroll
                    for (int r = 2; r < 16; r += 2) mx = fmaxf(mx, fmaxf(fmaxf(s0[r], s0[r + 1]), fmaxf(s1[r], s1[r + 1])));
                    mx = fmaxf(mx, __shfl_xor(mx, 32));
                    if (__any(mx > AT_THR)) {
                        const float dl = fmaxf(mx, 0.f), alpha = ex2(-dl); m_run += dl; l_run *= alpha;
#pragma unroll
                        for (int r = 0; r < 16; ++r) { s0[r] -= dl; s1[r] -= dl; o0[r] *= alpha; o1[r] *= alpha; cinit[r] -= dl; }
                    }
                    float ps = 0.f;
#pragma unroll
                    for (int r = 0; r < 16; ++r) { s0[r] = ex2(s0[r]); s1[r] = ex2(s1[r]); ps += s0[r] + s1[r]; }
                    l_run += ps;
                } else {
                    if (i == qb * 4 + (wave >> 1)) {
#pragma unroll
                        for (int r = 0; r < 16; ++r) {
                            const int d0 = dq - ((r & 3) + 8 * (r >> 2)), d1 = d0 - 32;
                            s0[r] = d0 >= 0 ? s0[r] : 0.f; s1[r] = d1 >= 0 ? s1[r] : 0.f;
                        }
                    }
#pragma unroll
                    for (int r = 0; r < 16; ++r) { o0[r] *= g64; o1[r] *= g64; }
                }
#pragma unroll
                for (int s = 0; s < 2; ++s) {
                    v4u w0, w1;
                    w0.x = cvtpk(s0[8 * s + 0], s0[8 * s + 1]); w0.y = cvtpk(s0[8 * s + 2], s0[8 * s + 3]); w0.z = cvtpk(s0[8 * s + 4], s0[8 * s + 5]); w0.w = cvtpk(s0[8 * s + 6], s0[8 * s + 7]);
                    w1.x = cvtpk(s1[8 * s + 0], s1[8 * s + 1]); w1.y = cvtpk(s1[8 * s + 2], s1[8 * s + 3]); w1.z = cvtpk(s1[8 * s + 4], s1[8 * s + 5]); w1.w = cvtpk(s1[8 * s + 6], s1[8 * s + 7]);
                    pf[s] = __builtin_bit_cast(bf16x8, w0); pf[2 + s] = __builtin_bit_cast(bf16x8, w1);
                }
            }
        }
        if (ph & 1) { const int j = (ph + 1) >> 1; if (j + 1 < NT) AT_WAIT_BAR_N(2); else AT_WAIT_BAR(); }
        else asm volatile("s_waitcnt lgkmcnt(0)\n\ts_barrier" ::: "memory");
    }
#undef AT_DMA
#undef AT_ACT
    int qa2 = q_abs; asm volatile("" : "+v"(qa2));
    const size_t qrow_e = (size_t)(b * T + qa2);
    float scale;
    if (MODE == 0) { const float l = l_run + __shfl_xor(l_run, 32); scale = 1.0f / l; }
    else { float ss = 0.f;
#pragma unroll
        for (int r = 0; r < 16; ++r) ss += o0[r] * o0[r] + o1[r] * o1[r];
        ss += __shfl_xor(ss, 32); scale = rsqrtf(ss * (1.0f / 64.0f) + 1e-6f); }
#pragma unroll
    for (int g = 0; g < 4; ++g) {
        const int d0 = 8 * g + 4 * h2;
        const v2u g0 = *(const gv2u*)(Pg + qrow_e * 256 + h * 64 + d0), g1 = *(const gv2u*)(Pg + qrow_e * 256 + h * 64 + 32 + d0);
        v2u w0, w1;
        w0.x = cvtpk(o0[4 * g] * scale * bf2f(g0.x & 0xffffu), o0[4 * g + 1] * scale * bf2f(g0.x >> 16)); w0.y = cvtpk(o0[4 * g + 2] * scale * bf2f(g0.y & 0xffffu), o0[4 * g + 3] * scale * bf2f(g0.y >> 16));
        w1.x = cvtpk(o1[4 * g] * scale * bf2f(g1.x & 0xffffu), o1[4 * g + 1] * scale * bf2f(g1.x >> 16)); w1.y = cvtpk(o1[4 * g + 2] * scale * bf2f(g1.y & 0xffffu), o1[4 * g + 3] * scale * bf2f(g1.y >> 16));
        *(gv2u*)(Y + qrow_e * D + ycol + h * 64 + d0) = w0; *(gv2u*)(Y + qrow_e * D + ycol + h * 64 + 32 + d0) = w1;
    }
}

constexpr int AB_SLOT = 65536, AB_LUT = LDSCTL_OFF + 1024, AB_LUT2 = LDSCTL_OFF + 2048;
static_assert(2 * AB_SLOT <= RING_BYTES && AB_LUT2 + 6144 <= LDS_BYTES, "attention block ring");
template <int MODE>
__device__ __forceinline__ void attn_unit_blk(const gbf* Pq, const gbf* Pk, const gbf* Pv, const gbf* Pg, gbf* Y, int ycol, int b, int h, int qb,
                                              const gf32* KMl, const gf32* lut, LAS unsigned char* lds, int wave, int lane) {
    const int r32 = lane & 31, h2 = lane >> 5;
    const int q_abs = qb * 256 + wave * 32 + r32; const size_t qrow = (size_t)(b * T + q_abs);
    const unsigned lds0 = (unsigned)(uintptr_t)lds;
    const int NS = qb + 1;
    const int kkey_ = wave * 8 + (lane >> 3);
    const gbf* ksrc = Pk + (size_t)(b * T + kkey_) * 256 + h * 64 + (((lane & 7) ^ ((kkey_ >> 1) & 7)) * 8);
    int koff[4];
#pragma unroll
    for (int ks = 0; ks < 4; ++ks) koff[ks] = r32 * 128 + (((2 * ks + h2) ^ ((r32 >> 1) & 7)) * 16);
    const gbf* vsrc = Pv + (size_t)(b * T + 16 * (wave & 3) + (lane >> 2)) * 256 + h * 64 + (wave >> 2) * 32 + (lane & 3) * 8;
#define AB_DMA(S_, slot_) do { _Pragma("unroll") for (int u_ = 0; u_ < 4; ++u_) { \
        glds16(ksrc + (size_t)((S_) * 4 + u_) * 64 * 256, (unsigned)__builtin_amdgcn_readfirstlane(lds0 + (slot_) * AB_SLOT + u_ * 8192 + wave * 1024)); \
        glds16(vsrc + (size_t)((S_) * 4 + u_) * 64 * 256, (unsigned)__builtin_amdgcn_readfirstlane(lds0 + (slot_) * AB_SLOT + 32768 + u_ * 8192 + wave * 1024)); } } while (0)
    AB_DMA(0, 0);
    if (MODE == 0 && wave < 6) glds16((const GAS unsigned char*)lut + (TAB_LUT2 - TAB_LUT) + (size_t)h * 6144 + wave * 1024 + lane * 16, (unsigned)__builtin_amdgcn_readfirstlane(lds0 + AB_LUT2 + wave * 1024));
    bf16x8 qf[4];
#pragma unroll
    for (int ks = 0; ks < 4; ++ks) qf[ks] = *(const gbf16x8*)(Pq + qrow * 256 + h * 64 + 16 * ks + 8 * h2);
    LAS float* lutL = (LAS float*)(lds + AB_LUT);
    unsigned sel = 0u;
    if (MODE == 0) {
        if (qb <= 3) sel = (1u << qb) - 1u;
        else {
            f32x16 gacc;
#pragma unroll
            for (int r = 0; r < 16; ++r) gacc[r] = 0.f;
            const gf32* km = KMl + (b * 8 + (r32 & 7)) * 256 + h * 64 + 8 * h2;
#pragma unroll
            for (int ks = 0; ks < 4; ++ks) {
                const f32x4 ka = *(const gf32x4*)(km + 16 * ks), kb = *(const gf32x4*)(km + 16 * ks + 4);
                v4u w; w.x = cvtpk(ka[0], ka[1]); w.y = cvtpk(ka[2], ka[3]); w.z = cvtpk(kb[0], kb[1]); w.w = cvtpk(kb[2], kb[3]);
                gacc = __builtin_amdgcn_mfma_f32_32x32x16_bf16(__builtin_bit_cast(bf16x8, w), qf[ks], gacc, 0, 0, 0);
            }
            float gv[8];
#pragma unroll
            for (int e = 0; e < 4; ++e) { const float mine = gacc[e], other = __shfl_xor(mine, 32); gv[e] = h2 ? other : mine; gv[4 + e] = h2 ? mine : other; }
            float g0 = -INFINITY, g1 = -INFINITY, g2 = -INFINITY; int i0 = 0, i1 = 0, i2 = 0;
#pragma unroll
            for (int n = 0; n < 8; ++n) {
                const float g = (n < qb) ? gv[n] : -INFINITY;
                if (g > g0) { g2 = g1; i2 = i1; g1 = g0; i1 = i0; g0 = g; i0 = n; }
                else if (g > g1) { g2 = g1; i2 = i1; g1 = g; i1 = n; }
                else if (g > g2) { g2 = g; i2 = n; }
            }
            sel = (1u << i0) | (1u << i1) | (1u << i2);
        }
    }
    const float g64 = (MODE == 1) ? ex2(256.0f * log2f(1.0f - ex2(-5.0f - (float)h))) : 1.0f;
    float m_run = 0.f; f32x16 o0, o1, cinit, lacc;
#pragma unroll
    for (int r = 0; r < 16; ++r) { o0[r] = 0.f; o1[r] = 0.f; cinit[r] = 0.f; lacc[r] = 0.f; }
    const bf16x8 ones = (bf16x8){0x3F80, 0x3F80, 0x3F80, 0x3F80, 0x3F80, 0x3F80, 0x3F80, 0x3F80};
    for (int S = 0; S < NS; ++S) {
        if (S + 1 < NS) AB_DMA(S + 1, (S + 1) & 1);
        if (S == 0) { if (NS > 1) AT_WAIT_BAR_N(8); else AT_WAIT_BAR(); }
        const bool own = (S == qb);
        if (MODE == 0) { const float cv = (own || ((sel >> S) & 1u)) ? -m_run : -1e30f;
#pragma unroll
            for (int r = 0; r < 16; ++r) cinit[r] = cv; }
        if (MODE == 1 && S > 0) {
#pragma unroll
            for (int r = 0; r < 16; ++r) { o0[r] *= g64; o1[r] *= g64; } }
        const LAS unsigned char* slot = lds + (S & 1) * AB_SLOT;
        bf16x8 kf[8]; bool have = false;
#pragma unroll 1
        for (int u = 0; u < 4; ++u) {
            const int t = 4 * S + u;
            const bool active = !own || (u * 64 <= wave * 32 + 31);
            if (!active) break;
            const LAS unsigned char* kb = slot + u * 8192;
            if (!have) {
#pragma unroll
                for (int ks = 0; ks < 4; ++ks) { kf[2 * ks] = *(const LAS bf16x8*)(kb + koff[ks]); kf[2 * ks + 1] = *(const LAS bf16x8*)(kb + koff[ks] + 4096); }
            }
            f32x16 s0 = cinit, s1 = cinit;
#pragma unroll
            for (int ks = 0; ks < 4; ++ks) {
                s0 = __builtin_amdgcn_mfma_f32_32x32x16_bf16(kf[2 * ks], qf[ks], s0, 0, 0, 0);
                s1 = __builtin_amdgcn_mfma_f32_32x32x16_bf16(kf[2 * ks + 1], qf[ks], s1, 0, 0, 0);
            }
            __builtin_amdgcn_sched_barrier(0);
            const LAS unsigned char* vb = slot + 32768 + u * 8192 + ((lane >> 4) & 1) * 32 + (lane & 3) * 8 + (4 * h2 + ((lane & 15) >> 2)) * 64;
            s16x4 vlo0[4], vhi0[4], vlo1[4], vhi1[4];
#pragma unroll
            for (int kk = 0; kk < 4; ++kk) { vlo0[kk] = vtr(vb + kk * 1024); vhi0[kk] = vtr(vb + kk * 1024 + 512); vlo1[kk] = vtr(vb + 4096 + kk * 1024); vhi1[kk] = vtr(vb + 4096 + kk * 1024 + 512); }
            __builtin_amdgcn_sched_barrier(0);
            const int dq = q_abs - (t * 64 + 4 * h2);
            if (MODE == 0) {
                const bool near = own || (qb * 256 + wave * 32 - (t * 64 + 63) < 113);
                if (near) {
                    const int jb = 255 - dq, cpy = jb & 3;
                    const LAS unsigned char* lp = lds + AB_LUT2 + cpy * 1344 + (jb - cpy) * 4;
#pragma unroll
                    for (int g = 0; g < 4; ++g) {
                        const f32x4 b0 = *(const LAS f32x4*)(lp + 32 * g), b1 = *(const LAS f32x4*)(lp + 128 + 32 * g);
#pragma unroll
                        for (int k = 0; k < 4; ++k) { s0[4 * g + k] += b0[k]; s1[4 * g + k] += b1[k]; }
                    }
                }
                float mxa = fmaxf(s0[0], s1[0]), mxb = fmaxf(s0[1], s1[1]);
#pragma unroll
                for (int r = 2; r < 16; r += 2) { mxa = fmaxf(fmaxf(mxa, s0[r]), s1[r]); mxb = fmaxf(fmaxf(mxb, s0[r + 1]), s1[r + 1]); }
                float mx = fmaxf(mxa, mxb);
                { const auto sw = __builtin_amdgcn_permlane32_swap(__float_as_uint(mx), __float_as_uint(mx), false, false);
                  mx = fmaxf(__uint_as_float(sw[0]), __uint_as_float(sw[1])); }
                if (__any(mx > AT_THR)) {
                    const float dl = fmaxf(mx, 0.f), alpha = ex2(-dl); m_run += dl; lacc[0] *= alpha;
#pragma unroll
                    for (int r = 0; r < 16; ++r) { s0[r] -= dl; s1[r] -= dl; o0[r] *= alpha; o1[r] *= alpha; cinit[r] -= dl; }
                }
            } else {
                if (t == qb * 4 + (wave >> 1)) {
#pragma unroll
                    for (int r = 0; r < 16; ++r) {
                        const int d0 = dq - ((r & 3) + 8 * (r >> 2)), d1 = d0 - 32;
                        s0[r] = d0 >= 0 ? s0[r] : 0.f; s1[r] = d1 >= 0 ? s1[r] : 0.f;
                    }
                }
            }
            bf16x8 pf[4];
#define AT_EX(kk, e) do { if (MODE == 0) { if ((kk) < 2) s0[8 * ((kk) & 1) + (e)] = ex2(s0[8 * ((kk) & 1) + (e)]); else s1[8 * ((kk) & 1) + (e)] = ex2(s1[8 * ((kk) & 1) + (e)]); } } while (0)
#define AT_CVT(kk) do { const int b_ = 8 * ((kk) & 1); v4u w_; \
                if ((kk) < 2) { w_.x = cvtpk(s0[b_], s0[b_ + 1]); w_.y = cvtpk(s0[b_ + 2], s0[b_ + 3]); w_.z = cvtpk(s0[b_ + 4], s0[b_ + 5]); w_.w = cvtpk(s0[b_ + 6], s0[b_ + 7]); } \
                else { w_.x = cvtpk(s1[b_], s1[b_ + 1]); w_.y = cvtpk(s1[b_ + 2], s1[b_ + 3]); w_.z = cvtpk(s1[b_ + 4], s1[b_ + 5]); w_.w = cvtpk(s1[b_ + 6], s1[b_ + 7]); } \
                pf[kk] = __builtin_bit_cast(bf16x8, w_); } while (0)
#define AT_SB() __builtin_amdgcn_sched_barrier(0)
#pragma unroll
            for (int e = 0; e < 8; ++e) AT_EX(0, e);
            AT_CVT(0);
            AT_SB();
            have = (u < 3) && (!own || ((u + 1) * 64 <= wave * 32 + 31));
            if (have) {
#pragma unroll
                for (int ks = 0; ks < 4; ++ks) { kf[2 * ks] = *(const LAS bf16x8*)(kb + 8192 + koff[ks]); kf[2 * ks + 1] = *(const LAS bf16x8*)(kb + 8192 + koff[ks] + 4096); }
            }
            AT_SB();
#pragma unroll
            for (int kk = 0; kk < 4; ++kk) {
                const s16x4 lo0 = vlo0[kk], hi0 = vhi0[kk], lo1 = vlo1[kk], hi1 = vhi1[kk];
                const bf16x8 v0 = (bf16x8){lo0[0], lo0[1], lo0[2], lo0[3], hi0[0], hi0[1], hi0[2], hi0[3]};
                const bf16x8 v1 = (bf16x8){lo1[0], lo1[1], lo1[2], lo1[3], hi1[0], hi1[1], hi1[2], hi1[3]};
                o0 = __builtin_amdgcn_mfma_f32_32x32x16_bf16(v0, pf[kk], o0, 0, 0, 0);
                AT_SB();
                if (kk < 3) { if (MODE == 0) { AT_EX(kk + 1, 0); AT_EX(kk + 1, 1); AT_EX(kk + 1, 2); } else AT_CVT(kk + 1); }
                AT_SB();
                o1 = __builtin_amdgcn_mfma_f32_32x32x16_bf16(v1, pf[kk], o1, 0, 0, 0);
                if (MODE == 0) {
                    AT_SB();
                    if (kk < 3) { AT_EX(kk + 1, 3); AT_EX(kk + 1, 4); AT_EX(kk + 1, 5); }
                    AT_SB();
                    lacc = __builtin_amdgcn_mfma_f32_32x32x16_bf16(ones, pf[kk], lacc, 0, 0, 0);
                    AT_SB();
                    if (kk < 3) { AT_EX(kk + 1, 6); AT_EX(kk + 1, 7); AT_CVT(kk + 1); }
                    AT_SB();
                }
            }
#undef AT_EX
#undef AT_CVT
#undef AT_SB
        }
        AT_WAIT_BAR();
    }
#undef AB_DMA
    int qa2 = q_abs; asm volatile("" : "+v"(qa2));
    const size_t qrow_e = (size_t)(b * T + qa2);
    float scale;
    if (MODE == 0) { scale = 1.0f / lacc[0]; }
    else { float ss = 0.f;
#pragma unroll
        for (int r = 0; r < 16; ++r) ss += o0[r] * o0[r] + o1[r] * o1[r];
        ss += __shfl_xor(ss, 32); scale = rsqrtf(ss * (1.0f / 64.0f) + 1e-6f); }
#pragma unroll
    for (int g = 0; g < 4; ++g) {
        const int d0 = 8 * g + 4 * h2;
        const v2u g0 = *(const gv2u*)(Pg + qrow_e * 256 + h * 64 + d0), g1 = *(const gv2u*)(Pg + qrow_e * 256 + h * 64 + 32 + d0);
        v2u w0, w1;
        w0.x = cvtpk(o0[4 * g] * scale * bf2f(g0.x & 0xffffu), o0[4 * g + 1] * scale * bf2f(g0.x >> 16)); w0.y = cvtpk(o0[4 * g + 2] * scale * bf2f(g0.y & 0xffffu), o0[4 * g + 3] * scale * bf2f(g0.y >> 16));
        w1.x = cvtpk(o1[4 * g] * scale * bf2f(g1.x & 0xffffu), o1[4 * g + 1] * scale * bf2f(g1.x >> 16)); w1.y = cvtpk(o1[4 * g + 2] * scale * bf2f(g1.y & 0xffffu), o1[4 * g + 3] * scale * bf2f(g1.y >> 16));
        *(gv2u*)(Y + qrow_e * D + ycol + h * 64 + d0) = w0; *(gv2u*)(Y + qrow_e * D + ycol + h * 64 + 32 + d0) = w1;
    }
}

__device__ __forceinline__ void attn_dispatch(const gu8* wsc, int l, int u, LAS unsigned char* lds, int wave, int lane) {
    gu8* ws = (gu8*)wsc;
    const gbf* PB = (const gbf*)(ws + WS_PB);
    const gf32* KMl = (const gf32*)(ws + WS_CTL + CTL_KM) + l * 64 * 256;
    const gf32* lut = (const gf32*)(ws + WS_TAB + TAB_LUT);
    gbf* Y = (gbf*)(ws + WS_XB);
    const int qb = 7 - (u >> 6), mode = (u >> 5) & 1, b = (u >> 2) & 7, h = u & 3;
#if ATT_STAGGER == 2
    if (mode == 0) attn_unit_blk<0>(PB + 8 * PANEL, PB + 9 * PANEL, PB + 10 * PANEL, PB + 11 * PANEL, Y, 512, b, h, qb, KMl, lut, lds, wave, lane);
    else           attn_unit_blk<1>(PB + 12 * PANEL, PB + 13 * PANEL, PB + 14 * PANEL, PB + 15 * PANEL, Y, 768, b, h, qb, KMl, lut, lds, wave, lane);
#elif ATT_STAGGER == 1
    if (mode == 0) attn_unit_stg<0>(PB + 8 * PANEL, PB + 9 * PANEL, PB + 10 * PANEL, PB + 11 * PANEL, Y, 512, b, h, qb, KMl, lut, lds, wave, lane);
    else           attn_unit_stg<1>(PB + 12 * PANEL, PB + 13 * PANEL, PB + 14 * PANEL, PB + 15 * PANEL, Y, 768, b, h, qb, KMl, lut, lds, wave, lane);
#else
    if (mode == 0) attn_unit<0>(PB + 8 * PANEL, PB + 9 * PANEL, PB + 10 * PANEL, PB + 11 * PANEL, Y, 512, b, h, qb, KMl, lut, lds, wave, lane);
    else           attn_unit<1>(PB + 12 * PANEL, PB + 13 * PANEL, PB + 14 * PANEL, PB + 15 * PANEL, Y, 768, b, h, qb, KMl, lut, lds, wave, lane);
#endif
#if PROBE_ATT
    if (mode == 0) attn_unit<0, PROBE_ATT>(PB + 8 * PANEL, PB + 9 * PANEL, PB + 10 * PANEL, PB + 11 * PANEL, Y, 512, b, h, qb, KMl, lut, lds, wave, lane);
    else           attn_unit<1, PROBE_ATT>(PB + 12 * PANEL, PB + 13 * PANEL, PB + 14 * PANEL, PB + 15 * PANEL, Y, 768, b, h, qb, KMl, lut, lds, wave, lane);
#endif
}
constexpr int RP = 144, TILE_B = 64 * RP;
constexpr int RW_LORA = 5 * TILE_B, RW_W2S = RW_LORA + 64 * 65 * 4, RW_A2S = RW_W2S + 8192;
constexpr int RW_TOT = 12 * TILE_B, RW_GL = RW_TOT + 2048, RW_END = RW_GL + 256;
constexpr int RW_W2P = 114688, RW_A2P = RW_W2P + 8192;
static_assert(2 * 64 * 68 * 4 <= 4 * TILE_B && RW_END <= RW_W2P && RW_W2P + 64 * RP <= RING_BYTES, "rwkv LDS map");

typedef GAS unsigned long long gu64;
__device__ __forceinline__ void st_wt64(GAS void* p, v2u v) { __hip_atomic_store((gu64*)p, ((unsigned long long)v.y << 32) | v.x, __ATOMIC_RELAXED, __HIP_MEMORY_SCOPE_AGENT); }
__device__ __forceinline__ void st_wt128(GAS void* p, v4u v) { st_wt64(p, (v2u){v.x, v.y}); st_wt64((GAS unsigned char*)p + 8, (v2u){v.z, v.w}); }
__device__ __forceinline__ void st_wt128f(GAS void* p, f32x4 v) { st_wt128(p, __builtin_bit_cast(v4u, v)); }
__device__ __forceinline__ bf16x8 rowfrag(const LAS unsigned char* tile, int idx0, int k0, int r32, int h2) { return *(const LAS bf16x8*)(tile + (idx0 + r32) * RP + (k0 + 8 * h2) * 2); }
__device__ __forceinline__ bf16x8 trfrag(const LAS unsigned char* tile, int k0, int idx0, int lane) {
    const int g = lane >> 4, i = lane & 15;
    const LAS unsigned char* p = tile + (k0 + 8 * (g >> 1) + (i >> 2)) * RP + (idx0 + 16 * (g & 1) + 4 * (i & 3)) * 2;
    const s16x4 lo = vtr(p), hi = vtr(p + 4 * RP);
    return (bf16x8){lo[0], lo[1], lo[2], lo[3], hi[0], hi[1], hi[2], hi[3]};
}
template <bool ATR, bool BTR>
__device__ __forceinline__ void quad_mma(f32x16& acc, const LAS unsigned char* At, int a0, const LAS unsigned char* Bt, int b0, int klo, int khi, int lane) {
    const int r32 = lane & 31, h2 = lane >> 5;
    const int nk = (khi - klo) >> 4;
    bf16x8 af[4], bfr[4];
#pragma unroll
    for (int i = 0; i < 4; ++i) { const int k0 = klo + 16 * i;
        af[i] = ATR ? trfrag(At, k0, a0, lane) : rowfrag(At, a0, k0, r32, h2);
        bfr[i] = BTR ? trfrag(Bt, k0, b0, lane) : rowfrag(Bt, b0, k0, r32, h2); }
    __builtin_amdgcn_sched_barrier(0);
    if (nk > 0) acc = __builtin_amdgcn_mfma_f32_32x32x16_bf16(bfr[0], af[0], acc, 0, 0, 0);
    if (nk > 1) acc = __builtin_amdgcn_mfma_f32_32x32x16_bf16(bfr[1], af[1], acc, 0, 0, 0);
    if (nk > 2) acc = __builtin_amdgcn_mfma_f32_32x32x16_bf16(bfr[2], af[2], acc, 0, 0, 0);
    if (nk > 3) acc = __builtin_amdgcn_mfma_f32_32x32x16_bf16(bfr[3], af[3], acc, 0, 0, 0);
}
__device__ __forceinline__ void quad_store_lds(const f32x16& acc, LAS unsigned char* tile, int a0, int b0, int lane) {
    const int r32 = lane & 31, h2 = lane >> 5;
#pragma unroll
    for (int g = 0; g < 4; ++g) { v2u w; w.x = cvtpk(acc[4 * g], acc[4 * g + 1]); w.y = cvtpk(acc[4 * g + 2], acc[4 * g + 3]);
        *(LAS v2u*)(tile + (a0 + r32) * RP + (b0 + 8 * g + 4 * h2) * 2) = w; }
}
#define RW_BAR() __syncthreads()

struct R1In { v4u l0, l1, r0, r1, k0, k1, v0, v1; };
__device__ __forceinline__ void r1_load(R1In& in, const gu8* wsc, int item, int tid) {
    const gbf* PB = (const gbf*)((gu8*)wsc + WS_PB); const gbf*P0 = PB, *P1 = PB + PANEL, *P2 = PB + 2 * PANEL, *P16 = PB + 16 * PANEL;
    const int c = item & 31, h = (item >> 5) & 3, b = (item >> 7) & 7, t = tid >> 3, cg = tid & 7, c0 = h * 64 + 8 * cg, tl = c * 64 + t;
    const size_t tok = (size_t)b * T + tl, prv = tok - (tl > 0 ? 1 : 0);
    in.l0 = *(const gv4u*)(P16 + tok * 64 + 8 * cg); in.l1 = *(const gv4u*)(P16 + prv * 64 + 8 * cg);
    in.r0 = *(const gv4u*)(P0 + tok * 256 + c0); in.r1 = *(const gv4u*)(P0 + prv * 256 + c0);
    in.k0 = *(const gv4u*)(P1 + tok * 256 + c0); in.k1 = *(const gv4u*)(P1 + prv * 256 + c0);
    in.v0 = *(const gv4u*)(P2 + tok * 256 + c0); in.v1 = *(const gv4u*)(P2 + prv * 256 + c0);
}
constexpr int RW_PAR = RW_W2P + 64 * RP;
static_assert(RW_PAR + 9 * 64 * 4 <= RING_BYTES, "rwkv parameter block");
__device__ __forceinline__ void r1_stage_lora_w(const DArgs& a, int l, int h, LAS unsigned char* lds, int tid) {
    const gf32*w2 = a.in[6] + l * 32 * 256, *a2 = a.in[8] + l * 32 * 256;
    const int idx = tid * 4, m = idx >> 6, j = idx & 63;
    const f32x4 wv = *(const gf32x4*)(w2 + m * 256 + h * 64 + j), av = *(const gf32x4*)(a2 + m * 256 + h * 64 + j);
    v2u ww, aw; ww.x = cvtpk(wv[0], wv[1]); ww.y = cvtpk(wv[2], wv[3]); aw.x = cvtpk(av[0], av[1]); aw.y = cvtpk(av[2], av[3]);
    *(LAS v2u*)(lds + RW_W2P + m * RP + j * 2) = ww; *(LAS v2u*)(lds + RW_W2P + 32 * RP + m * RP + j * 2) = aw;
}
__device__ __forceinline__ void rwkv_chunk_item(const gu8* wsc, const DArgs& a, int l, int item, const R1In& in, int next_item, R1In& nxt, LAS unsigned char* lds, int wave, int lane, int tid) {
    gu8* ws = (gu8*)wsc;
    const int c = item & 31, h = (item >> 5) & 3, b = (item >> 7) & 7;
    const gf32*mu = a.in[4] + l * 832, *w0 = a.in[5] + l * 256, *a0p = a.in[7] + l * 256,
                *k_k = a.in[9] + l * 256, *k_a = a.in[10] + l * 256, *r_k = a.in[11] + l * 256;
    gu8* tmpb = (gu8*)a.out;
    gbf* QtG = (gbf*)(tmpb) + (size_t)item * 4096; gbf* PG = (gbf*)(tmpb + 8 * MiB) + (size_t)item * 4096;
    gf32* YiG = (gf32*)(tmpb + 16 * MiB) + (size_t)item * 4096; gf32* GG = (gf32*)(ws + WS_R1) + (size_t)item * 4096;
    gf32* SB = (gf32*)(ws + WS_SB);
    const int r32 = lane & 31, h2 = lane >> 5;
#define TL(s) (lds + (s) * TILE_B)
    {
        const int t = tid >> 3, cg = tid & 7, c0 = h * 64 + 8 * cg, tl = c * 64 + t; const size_t tok = (size_t)b * T + tl; const bool hp = tl > 0;
        { float fc[8], fp[8], xl[8]; unpack8(in.l0, fc); unpack8(in.l1, fp);
#pragma unroll
          for (int e = 0; e < 8; ++e) { float x = fc[e] + ((hp ? fp[e] : 0.f) - fc[e]) * mu[768 + 8 * cg + e]; if (cg < 4) x = 1.0f - 2.0f * __builtin_amdgcn_rcpf(1.0f + __expf(2.0f * x)); xl[e] = x; }
          v4u w_; w_.x = cvtpk(xl[0], xl[1]); w_.y = cvtpk(xl[2], xl[3]); w_.z = cvtpk(xl[4], xl[5]); w_.w = cvtpk(xl[6], xl[7]); *(LAS v4u*)(TL(5) + t * RP + cg * 16) = w_; }
        float xr[8], xk[8], xv[8];
        { float f0[8], f1[8];
          unpack8(in.r0, f0); unpack8(in.r1, f1);
#pragma unroll
          for (int e = 0; e < 8; ++e) xr[e] = f0[e] + ((hp ? f1[e] : 0.f) - f0[e]) * mu[c0 + e];
          unpack8(in.k0, f0); unpack8(in.k1, f1);
#pragma unroll
          for (int e = 0; e < 8; ++e) xk[e] = f0[e] + ((hp ? f1[e] : 0.f) - f0[e]) * mu[256 + c0 + e];
          unpack8(in.v0, f0); unpack8(in.v1, f1);
#pragma unroll
          for (int e = 0; e < 8; ++e) xv[e] = f0[e] + ((hp ? f1[e] : 0.f) - f0[e]) * mu[512 + c0 + e]; }
        RW_BAR();
        { const int kind = wave >> 2, q = wave & 3, qa = (q >> 1) * 32, qb_ = (q & 1) * 32; f32x16 acc;
#pragma unroll
          for (int r = 0; r < 16; ++r) acc[r] = 0.f;
          quad_mma<false, true>(acc, TL(5) + kind * 64, qa, lds + RW_W2P + kind * 32 * RP, qb_, 0, 32, lane);
          LAS float* od = (LAS float*)(lds + 8 * TILE_B) + kind * (64 * 68) + (qa + r32) * 68 + qb_ + 4 * h2;
#pragma unroll
          for (int g = 0; g < 4; ++g) *(LAS f32x4*)(od + 8 * g) = (f32x4){acc[4 * g], acc[4 * g + 1], acc[4 * g + 2], acc[4 * g + 3]}; }
        RW_BAR();
        float lw[8], la[8];
        { const LAS float* lwp = (const LAS float*)(lds + 8 * TILE_B) + t * 68 + 8 * cg; const LAS float* lap = lwp + 64 * 68;
          const f32x4 w0_ = *(const LAS f32x4*)lwp, w1_ = *(const LAS f32x4*)(lwp + 4), a0_ = *(const LAS f32x4*)lap, a1_ = *(const LAS f32x4*)(lap + 4);
#pragma unroll
          for (int e = 0; e < 4; ++e) { lw[e] = w0_[e]; lw[4 + e] = w1_[e]; la[e] = a0_[e]; la[4 + e] = a1_[e]; } }
        float l2w[8], av[8], kk[8], kp[8]; float ssum = 0.f, sb = 0.f;
#pragma unroll
        for (int e = 0; e < 8; ++e) {
            l2w[e] = (-0.6065306597126334f * LOG2E) * sigmoidf_(w0[c0 + e] + lw[e]);
            av[e] = sigmoidf_(a0p[c0 + e] + la[e]);
            kk[e] = xk[e] * k_k[c0 + e]; ssum += kk[e] * kk[e];
            kp[e] = xk[e] * (1.0f + (av[e] - 1.0f) * k_a[c0 + e]);
            sb += xr[e] * kp[e] * r_k[c0 + e];
        }
        ssum += __shfl_xor(ssum, 1); ssum += __shfl_xor(ssum, 2); ssum += __shfl_xor(ssum, 4);
        sb += __shfl_xor(sb, 1); sb += __shfl_xor(sb, 2); sb += __shfl_xor(sb, 4);
        if (cg == 0) SB[tok * 4 + h] = sb;
        const float rn = __builtin_amdgcn_rsqf(fmaxf(ssum, 1e-24f));
        float cs[8];
#pragma unroll
        for (int e = 0; e < 8; ++e) cs[e] = l2w[e];
#pragma unroll
        for (int off = 8; off < 64; off <<= 1) {
#pragma unroll
            for (int e = 0; e < 8; ++e) { const float v = __shfl_up(cs[e], off); if (lane >= off) cs[e] += v; }
        }
        LAS float* tot = (LAS float*)(lds + RW_TOT);
        if (lane >= 56) {
#pragma unroll
            for (int e = 0; e < 8; ++e) tot[wave * 64 + 8 * cg + e] = cs[e]; }
        RW_BAR();
        for (int w = 0; w < wave; ++w) {
            const f32x4 ta = *(const LAS f32x4*)(tot + w * 64 + 8 * cg), tb = *(const LAS f32x4*)(tot + w * 64 + 8 * cg + 4);
#pragma unroll
            for (int e = 0; e < 4; ++e) { cs[e] += ta[e]; cs[4 + e] += tb[e]; }
        }
        float vRb[8], vAb[8], vBb[8], vKb[8];
#pragma unroll
        for (int e = 0; e < 8; ++e) {
            const float g = ex2(cs[e]), gp = ex2(cs[e] - l2w[e]), gi = ex2(-cs[e]); const float kn = kk[e] * rn;
            vRb[e] = xr[e] * g; vAb[e] = kn * gp; vBb[e] = -kn * av[e] * gi; vKb[e] = kp[e] * gi;
            if (t == 63) ((LAS float*)(lds + RW_GL))[8 * cg + e] = g;
        }
#define ST8(slot, v) do { v4u w_; w_.x = cvtpk(v[0], v[1]); w_.y = cvtpk(v[2], v[3]); w_.z = cvtpk(v[4], v[5]); w_.w = cvtpk(v[6], v[7]); *(LAS v4u*)(TL(slot) + t * RP + cg * 16) = w_; } while (0)
        ST8(0, vRb); ST8(1, vAb); ST8(2, vBb); ST8(3, vKb); ST8(4, xv);
#undef ST8
        RW_BAR();
    }
    if (PROBE_R1 == 1 && item >= 4096) return;
    f32x16 macc;
#pragma unroll
    for (int r = 0; r < 16; ++r) macc[r] = 0.f;
#pragma unroll
    for (int rnd = 0; rnd < 2; ++rnd) {
        const int id = rnd * 8 + wave;
        if (id < 12) {
            const int mi = id / 3, qi = id % 3, qa = qi >= 1 ? 32 : 0, qb_ = qi == 2 ? 32 : 0;
            f32x16 acc;
#pragma unroll
            for (int r = 0; r < 16; ++r) acc[r] = 0.f;
            quad_mma<false, false>(acc, TL(mi < 2 ? 1 : 0), qa, TL((mi & 1) ? 3 : 2), qb_, 0, 64, lane);
            const int trow = qa + r32; const bool strict = mi < 2;
#pragma unroll
            for (int r = 0; r < 16; ++r) { const int tau = qb_ + (r & 3) + 8 * (r >> 2) + 4 * h2; const bool keep = strict ? (tau < trow) : (tau <= trow); acc[r] = keep ? acc[r] : 0.f; }
            quad_store_lds(acc, TL(5 + mi), qa, qb_, lane);
            if (mi == 0) {
#pragma unroll
                for (int r = 0; r < 16; ++r) { const int tau = qb_ + (r & 3) + 8 * (r >> 2) + 4 * h2; macc[r] = acc[r] + (tau == trow ? 1.0f : 0.f); }
                quad_store_lds(macc, TL(10), qa, qb_, lane);
            }
        }
    }
    RW_BAR();
    {
        const int qi = wave < 3 ? wave : wave - 3, qa = qi >= 1 ? 32 : 0, qb_ = qi == 2 ? 32 : 0;
        if (wave >= 3 && wave < 6) { f32x16 acc;
#pragma unroll
            for (int r = 0; r < 16; ++r) acc[r] = 0.f;
            quad_mma<false, true>(acc, TL(5), qa, TL(5), qb_, qb_, qa + 32, lane); quad_store_lds(acc, TL(9), qa, qb_, lane); }
        RW_BAR();
#pragma unroll
        for (int k = 1; k <= 5; ++k) {
            const int xs = (k & 1) ? 9 : 5, xd = (k & 1) ? 5 : 9, ms = (k & 1) ? 10 : 11, md = (k & 1) ? 11 : 10;
            if (wave < 3) { quad_mma<false, true>(macc, TL(ms), qa, TL(xs), qb_, qb_, qa + 32, lane); quad_store_lds(macc, TL(md), qa, qb_, lane); }
            else if (wave < 6 && k < 5) { f32x16 acc;
#pragma unroll
                for (int r = 0; r < 16; ++r) acc[r] = 0.f;
                quad_mma<false, true>(acc, TL(xs), qa, TL(xs), qb_, qb_, qa + 32, lane); quad_store_lds(acc, TL(xd), qa, qb_, lane); }
            RW_BAR();
        }
    }
    {
        const int q = wave & 3, qa = (q >> 1) * 32, qb_ = (q & 1) * 32; f32x16 acc;
#pragma unroll
        for (int r = 0; r < 16; ++r) acc[r] = 0.f;
        if (wave < 4) { quad_mma<false, true>(acc, TL(11), qa, TL(1), qb_, 0, qa + 32, lane); quad_store_lds(acc, TL(5), qa, qb_, lane); }
        else          { quad_mma<false, true>(acc, TL(6), qa, TL(4), qb_, 0, qa + 32, lane); quad_store_lds(acc, TL(9), qa, qb_, lane); }
    }
    RW_BAR();
    if (next_item >= 0) r1_load(nxt, wsc, next_item, tid);
    const LAS float* gl = (const LAS float*)(lds + RW_GL);
#pragma unroll
    for (int rnd = 0; rnd < 2; ++rnd) {
        const int id = rnd * 8 + wave;
        if (id < 12) {
            const int kind = id >> 2, q = id & 3, qa = (q >> 1) * 32, qb_ = (q & 1) * 32; const int row = qa + r32; f32x16 acc;
#pragma unroll
            for (int r = 0; r < 16; ++r) acc[r] = 0.f;
            if (kind == 0) { quad_mma<false, true>(acc, TL(11), qa, TL(9), qb_, 0, qa + 32, lane); quad_store_lds(acc, TL(10), qa, qb_, lane); }
            else if (kind == 1) {
#pragma unroll
                for (int g = 0; g < 4; ++g) { const v2u w = *(const LAS v2u*)(TL(0) + row * RP + (qb_ + 8 * g + 4 * h2) * 2);
                    acc[4 * g] = bf2f(w.x & 0xffffu); acc[4 * g + 1] = bf2f(w.x >> 16); acc[4 * g + 2] = bf2f(w.y & 0xffffu); acc[4 * g + 3] = bf2f(w.y >> 16); }
                quad_mma<false, true>(acc, TL(7), qa, TL(5), qb_, 0, qa + 32, lane);
#pragma unroll
                for (int g = 0; g < 4; ++g) { v2u w; w.x = cvtpk(acc[4 * g], acc[4 * g + 1]); w.y = cvtpk(acc[4 * g + 2], acc[4 * g + 3]); *(gv2u*)(QtG + row * 64 + qb_ + 8 * g + 4 * h2) = w; }
            } else {
                quad_mma<true, true>(acc, TL(2), qa, TL(5), qb_, 0, 64, lane);
                const float gL = gl[row];
                float p[16];
#pragma unroll
                for (int r = 0; r < 16; ++r) { const int col = qb_ + 8 * (r >> 2) + 4 * h2 + (r & 3); p[r] = gL * (acc[r] + (col == row ? 1.0f : 0.f)); }
#pragma unroll
                for (int s = 0; s < 2; ++s) { v4u w; w.x = cvtpk(p[8 * s], p[8 * s + 1]); w.y = cvtpk(p[8 * s + 2], p[8 * s + 3]); w.z = cvtpk(p[8 * s + 4], p[8 * s + 5]); w.w = cvtpk(p[8 * s + 6], p[8 * s + 7]);
                    *(gv4u*)(PG + (((qa >> 5) * 4 + (qb_ >> 4) + s) * 64 + lane) * 8) = w; }
            }
        }
    }
    RW_BAR();
    {
        const int q = wave & 3, qa = (q >> 1) * 32, qb_ = (q & 1) * 32; const int row = qa + r32; f32x16 acc;
#pragma unroll
        for (int r = 0; r < 16; ++r) acc[r] = 0.f;
        if (wave < 4) {
            quad_mma<false, true>(acc, TL(7), qa, TL(10), qb_, 0, qa + 32, lane); quad_mma<false, true>(acc, TL(8), qa, TL(4), qb_, 0, qa + 32, lane);
#pragma unroll
            for (int g = 0; g < 4; ++g) *(gf32x4*)(YiG + row * 64 + qb_ + 8 * g + 4 * h2) = (f32x4){acc[4 * g], acc[4 * g + 1], acc[4 * g + 2], acc[4 * g + 3]};
        } else {
            for (int k0 = 0; k0 < 64; k0 += 16) { acc = __builtin_amdgcn_mfma_f32_32x32x16_bf16(trfrag(TL(2), k0, qa, lane), trfrag(TL(10), k0, qb_, lane), acc, 0, 0, 0);
                                                  acc = __builtin_amdgcn_mfma_f32_32x32x16_bf16(trfrag(TL(3), k0, qa, lane), trfrag(TL(4), k0, qb_, lane), acc, 0, 0, 0); }
            gf32* gp = GG + ((((qb_ >> 5) * 2 + (qa >> 5)) * 4) * 64 + lane) * 4;
#pragma unroll
            for (int g = 0; g < 4; ++g) { const f32x4 gv = *(const LAS f32x4*)(gl + qa + 8 * g + 4 * h2);
                *(gf32x4*)(gp + g * 256) = (f32x4){gv[0] * acc[4 * g], gv[1] * acc[4 * g + 1], gv[2] * acc[4 * g + 2], gv[3] * acc[4 * g + 3]}; }
        }
    }
    RW_BAR();
#undef TL
}

constexpr int SC_NS = 5, SC_SLOT = 24576;
static_assert(SC_NS * SC_SLOT <= RING_BYTES, "scan ring");
__device__ __forceinline__ void rwkv_scan(const gu8* wsc, const gu8* tmpc, int bh, LAS unsigned char* lds, int wave, int lane) {
    gu8* ws = (gu8*)wsc;
    const gbf* PGb = (const gbf*)(tmpc + 8 * MiB) + (size_t)bh * 32 * 4096; const gf32* GGb = (const gf32*)(ws + WS_R1) + (size_t)bh * 32 * 4096;
    gbf* TGb = (gbf*)(ws + WS_YRAW) + (size_t)bh * 32 * 4096;
    const int r32 = lane & 31, h2 = lane >> 5, cb = wave & 1;
    const unsigned lds0 = (unsigned)(uintptr_t)lds;
#define SC_DMA(c_, slot_) do { _Pragma("unroll") for (int q_ = 0; q_ < 4; ++q_) { const int p_ = (wave - 2) * 4 + q_; \
        const GAS void* src_ = p_ < 8 ? (const GAS void*)(PGb + (size_t)(c_) * 4096 + p_ * 512 + lane * 8) : (const GAS void*)(GGb + (size_t)(c_) * 4096 + (p_ - 8) * 256 + lane * 4); \
        glds16(src_, (unsigned)__builtin_amdgcn_readfirstlane(lds0 + (slot_) * SC_SLOT + p_ * 1024)); } } while (0)
    if (wave >= 2) { SC_DMA(0, 0); SC_DMA(1, 1); SC_DMA(2, 2); SC_DMA(3, 3); asm volatile("s_waitcnt vmcnt(12)" ::: "memory"); }
    asm volatile("s_waitcnt lgkmcnt(0)\n\ts_barrier" ::: "memory");
    f32x16 T0, T1;
#pragma unroll
    for (int r = 0; r < 16; ++r) { T0[r] = 0.f; T1[r] = 0.f; }
    for (int c = 0; c < 32; ++c) {
        if (wave >= 2) { if (c + 4 < 32) SC_DMA(c + 4, (c + 4) % SC_NS); }
        else {
            const LAS unsigned char* sl = lds + (c % SC_NS) * SC_SLOT;
            gbf* Tp = TGb + (size_t)c * 4096 + (32 * cb + r32) * 64;
            bf16x8 tb[4];
#pragma unroll
            for (int g = 0; g < 4; ++g) {
                v2u w0, w1; w0.x = cvtpk(T0[4 * g], T0[4 * g + 1]); w0.y = cvtpk(T0[4 * g + 2], T0[4 * g + 3]); w1.x = cvtpk(T1[4 * g], T1[4 * g + 1]); w1.y = cvtpk(T1[4 * g + 2], T1[4 * g + 3]);
                *(gv2u*)(Tp + 8 * g + 4 * h2) = w0; *(gv2u*)(Tp + 32 + 8 * g + 4 * h2) = w1;
            }
#pragma unroll
            for (int s = 0; s < 2; ++s) {
                v4u w0, w1;
                w0.x = cvtpk(T0[8 * s], T0[8 * s + 1]); w0.y = cvtpk(T0[8 * s + 2], T0[8 * s + 3]); w0.z = cvtpk(T0[8 * s + 4], T0[8 * s + 5]); w0.w = cvtpk(T0[8 * s + 6], T0[8 * s + 7]);
                w1.x = cvtpk(T1[8 * s], T1[8 * s + 1]); w1.y = cvtpk(T1[8 * s + 2], T1[8 * s + 3]); w1.z = cvtpk(T1[8 * s + 4], T1[8 * s + 5]); w1.w = cvtpk(T1[8 * s + 6], T1[8 * s + 7]);
                tb[s] = __builtin_bit_cast(bf16x8, w0); tb[2 + s] = __builtin_bit_cast(bf16x8, w1);
            }
            f32x16 N0, N1;
#pragma unroll
            for (int g = 0; g < 4; ++g) {
                const f32x4 ga = *(const LAS f32x4*)(sl + 8192 + (((cb * 2 + 0) * 4 + g) * 64 + lane) * 16), gb = *(const LAS f32x4*)(sl + 8192 + (((cb * 2 + 1) * 4 + g) * 64 + lane) * 16);
                N0[4 * g] = ga[0]; N0[4 * g + 1] = ga[1]; N0[4 * g + 2] = ga[2]; N0[4 * g + 3] = ga[3]; N1[4 * g] = gb[0]; N1[4 * g + 1] = gb[1]; N1[4 * g + 2] = gb[2]; N1[4 * g + 3] = gb[3];
            }
#pragma unroll
            for (int ks = 0; ks < 4; ++ks) {
                const bf16x8 a0 = *(const LAS bf16x8*)(sl + ((0 * 4 + ks) * 64 + lane) * 16), a1 = *(const LAS bf16x8*)(sl + ((1 * 4 + ks) * 64 + lane) * 16);
                N0 = __builtin_amdgcn_mfma_f32_32x32x16_bf16(a0, tb[ks], N0, 0, 0, 0);
                N1 = __builtin_amdgcn_mfma_f32_32x32x16_bf16(a1, tb[ks], N1, 0, 0, 0);
            }
            T0 = N0; T1 = N1;
        }
        if (wave >= 2) { if (c + 4 < 32) asm volatile("s_waitcnt vmcnt(12)" ::: "memory"); else if (c + 3 < 32) asm volatile("s_waitcnt vmcnt(8)" ::: "memory");
                         else if (c + 2 < 32) asm volatile("s_waitcnt vmcnt(4)" ::: "memory"); else asm volatile("s_waitcnt vmcnt(0)" ::: "memory"); }
        asm volatile("s_waitcnt lgkmcnt(0)\n\ts_barrier" ::: "memory");
    }
#undef SC_DMA
}

__device__ __forceinline__ void rwkv_out_item(const gu8* wsc, const DArgs& a, int l, int e, int wave, int lane) {
    gu8* ws = (gu8*)wsc;
    const gu8* tmpb = (const gu8*)a.out;
    const gbf* QtGb = (const gbf*)(tmpb); const gf32* YiGb = (const gf32*)(tmpb + 16 * MiB); const gbf* TGb = (const gbf*)(ws + WS_YRAW);
    const gf32* SB = (const gf32*)(ws + WS_SB);
    const gbf* P2 = (const gbf*)(ws + WS_PB) + 2 * PANEL; const gbf* P3 = (const gbf*)(ws + WS_PB) + 3 * PANEL;
    const gf32*mu_v = a.in[4] + l * 832 + 512, *lnx_w = a.in[12] + l * 256, *lnx_b = a.in[13] + l * 256;
    gbf* Y = (gbf*)(ws + WS_XB);
    const int r32 = lane & 31, h2 = lane >> 5;
    {
        const int tb_ = wave & 1, item = (e >> 3) * 32 + (e & 7) * 4 + (wave >> 1), c = item & 31, h = (item >> 5) & 3, b = item >> 7;
        const int tl = c * 64 + 32 * tb_ + r32; const size_t tok = (size_t)b * T + tl;
        const gbf* Qp = QtGb + (size_t)item * 4096 + (32 * tb_ + r32) * 64; const gf32* Yp = YiGb + (size_t)item * 4096 + (32 * tb_ + r32) * 64; const gbf* Tp = TGb + (size_t)item * 4096;
        f32x16 acc[2];
#pragma unroll
        for (int ib = 0; ib < 2; ++ib)
#pragma unroll
            for (int g = 0; g < 4; ++g) { const f32x4 y = *(const gf32x4*)(Yp + 32 * ib + 8 * g + 4 * h2); acc[ib][4 * g] = y[0]; acc[ib][4 * g + 1] = y[1]; acc[ib][4 * g + 2] = y[2]; acc[ib][4 * g + 3] = y[3]; }
#pragma unroll
        for (int ks = 0; ks < 4; ++ks) {
            const bf16x8 qf = *(const gbf16x8*)(Qp + 16 * ks + 8 * h2);
#pragma unroll
            for (int ib = 0; ib < 2; ++ib) { const bf16x8 tf = *(const gbf16x8*)(Tp + (32 * ib + r32) * 64 + 16 * ks + 8 * h2);
                acc[ib] = __builtin_amdgcn_mfma_f32_32x32x16_bf16(tf, qf, acc[ib], 0, 0, 0); }
        }
        float s = 0.f;
#pragma unroll
        for (int r = 0; r < 16; ++r) s += acc[0][r] + acc[1][r];
        s += __shfl_xor(s, 32); const float mean = s * (1.0f / 64.0f);
        float vs = 0.f;
#pragma unroll
        for (int r = 0; r < 16; ++r) { const float d0 = acc[0][r] - mean, d1 = acc[1][r] - mean; vs += d0 * d0 + d1 * d1; }
        vs += __shfl_xor(vs, 32); const float rstd = rsqrtf(vs * (1.0f / 64.0f) + 64e-5f);
        const float sb = SB[tok * 4 + h]; const bool hp = tl > 0;
        const size_t tokp = hp ? tok - 1 : tok;
#pragma unroll
        for (int ib = 0; ib < 2; ++ib) {
            f32x4 lw[4], lb[4], mv[4]; v2u vc[4], gt[4], vp[4];
#pragma unroll
            for (int g = 0; g < 4; ++g) { const int ch = h * 64 + 32 * ib + 8 * g + 4 * h2;
                lw[g] = *(const gf32x4*)(lnx_w + ch); lb[g] = *(const gf32x4*)(lnx_b + ch); mv[g] = *(const gf32x4*)(mu_v + ch);
                vc[g] = *(const gv2u*)(P2 + tok * 256 + ch); gt[g] = *(const gv2u*)(P3 + tok * 256 + ch); vp[g] = *(const gv2u*)(P2 + tokp * 256 + ch); }
#pragma unroll
            for (int g = 0; g < 4; ++g) {
                const int ch = h * 64 + 32 * ib + 8 * g + 4 * h2;
                float o[4];
#pragma unroll
                for (int e = 0; e < 4; ++e) {
                    const unsigned sh = (e & 1) * 16; const float v0 = bf2f(((e >> 1 ? vc[g].y : vc[g].x) >> sh) & 0xffffu), v1 = hp ? bf2f(((e >> 1 ? vp[g].y : vp[g].x) >> sh) & 0xffffu) : 0.f, gg = bf2f(((e >> 1 ? gt[g].y : gt[g].x) >> sh) & 0xffffu);
                    const float xv = v0 + (v1 - v0) * mv[g][e];
                    o[e] = ((acc[ib][4 * g + e] - mean) * rstd * lw[g][e] + lb[g][e] + sb * xv) * gg;
                }
                v2u w; w.x = cvtpk(o[0], o[1]); w.y = cvtpk(o[2], o[3]);
                *(gv2u*)(Y + tok * D + ch) = w;
            }
        }
    }
}

constexpr int LR_PITCH = 68;
static_assert(4 * 64 * LR_PITCH * 4 <= RING_BYTES, "lora partials fit the LDS scratch");
__device__ __forceinline__ void lora_proj(const gu8* wsc, int l, LAS unsigned char* lds, int wave, int lane, int tid) {
    gu8* ws = (gu8*)wsc;
    const gbf* XA = (const gbf*)(ws + WS_XA); const gbf* WL = (const gbf*)(ws + WS_WIN) + (size_t)l * NPAD * D + (size_t)4096 * D;
    const gf32* ssq = (const gf32*)(ws + WS_CTL + CTL_SSQ) + (size_t)l * M; gbf* P16 = (gbf*)(ws + WS_PB) + 16 * PANEL;
    const int r32 = lane & 31, h2 = lane >> 5, ksl = wave & 3, a = wave >> 2;
    LAS float* part = (LAS float*)lds;
    for (int blk = blockIdx.x; blk < M / 64; blk += gridDim.x) {
        const int r0 = blk * 64;
        f32x16 acc0, acc1;
#pragma unroll
        for (int r = 0; r < 16; ++r) { acc0[r] = 0.f; acc1[r] = 0.f; }
#pragma unroll 8
        for (int s = 0; s < 16; ++s) {
            const int k = 256 * ksl + 16 * s + 8 * h2;
            const bf16x8 af = *(const gbf16x8*)(XA + (size_t)(r0 + 32 * a + r32) * D + k);
            const bf16x8 b0 = *(const gbf16x8*)(WL + (size_t)r32 * D + k), b1 = *(const gbf16x8*)(WL + (size_t)(32 + r32) * D + k);
            acc0 = __builtin_amdgcn_mfma_f32_32x32x16_bf16(b0, af, acc0, 0, 0, 0); acc1 = __builtin_amdgcn_mfma_f32_32x32x16_bf16(b1, af, acc1, 0, 0, 0);
        }
#pragma unroll
        for (int g = 0; g < 4; ++g) {
            *(LAS f32x4*)(part + (ksl * 64 + 32 * a + r32) * LR_PITCH + 8 * g + 4 * h2) = (f32x4){acc0[4 * g], acc0[4 * g + 1], acc0[4 * g + 2], acc0[4 * g + 3]};
            *(LAS f32x4*)(part + (ksl * 64 + 32 * a + r32) * LR_PITCH + 32 + 8 * g + 4 * h2) = (f32x4){acc1[4 * g], acc1[4 * g + 1], acc1[4 * g + 2], acc1[4 * g + 3]};
        }
        __syncthreads();
        { const int row = tid >> 3, cg = tid & 7; f32x4 s0 = {0.f, 0.f, 0.f, 0.f}, s1 = {0.f, 0.f, 0.f, 0.f};
#pragma unroll
          for (int w = 0; w < 4; ++w) { s0 += *(const LAS f32x4*)(part + (w * 64 + row) * LR_PITCH + 8 * cg); s1 += *(const LAS f32x4*)(part + (w * 64 + row) * LR_PITCH + 8 * cg + 4); }
          const float rs = rsqrtf(ssq[r0 + row] * (1.0f / 1024.0f) + 1e-6f);
          v4u o; o.x = cvtpk(s0[0] * rs, s0[1] * rs); o.y = cvtpk(s0[2] * rs, s0[3] * rs); o.z = cvtpk(s1[0] * rs, s1[1] * rs); o.w = cvtpk(s1[2] * rs, s1[3] * rs);
          *(gv4u*)(P16 + (size_t)(r0 + row) * 64 + 8 * cg) = o; }
        __syncthreads();
    }
}

__device__ __forceinline__ int src_col(int n) { return n < 768 ? n : (n < 4096 ? n + 64 : n - 4096 + 768); }

__device__ __forceinline__ void p0_transpose_item(const gf32* W, int N, int K, const gf32* kscale, gbf* WT, int dst_row0, int src_col0, int k0, LAS float* scr, int lane) {
    float wv[32];
#pragma unroll
    for (int i = 0; i < 32; ++i) wv[i] = W[(size_t)(k0 + 2 * i + (lane >> 5)) * N + src_col0 + (lane & 31)];
    if (kscale) {
#pragma unroll
        for (int i = 0; i < 32; ++i) wv[i] *= kscale[k0 + 2 * i + (lane >> 5)];
    }
#pragma unroll
    for (int i = 0; i < 32; ++i) scr[(2 * i + (lane >> 5)) * 33 + (lane & 31)] = wv[i];
    LDS_WAIT(); asm volatile("" ::: "memory");
    const int c = lane & 7;
#pragma unroll
    for (int j = 0; j < 4; ++j) { const int n = (lane >> 3) + 8 * j; const LAS float* s = scr + (8 * c) * 33 + n;
        v4u o; o.x = pk2(s[0 * 33], s[1 * 33]); o.y = pk2(s[2 * 33], s[3 * 33]); o.z = pk2(s[4 * 33], s[5 * 33]); o.w = pk2(s[6 * 33], s[7 * 33]);
        *(gv4u*)(WT + (size_t)(dst_row0 + n) * K + k0 + 8 * c) = o; }
    LDS_WAIT(); asm volatile("" ::: "memory");
}

__device__ __forceinline__ void convert_weights(const DArgs& a, int l0, int l1, int w, int nw, LAS unsigned char* lds, int wave, int lane) {
    gu8* ws = a.ws;
    LAS float* scr = (LAS float*)(lds + RING_OFF + wave * 16384);
    constexpr int I_IN = 16 * 130, I_OUT = 16 * 32, I_L = I_IN + I_OUT;
    for (int it = l0 * I_L + w; it < l1 * I_L; it += nw) {
        const int l = it / I_L; int r = it % I_L;
        if (r < I_IN) { const int kb = r / 130, nb = r % 130;
            p0_transpose_item(a.in[2] + (size_t)l * D * WCOLS, WCOLS, D, a.in[1] + l * D, (gbf*)(ws + WS_WIN) + (size_t)l * NPAD * D, 32 * nb, src_col(32 * nb), 64 * kb, scr, lane); }
        else { r -= I_IN; const int kb = r / 32, nb = r % 32;
            p0_transpose_item(a.in[3] + (size_t)l * D * D, D, D, nullptr, (gbf*)(ws + WS_WOUT) + (size_t)l * D * D, 32 * nb, 32 * nb, 64 * kb, scr, lane); }
    }
}
constexpr int W_LATER = 1;
__device__ __forceinline__ void phase_prologue(const DArgs& a, LAS unsigned char* lds, int wave, int lane, int tid) {
    gu8* ws = a.ws;
    const int G = gridDim.x, gw = blockIdx.x * NWAVES + wave, NGW = G * NWAVES;
    convert_weights(a, 0, (G == 256) ? W_LATER : DEPTH, gw, NGW, lds, wave, lane);
    { const gf32* x = a.in[0]; gbf* xa = (gbf*)(ws + WS_XA); gf32* ssq0 = (gf32*)(ws + WS_CTL + CTL_SSQ);
      for (int m0 = gw * 4; m0 < M; m0 += NGW * 4) {
          f32x4 v[4][4];
#pragma unroll
          for (int r = 0; r < 4; ++r) { const gf32x4* xr = (const gf32x4*)(x + (size_t)(m0 + r) * D) + lane;
#pragma unroll
              for (int j = 0; j < 4; ++j) v[r][j] = xr[64 * j]; }
#pragma unroll
          for (int r = 0; r < 4; ++r) { float s = 0.f;
#pragma unroll
              for (int j = 0; j < 4; ++j) s += (v[r][j].x * v[r][j].x + v[r][j].y * v[r][j].y) + (v[r][j].z * v[r][j].z + v[r][j].w * v[r][j].w);
              s = wave_sum(s); if (lane == 0) ssq0[m0 + r] = s;
              gv2u* o8 = (gv2u*)(xa + (size_t)(m0 + r) * D) + lane;
#pragma unroll
              for (int j = 0; j < 4; ++j) { v2u o; o.x = pk2(v[r][j].x, v[r][j].y); o.y = pk2(v[r][j].z, v[r][j].w); o8[64 * j] = o; } }
      } }
    { const int gt = blockIdx.x * (NWAVES * 64) + tid, NT = G * NWAVES * 64;
      gf32* lut = (gf32*)(ws + WS_TAB + TAB_LUT);
      if (gt < 32) ((gf32*)(ws + WS_TAB + TAB_THR))[gt] = (float)(THETA_D[gt] * 0.15915494309189535);
      for (int idx = gt; idx < NH * 128; idx += NT) { const int h = idx >> 7, d = idx & 127;
          int bk = d; if (d >= 16) { bk = 16 + (int)(logf((float)d * (1.0f / 16.0f)) / 2.0794415416798357f * 16.0f); if (bk > 31) bk = 31; }
          lut[idx] = a.in[15][bk * NH + h]; }
      gf32* lut2 = (gf32*)(ws + WS_TAB + TAB_LUT2);
      for (int idx = gt; idx < NH * 1536; idx += NT) { const int h = idx / 1536, w = idx % 1536, c = w / 336, i = w % 336;
          float v = -1e30f;
          if (c < 4) { const int d = 255 - (i + c);
              if (d > 127) v = 0.f;
              else if (d >= 0) { int bk = d; if (d >= 16) { bk = 16 + (int)(logf((float)d * (1.0f / 16.0f)) / 2.0794415416798357f * 16.0f); if (bk > 31) bk = 31; }
                  v = (a.in[15][bk * NH + h] - a.in[15][31 * NH + h]) * 1.4426950408889634f; } }
          lut2[idx] = v; }
    }
}

__device__ __forceinline__ void conv_item(const DArgs& a, int l, int e, int wave, int lane) {
    gu8* ws = a.ws; const gf32* cw = a.in[14] + l * 768;
    const gbf* PB = (const gbf*)(ws + WS_PB);
    const gbf*Pb = PB + 4 * PANEL, *Pc = PB + 5 * PANEL, *Ph = PB + 6 * PANEL, *Pg = PB + 7 * PANEL;
    gbf* Y = (gbf*)(ws + WS_XB);
    const int tok0 = e * 64 + wave * 8, t0 = tok0 & (T - 1); const size_t o0 = (size_t)tok0 * 256 + 4 * lane;
    v2u bb[8], gg[8], cc[10], hh[10];
#pragma unroll
    for (int i = 0; i < 8; ++i) { bb[i] = *(const gv2u*)(Pb + o0 + i * 256); gg[i] = *(const gv2u*)(Pg + o0 + i * 256); cc[i + 2] = *(const gv2u*)(Pc + o0 + i * 256); hh[i + 2] = *(const gv2u*)(Ph + o0 + i * 256); }
    cc[0] = cc[1] = hh[0] = hh[1] = (v2u){0u, 0u};
    if (t0 >= 2) { cc[0] = *(const gv2u*)(Pc + o0 - 512); hh[0] = *(const gv2u*)(Ph + o0 - 512); cc[1] = *(const gv2u*)(Pc + o0 - 256); hh[1] = *(const gv2u*)(Ph + o0 - 256); }
    const f32x4 w0 = *(const gf32x4*)(cw + 4 * lane), w1 = *(const gf32x4*)(cw + 256 + 4 * lane), w2 = *(const gf32x4*)(cw + 512 + 4 * lane);
#pragma unroll
    for (int i = 0; i < 8; ++i) {
        float out[4];
#pragma unroll
        for (int j = 0; j < 4; ++j) {
            const unsigned sh = (j & 1) * 16; const int hi = j >> 1;
#define EL(v) bf2f(((hi ? (v).y : (v).x) >> sh) & 0xffffu)
            const float u0 = EL(cc[i + 2]) * EL(hh[i + 2]), u1 = EL(cc[i + 1]) * EL(hh[i + 1]), u2 = EL(cc[i]) * EL(hh[i]);
            out[j] = EL(bb[i]) * (w0[j] * u2 + w1[j] * u1 + w2[j] * u0) * EL(gg[i]);
#undef EL
        }
        v2u w; w.x = cvtpk(out[0], out[1]); w.y = cvtpk(out[2], out[3]);
        *(gv2u*)(Y + (size_t)(tok0 + i) * D + 256 + 4 * lane) = w;
    }
}

constexpr int QN_SCAN = 32, QN_ATT = 512, QN_CONV = M / 64, QN_OUT = 256, QN_ALL = QN_SCAN + QN_ATT + QN_CONV + QN_OUT;
constexpr int QW_HEAD = 0, QW_CNT = 64, QW_SCANDONE = 64 * 40, QW_LAYER = 4096;
__device__ __forceinline__ bool q_wait_ge(GAS unsigned* w, unsigned need, GAS unsigned* tmo) {
    unsigned sp = 0; bool ok = true;
    while (__hip_atomic_load(w, __ATOMIC_RELAXED, __HIP_MEMORY_SCOPE_AGENT) < need) {
        __builtin_amdgcn_s_sleep(2);
        if ((++sp & 255u) == 0u) { if (__hip_atomic_load(tmo, __ATOMIC_RELAXED, __HIP_MEMORY_SCOPE_AGENT) != 0u) { ok = false; break; }
                                   if (sp > (1u << 20)) { __hip_atomic_store(tmo, 1u, __ATOMIC_RELAXED, __HIP_MEMORY_SCOPE_AGENT); ok = false; break; } }
    }
    __builtin_amdgcn_fence(__ATOMIC_ACQUIRE, "agent");
    asm volatile("s_waitcnt vmcnt(0)" ::: "memory");
    return ok;
}
__device__ __forceinline__ void q_publish(GAS unsigned* w, unsigned add) {
    __builtin_amdgcn_fence(__ATOMIC_RELEASE, "agent");
    asm volatile("s_waitcnt vmcnt(0)" ::: "memory");
    __hip_atomic_fetch_add(w, add, __ATOMIC_RELAXED, __HIP_MEMORY_SCOPE_AGENT);
}
__device__ __forceinline__ void mix_phase(const DArgs& a0_, int l, int qblk, LAS unsigned char* lds, int wave, int lane0_, int tid) {
    GAS unsigned* qw = (GAS unsigned*)(a0_.ws + WS_CTL + CTL_Q) + qblk * QW_LAYER;
    GAS unsigned* tmo = (GAS unsigned*)(a0_.ws + WS_CTL) + 8;
    volatile LAS unsigned* qslot = (volatile LAS unsigned*)(lds + MISC_OFF + 64);
    {
        R1In inA, inB; int staged_h = -1;
        if ((int)blockIdx.x < BATCH * NH * 32) r1_load(inA, a0_.ws, blockIdx.x, tid);
        for (int item = blockIdx.x; item < BATCH * NH * 32; item += gridDim.x) {
            int ln2; asm volatile("v_mbcnt_lo_u32_b32 %0, -1, 0\n\tv_mbcnt_hi_u32_b32 %0, -1, %0" : "=v"(ln2));
            const int td2 = wave * 64 + ln2;
            const int h = (item >> 5) & 3;
            if (h != staged_h) { __syncthreads(); r1_stage_lora_w(a0_, l, h, lds, td2); staged_h = h; }
            const int nx = item + (int)gridDim.x < BATCH * NH * 32 ? item + (int)gridDim.x : -1;
            rwkv_chunk_item(a0_.ws, a0_, l, item, inA, nx, inB, lds, wave, ln2, td2);
            inA = inB;
        }
    }
    asm volatile("s_waitcnt vmcnt(0)" ::: "memory"); __syncthreads();
    if (tid == 0) { __builtin_amdgcn_fence(__ATOMIC_RELEASE, "agent"); asm volatile("s_waitcnt vmcnt(0)" ::: "memory");
        for (int item = blockIdx.x; item < BATCH * NH * 32; item += gridDim.x) __hip_atomic_fetch_add(qw + QW_CNT + 64 * (item >> 5), 1u, __ATOMIC_RELAXED, __HIP_MEMORY_SCOPE_AGENT);
    }
    bool out_ready = false;
    for (int it = 0;; ++it) {
        if (tid == 0) qslot[it & 1] = __hip_atomic_fetch_add(qw + QW_HEAD, 1u, __ATOMIC_RELAXED, __HIP_MEMORY_SCOPE_AGENT);
        __syncthreads();
        const int u = (int)__builtin_amdgcn_readfirstlane(qslot[it & 1]);
        if (u >= QN_ALL) break;
        DArgs al = a0_;
        { _Pragma("unroll") for (int i_ = 0; i_ < 17; ++i_) asm volatile("" : "+s"(al.in[i_])); asm volatile("" : "+s"(al.out), "+s"(al.ws)); }
        int lane; asm volatile("v_mbcnt_lo_u32_b32 %0, -1, 0\n\tv_mbcnt_hi_u32_b32 %0, -1, %0" : "=v"(lane));
        if (u < QN_SCAN) {
            if (tid == 0) (void)q_wait_ge(qw + QW_CNT + 64 * u, 32u, tmo);
            __syncthreads();
            rwkv_scan(al.ws, (const gu8*)al.out, u, lds, wave, lane);
            asm volatile("s_waitcnt vmcnt(0)" ::: "memory"); __syncthreads();
            if (tid == 0) q_publish(qw + QW_SCANDONE, 1u);
        } else if (u < QN_SCAN + QN_ATT) {
            attn_dispatch(al.ws, l, u - QN_SCAN, lds, wave, lane);
            if (PROBE_DUP == 20 || (PROBE_DUP == 21 && ((u - QN_SCAN) >> 5 & 1) == 0) || (PROBE_DUP == 22 && ((u - QN_SCAN) >> 5 & 1) == 1)) { __syncthreads(); attn_dispatch(al.ws, l, u - QN_SCAN, lds, wave, lane); }
        } else if (u < QN_SCAN + QN_ATT + QN_CONV) {
            conv_item(al, l, u - QN_SCAN - QN_ATT, wave, lane);
        } else {
            if (!out_ready) { if (tid == 0) (void)q_wait_ge(qw + QW_SCANDONE, (unsigned)QN_SCAN, tmo); __syncthreads(); out_ready = true; }
            rwkv_out_item(al.ws, al, l, u - QN_SCAN - QN_ATT - QN_CONV, wave, lane);
        }
    }
}

__global__ void __launch_bounds__(NWAVES * 64, 2) hybrid_fwd(Args args) {
    extern __shared__ __attribute__((aligned(16))) unsigned char lds_raw[];
    LAS unsigned char* lds = (LAS unsigned char*)lds_raw;
    const int tid = threadIdx.x; const int wave = __builtin_amdgcn_readfirstlane(tid >> 6);
    volatile LAS unsigned* MISC = (volatile LAS unsigned*)(lds + MISC_OFF);
    for (int u = tid; u < (LDS_BYTES - LDSCTL_OFF) / 4; u += NWAVES * 64) ((LAS unsigned*)(lds + LDSCTL_OFF))[u] = 0u;
    __syncthreads();
    unsigned char* ws = args.ws;
    unsigned* ctl = (unsigned*)(ws + WS_CTL);
    const int lo = (N_LAUNCHES == 1) ? 0 : args.ph_lo, hi = (N_LAUNCHES == 1) ? N_PHASES : args.ph_hi;
    XcdBarrier bar; bar.bar = ctl + CW_BAR; bar.x = 0; bar.st = nullptr;
    if (hi - lo > 1) bar = xcd_barrier_post(ctl + CW_BAR, MISC + 8);
#define IN(k) (lo <= (k) && (k) < hi)
#define SEAM(k) do { if (IN(k) && IN((k) + 1)) { XcdBarrier b_ = bar; asm volatile("" : "+s"(b_.bar), "+s"(b_.x)); xcd_barrier(b_); } } while (0)

#define FRESH_ARGS() DArgs A; { _Pragma("unroll") for (int i_ = 0; i_ < 17; ++i_) { A.in[i_] = (const gf32*)args.in[i_]; asm volatile("" : "+s"(A.in[i_])); } A.out = (gf32*)args.out; A.ws = (gu8*)args.ws; asm volatile("" : "+s"(A.out), "+s"(A.ws)); } \
    int wv = wave; asm volatile("" : "+s"(wv)); int ln; asm volatile("v_mbcnt_lo_u32_b32 %0, -1, 0\n\tv_mbcnt_hi_u32_b32 %0, -1, %0" : "=v"(ln)); int td = wv * 64 + ln;
    if (IN(0)) { for (int rep = 0; rep < (PROBE_DUP == 7 ? 2 : 1); ++rep) { FRESH_ARGS(); phase_prologue(A, lds, wv, ln, td); } }
    SEAM(0);
    for (int l = 0; l < DEPTH; ++l) {
        const int pb = 1 + 3 * l;
        if (IN(pb)) {
            for (int rep = 0; rep < (PROBE_DUP == 6 ? 2 : 1); ++rep) {
            FRESH_ARGS(); unsigned char* w_ = (unsigned char*)A.ws;
            const int ncols = (l == 0 || gridDim.x != 256) ? NPAD : NMAIN;
            pg8::Gemm g{(const pg8::bf16_t*)(w_ + WS_XA), (const pg8::bf16_t*)(w_ + WS_WIN) + (size_t)l * NPAD * D, M, ncols, D};
            pg8::StaticOrder S; S.init(M, ncols, gridDim.x, (int)blockIdx.x);
            pg8::EpiWin E{(pg8::bf16_t*)(w_ + WS_PB), (const float*)(w_ + WS_CTL + CTL_SSQ) + (size_t)l * M, (const float*)(w_ + WS_TAB + TAB_THR), (float*)(w_ + WS_CTL + CTL_KM) + l * 64 * 256};
            pg8::gemm_phase<pg8::EpiWin, pg8::StaticOrder, PG8_ALIGN, PG8_SP2>(lds + RING_OFF, g, S, E, td);
            if (ncols == NMAIN) { __syncthreads(); lora_proj(A.ws, l, lds, wv, ln, td); }
            if (l == 0 && gridDim.x == 256 && W_LATER < DEPTH) {
                pg8::Unit u5; if (!S.next(4, u5)) convert_weights(A, W_LATER, DEPTH, ((int)blockIdx.x - 64) * NWAVES + wv, 192 * NWAVES, lds, wv, ln);
            }
            if (PROBE_DUP == 6) __syncthreads();
            if (PROBE_DUP == 12) { __syncthreads(); pg8::EpiNull EN; pg8::gemm_phase<pg8::EpiNull, pg8::StaticOrder, PG8_ALIGN, PG8_SP2>(lds + RING_OFF, g, S, EN, td); }
            }
        }
        SEAM(pb);
        if (IN(pb + 1)) { for (int rep = 0; rep < (PROBE_DUP == 10 ? 2 : 1); ++rep) { FRESH_ARGS(); mix_phase(A, l, l + 2 * rep, lds, wv, ln, td); } }
        SEAM(pb + 1);
        if (IN(pb + 2)) {
            FRESH_ARGS(); unsigned char* w_ = (unsigned char*)A.ws;
            pg8::Gemm g{(const pg8::bf16_t*)(w_ + WS_XB), (const pg8::bf16_t*)(w_ + WS_WOUT) + (size_t)l * D * D, M, D, D};
            pg8::StaticOrder S; S.init(M, D, gridDim.x, (int)blockIdx.x);
            if (l + 1 < DEPTH) {
                pg8::EpiWout E{(const pg8::bf16_t*)(w_ + WS_XA), (pg8::bf16_t*)(w_ + WS_XA), (float*)(w_ + WS_CTL + CTL_SSQ) + (size_t)(l + 1) * M};
                pg8::gemm_phase<pg8::EpiWout, pg8::StaticOrder, PG8_ALIGN, PG8_SP2>(lds + RING_OFF, g, S, E, td);
            } else {
                pg8::EpiWoutFinal E{(const pg8::bf16_t*)(w_ + WS_XA), (float*)A.out, (float*)(w_ + WS_SSQP), (unsigned*)(w_ + WS_CTL + CTL_Q) + 3 * QW_LAYER, (const float*)A.in[16], (unsigned*)(w_ + WS_CTL) + 8};
                pg8::gemm_phase<pg8::EpiWoutFinal, pg8::StaticOrder, false, PG8_SP2>(lds + RING_OFF, g, S, E, td);
            }
        }
        if (l + 1 < DEPTH) SEAM(pb + 2);
    }
#undef IN
#undef SEAM
}

extern "C" void kernel_launch(void* const* d_in, const int* in_sizes, int n_in, void* d_out, int out_size, void* d_ws, size_t ws_size, hipStream_t stream) {
    static int grid = 0;
    if (grid == 0) {
        if (n_in != 17 || in_sizes[0] != M * D || out_size != M * D || ws_size < WS_END) { fprintf(stderr, "kernel_launch: unexpected shapes (n_in %d, in0 %d, out %d, ws %zu); nothing launched\n", n_in, n_in > 0 ? in_sizes[0] : -1, out_size, ws_size); grid = -1; return; }
        int dev = 0, cus = 0, per_cu = 0;
        if (hipGetDevice(&dev) != hipSuccess || hipDeviceGetAttribute(&cus, hipDeviceAttributeMultiprocessorCount, dev) != hipSuccess) { grid = -1; return; }
        if (hipFuncSetAttribute((const void*)hybrid_fwd, hipFuncAttributeMaxDynamicSharedMemorySize, LDS_BYTES) != hipSuccess) { fprintf(stderr, "kernel_launch: hipFuncSetAttribute failed\n"); grid = -1; return; }
        if (hipOccupancyMaxActiveBlocksPerMultiprocessor(&per_cu, (const void*)hybrid_fwd, NWAVES * 64, LDS_BYTES) != hipSuccess || per_cu < 1)
            fprintf(stderr, "kernel_launch: note: occupancy query reports %d workgroups per CU\n", per_cu);
        (void)hipGetLastError();
        grid = cus;
    }
    if (grid < 0) return;
    if (hipMemsetAsync((char*)d_ws + WS_CTL, 0, CTL_ZERO_BYTES, stream) != hipSuccess) { fprintf(stderr, "kernel_launch: hipMemsetAsync failed\n"); return; }
    Args a{};
    for (int i = 0; i < 17; ++i) a.in[i] = (const float*)d_in[i];
    a.out = (float*)d_out; a.ws = (unsigned char*)d_ws;
    if (N_LAUNCHES == 1) {
        a.ph_lo = 0; a.ph_hi = N_PHASES; a.li = 0;
        hipLaunchKernelGGL(hybrid_fwd, dim3(grid), dim3(NWAVES * 64), LDS_BYTES, stream, a);
    } else {
        for (int p = 0; p < N_PHASES; ++p) { a.ph_lo = p; a.ph_hi = p + 1; a.li = p;
            hipLaunchKernelGGL(hybrid_fwd, dim3(grid), dim3(NWAVES * 64), LDS_BYTES, stream, a); }
    }
    const hipError_t le = hipPeekAtLastError();
    if (le != hipSuccess) fprintf(stderr, "kernel_launch: launch failed: %s\n", hipGetErrorName(le));
}
```
